# Optimizing an MI355X kernel written in HIP

```python
import math
import jax, jax.numpy as jnp
from jax import lax
import numpy as np

D_MODEL = 1024
BATCH = 4
SEQ = 8192
DEPTH = 2

CHUNK = 64
LEFT_CHUNKS = 8
BAND = (LEFT_CHUNKS + 1) * CHUNK
S5_WIDTH = D_MODEL // 2
S5_GROUP = 16
S5_GROUPS = S5_WIDTH // S5_GROUP
S5_STATE = 64
CONV_WIDTH = D_MODEL - S5_WIDTH
CONV_KERNEL = 31
ATT_HEADS = 16
ATT_HEAD_DIM = D_MODEL // ATT_HEADS
MAX_REL = 128
MEM_LEN = 256
XA_HEADS = 4
XA_HEAD_DIM = D_MODEL // XA_HEADS
EPS = 1e-6
N_EVEN = (DEPTH + 1) // 2
N_ODD = DEPTH // 2
EVEN_IN = 2 * S5_WIDTH + 3 * CONV_WIDTH
ODD_IN = 4 * D_MODEL

kernel_name = 'streaming_hybrid_s5_conv_chunkattn'


def rms_norm(x, g):
    xf = x.astype(jnp.float32)
    y = xf * lax.rsqrt(jnp.mean(xf * xf, axis=-1, keepdims=True) + EPS)
    return (y * g.astype(jnp.float32)).astype(x.dtype)


def _complex_affine_combine(e1, e2):
    a1r, a1i, b1r, b1i = e1
    a2r, a2i, b2r, b2i = e2
    ar = a2r * a1r - a2i * a1i
    ai = a2r * a1i + a2i * a1r
    br = a2r * b1r - a2i * b1i + b2r
    bi = a2r * b1i + a2i * b1r + b2i
    return (ar, ai, br, bi)


def s5_mixer(u, lam_re, lam_im, log_dt, b_re, b_im, c_re, c_im, d_skip, glu_w, glu_b):
    bsz, L, _ = u.shape
    f32 = jnp.float32
    uf = u.astype(f32)
    ug = uf.reshape(bsz, L, S5_GROUPS, S5_GROUP)
    lr = lam_re.astype(f32)
    li = lam_im.astype(f32)
    dt = jnp.exp(log_dt.astype(f32))[:, None]
    mag = jnp.exp(lr * dt)
    ab_re = mag * jnp.cos(li * dt)
    ab_im = mag * jnp.sin(li * dt)
    den = lr * lr + li * li
    nr = ab_re - 1.0
    coef_re = (nr * lr + ab_im * li) / den
    coef_im = (ab_im * lr - nr * li) / den
    br = b_re.astype(f32)
    bi = b_im.astype(f32)
    bb_re = coef_re[..., None] * br - coef_im[..., None] * bi
    bb_im = coef_re[..., None] * bi + coef_im[..., None] * br
    bu_re = jnp.einsum('blgc,gpc->blgp', ug, bb_re)
    bu_im = jnp.einsum('blgc,gpc->blgp', ug, bb_im)
    a_re = jnp.broadcast_to(ab_re, bu_re.shape)
    a_im = jnp.broadcast_to(ab_im, bu_im.shape)
    _, _, h_re, h_im = lax.associative_scan(_complex_affine_combine, (a_re, a_im, bu_re, bu_im), axis=1)
    y = (jnp.einsum('blgp,gcp->blgc', h_re, c_re.astype(f32))
         - jnp.einsum('blgp,gcp->blgc', h_im, c_im.astype(f32)))
    y = y.reshape(bsz, L, S5_WIDTH) + d_skip.astype(f32) * uf
    z = jax.nn.gelu(y)
    out = z * jax.nn.sigmoid(z @ glu_w.astype(f32) + glu_b.astype(f32))
    return out.astype(u.dtype)


def conv_module(val, glu_gate, conv_w, conv_b, ln_g, ln_b):
    v = val * jax.nn.sigmoid(glu_gate)
    vpad = jnp.pad(v, ((0, 0), (CONV_KERNEL - 1, 0), (0, 0)))
    c = lax.conv_general_dilated(vpad, conv_w[:, None, :].astype(v.dtype), window_strides=(1,),
                                 padding='VALID', dimension_numbers=('NWC', 'WIO', 'NWC'),
                                 feature_group_count=CONV_WIDTH) + conv_b.astype(v.dtype)
    cf = c.astype(jnp.float32)
    mu = jnp.mean(cf, axis=-1, keepdims=True)
    var = jnp.mean(jnp.square(cf - mu), axis=-1, keepdims=True)
    cn = (cf - mu) * lax.rsqrt(var + EPS) * ln_g.astype(jnp.float32) + ln_b.astype(jnp.float32)
    return jax.nn.silu(cn).astype(val.dtype)


def ssm_conv_layer(h, w_in, lam_re, lam_im, log_dt, b_re, b_im, c_re, c_im, d_skip, glu_w, glu_b,
                   conv_w, conv_b, ln_g, ln_b, w_out):
    z = h @ w_in
    cuts = [S5_WIDTH, 2 * S5_WIDTH, 2 * S5_WIDTH + CONV_WIDTH, 2 * S5_WIDTH + 2 * CONV_WIDTH]
    u_a, gate_a, val_b, glu_b_in, gate_b = jnp.split(z, cuts, axis=-1)
    y_a = s5_mixer(u_a, lam_re, lam_im, log_dt, b_re, b_im, c_re, c_im, d_skip, glu_w, glu_b) * jax.nn.silu(gate_a)
    y_b = conv_module(val_b, glu_b_in, conv_w, conv_b, ln_g, ln_b) * jax.nn.silu(gate_b)
    return jnp.concatenate([y_a, y_b], axis=-1) @ w_out


def chunk_attention_layer(h, w_in, rel_bias, w_out):
    bsz, L, _ = h.shape
    q, k, v, g = jnp.split(h @ w_in, 4, axis=-1)
    q = q.reshape(bsz, L, ATT_HEADS, ATT_HEAD_DIM)
    k = k.reshape(bsz, L, ATT_HEADS, ATT_HEAD_DIM)
    v = v.reshape(bsz, L, ATT_HEADS, ATT_HEAD_DIM)
    pad = BAND - CHUNK
    kp = jnp.pad(k, ((0, 0), (pad, 0), (0, 0), (0, 0)))
    vp = jnp.pad(v, ((0, 0), (pad, 0), (0, 0), (0, 0)))
    qi = jnp.arange(CHUNK)[:, None]
    kj = jnp.arange(BAND)[None, :]
    rel = jnp.clip(qi - kj + pad, -MAX_REL, MAX_REL) + MAX_REL
    bias = rel_bias.astype(jnp.float32)[:, rel]
    scale = ATT_HEAD_DIM ** -0.5

    def one_chunk(c):
        start = c * CHUNK
        qc = lax.dynamic_slice_in_dim(q, start, CHUNK, axis=1)
        kc = lax.dynamic_slice_in_dim(kp, start, BAND, axis=1)
        vc = lax.dynamic_slice_in_dim(vp, start, BAND, axis=1)
        s = jnp.einsum('bqhd,bkhd->bhqk', qc, kc).astype(jnp.float32) * scale + bias
        valid = (start - pad + jnp.arange(BAND)) >= 0
        s = jnp.where(valid[None, None, None, :], s, -1e30)
        p = jax.nn.softmax(s, axis=-1).astype(h.dtype)
        return jnp.einsum('bhqk,bkhd->bqhd', p, vc)

    o = lax.map(one_chunk, jnp.arange(L // CHUNK))
    o = jnp.moveaxis(o, 0, 1).reshape(bsz, L, D_MODEL)
    return (o * jax.nn.silu(g)) @ w_out


def mem_cross_attention(h, mem_n, w_qg, w_kv, w_o):
    bsz, L, _ = h.shape
    q, g = jnp.split(h @ w_qg, 2, axis=-1)
    k, v = jnp.split(mem_n @ w_kv, 2, axis=-1)
    q = q.reshape(bsz, L, XA_HEADS, XA_HEAD_DIM)
    k = k.reshape(bsz, -1, XA_HEADS, XA_HEAD_DIM)
    v = v.reshape(bsz, -1, XA_HEADS, XA_HEAD_DIM)
    s = jnp.einsum('bqhd,bkhd->bhqk', q, k).astype(jnp.float32) * (XA_HEAD_DIM ** -0.5)
    p = jax.nn.softmax(s, axis=-1).astype(h.dtype)
    o = jnp.einsum('bhqk,bkhd->bqhd', p, v).reshape(bsz, L, D_MODEL)
    return (o * jax.nn.silu(g)) @ w_o


def setup_inputs(seed: int = 0) -> dict:
    key = jax.random.key(seed)
    ks = iter(jax.random.split(key, 40))

    def nrm(shape, scale):
        return jax.random.normal(next(ks), shape, jnp.float32) * scale

    def gain(shape):
        return 1.0 + nrm(shape, 0.02)

    lam_im_base = jnp.pi * jnp.arange(S5_STATE, dtype=jnp.float32)
    return {
        'x': nrm((BATCH, SEQ, D_MODEL), 1.0),
        'mem': nrm((BATCH, MEM_LEN, D_MODEL), 1.0),
        'mem_norm_g': gain((D_MODEL,)),
        'ev_norm_g': gain((N_EVEN, D_MODEL)),
        'ev_w_in': nrm((N_EVEN, D_MODEL, EVEN_IN), D_MODEL ** -0.5),
        'ev_s5_lambda_re': -0.5 + nrm((N_EVEN, S5_GROUPS, S5_STATE), 0.01),
        'ev_s5_lambda_im': lam_im_base + nrm((N_EVEN, S5_GROUPS, S5_STATE), 0.01),
        'ev_s5_log_dt': jax.random.uniform(next(ks), (N_EVEN, S5_GROUPS), jnp.float32,
                                           math.log(1e-3), math.log(1e-1)),
        'ev_s5_b_re': nrm((N_EVEN, S5_GROUPS, S5_STATE, S5_GROUP), (2 * S5_GROUP) ** -0.5),
        'ev_s5_b_im': nrm((N_EVEN, S5_GROUPS, S5_STATE, S5_GROUP), (2 * S5_GROUP) ** -0.5),
        'ev_s5_c_re': nrm((N_EVEN, S5_GROUPS, S5_GROUP, S5_STATE), S5_STATE ** -0.5),
        'ev_s5_c_im': nrm((N_EVEN, S5_GROUPS, S5_GROUP, S5_STATE), S5_STATE ** -0.5),
        'ev_s5_d': nrm((N_EVEN, S5_WIDTH), 1.0),
        'ev_s5_glu_w': nrm((N_EVEN, S5_WIDTH, S5_WIDTH), S5_WIDTH ** -0.5),
        'ev_s5_glu_b': nrm((N_EVEN, S5_WIDTH), 0.01),
        'ev_conv_w': nrm((N_EVEN, CONV_KERNEL, CONV_WIDTH), CONV_KERNEL ** -0.5),
        'ev_conv_b': nrm((N_EVEN, CONV_WIDTH), 0.01),
        'ev_conv_ln_g': gain((N_EVEN, CONV_WIDTH)),
        'ev_conv_ln_b': nrm((N_EVEN, CONV_WIDTH), 0.01),
        'ev_w_out': nrm((N_EVEN, D_MODEL, D_MODEL), D_MODEL ** -0.5),
        'od_norm_g': gain((N_ODD, D_MODEL)),
        'od_w_in': nrm((N_ODD, D_MODEL, ODD_IN), D_MODEL ** -0.5),
        'od_rel_bias': nrm((N_ODD, ATT_HEADS, 2 * MAX_REL + 1), 0.1),
        'od_w_out': nrm((N_ODD, D_MODEL, D_MODEL), D_MODEL ** -0.5),
        'xa_norm_g': gain((DEPTH, D_MODEL)),
        'xa_w_qg': nrm((DEPTH, D_MODEL, 2 * D_MODEL), D_MODEL ** -0.5),
        'xa_w_kv': nrm((DEPTH, D_MODEL, 2 * D_MODEL), D_MODEL ** -0.5),
        'xa_w_o': nrm((DEPTH, D_MODEL, D_MODEL), D_MODEL ** -0.5),
        'final_norm_g': gain((D_MODEL,)),
    }


def reference(x, mem, mem_norm_g, ev_norm_g, ev_w_in, ev_s5_lambda_re, ev_s5_lambda_im, ev_s5_log_dt,
              ev_s5_b_re, ev_s5_b_im, ev_s5_c_re, ev_s5_c_im, ev_s5_d, ev_s5_glu_w, ev_s5_glu_b,
              ev_conv_w, ev_conv_b, ev_conv_ln_g, ev_conv_ln_b, ev_w_out,
              od_norm_g, od_w_in, od_rel_bias, od_w_out,
              xa_norm_g, xa_w_qg, xa_w_kv, xa_w_o, final_norm_g):
    mem_n = rms_norm(mem, mem_norm_g)
    for layer in range(DEPTH):
        i = layer // 2
        if layer % 2 == 0:
            x = x + ssm_conv_layer(rms_norm(x, ev_norm_g[i]), ev_w_in[i], ev_s5_lambda_re[i], ev_s5_lambda_im[i],
                                   ev_s5_log_dt[i], ev_s5_b_re[i], ev_s5_b_im[i], ev_s5_c_re[i], ev_s5_c_im[i],
                                   ev_s5_d[i], ev_s5_glu_w[i], ev_s5_glu_b[i], ev_conv_w[i], ev_conv_b[i],
                                   ev_conv_ln_g[i], ev_conv_ln_b[i], ev_w_out[i])
        else:
            x = x + chunk_attention_layer(rms_norm(x, od_norm_g[i]), od_w_in[i], od_rel_bias[i], od_w_out[i])
        x = x + mem_cross_attention(rms_norm(x, xa_norm_g[layer]), mem_n, xa_w_qg[layer], xa_w_kv[layer], xa_w_o[layer])
    return rms_norm(x, final_norm_g)
```

```cpp
#include <hip/hip_runtime.h>
#include <cstdio>
#include <cstdint>
#include <utility>

#ifndef MK_N_LAUNCHES
#define MK_N_LAUNCHES 1
#endif

#define GAS __attribute__((address_space(1)))
#define LAS __attribute__((address_space(3)))
typedef unsigned short bf16;
typedef short bf16x8 __attribute__((ext_vector_type(8)));
typedef float f32x4 __attribute__((ext_vector_type(4)));
typedef float f32x2 __attribute__((ext_vector_type(2)));
typedef unsigned u32x4 __attribute__((ext_vector_type(4)));
typedef unsigned u32x2 __attribute__((ext_vector_type(2)));

constexpr int BATCH = 4, SEQ = 8192, DM = 1024, MTOK = BATCH * SEQ;
constexpr int EVEN_IN = 2560, ODD_IN = 4096, S5W = 512, NGRP = 32, NST = 64, CONVK = 31;
constexpr int MEMLEN = 256, NCHUNK = SEQ / 64;
constexpr float EPS = 1e-6f, LOG2E = 1.4426950408889634f;
constexpr float QSCALE_ATT = 0.125f * LOG2E;
constexpr float QSCALE_XA = 0.0625f * LOG2E;
constexpr int NWAVES = 8;

constexpr size_t MiB = 1u << 20;
constexpr size_t WS_CTL = 0, CTL_ZERO_BYTES = 1 * MiB;
constexpr size_t WS_W_IN0 = 2 * MiB, WS_W_OUT0 = 7 * MiB, WS_W_GLU = 9 * MiB, WS_W_IN1 = 10 * MiB, WS_W_OUT1 = 18 * MiB;
constexpr size_t WS_W_QG = 20 * MiB, WS_W_KV = 28 * MiB, WS_W_O = 36 * MiB, WS_MEMN = 40 * MiB, WS_KV = 42 * MiB;
constexpr size_t WS_PAR = 50 * MiB, WS_RS = 51 * MiB, WS_SC = 53 * MiB;
constexpr size_t WS_XB = 64 * MiB, WS_Y = 128 * MiB, WS_ZS = 192 * MiB, WS_Z = 224 * MiB, WS_END = 480 * MiB;
constexpr int CW_BAR = 4096;

constexpr int RING_BYTES = 131072, LDSCTL_OFF = RING_BYTES, MISC_OFF = LDSCTL_OFF + 320, LDS_BYTES = 147456;

#define RLX_AGENT __ATOMIC_RELAXED, __HIP_MEMORY_SCOPE_AGENT
__device__ __forceinline__ unsigned f2bf(float f) { unsigned u = __builtin_bit_cast(unsigned, f); return (u + 0x7fffu + ((u >> 16) & 1u)) >> 16; }
__device__ __forceinline__ unsigned pk2(float lo, float hi) { return f2bf(lo) | (f2bf(hi) << 16); }
__device__ __forceinline__ float bflo(unsigned w) { return __uint_as_float(w << 16); }
__device__ __forceinline__ float bfhi(unsigned w) { return __uint_as_float(w & 0xffff0000u); }
__device__ __forceinline__ float bf2f(unsigned short b) { return __uint_as_float((unsigned)b << 16); }
__device__ __forceinline__ int opaque0() { int z; asm volatile("v_mov_b32 %0, 0" : "=v"(z)); return z; }
__device__ __forceinline__ float fast_sigmoid(float x) { return __builtin_amdgcn_rcpf(1.0f + __builtin_amdgcn_exp2f(-x * LOG2E)); }
__device__ __forceinline__ float fast_silu(float x) { return x * fast_sigmoid(x); }
__device__ __forceinline__ float gelu_tanh(float y) { const float x = 0.7978845608028654f * (y + 0.044715f * y * y * y); return y * fast_sigmoid(2.0f * x); }
__device__ __forceinline__ float wave_sum(float v) {
#pragma unroll
    for (int o = 1; o < 64; o <<= 1) v += __shfl_xor(v, o);
    return v;
}
__device__ __forceinline__ void unpack8(const u32x4 w, float* f) {
    f[0] = bflo(w.x); f[1] = bfhi(w.x); f[2] = bflo(w.y); f[3] = bfhi(w.y); f[4] = bflo(w.z); f[5] = bfhi(w.z); f[6] = bflo(w.w); f[7] = bfhi(w.w);
}

namespace pg8 {
constexpr int BM = 256, BK = 64, HALF = 128, HTB = HALF * BK * 2, STAGE_BYTES = 8 * HTB, NXCD = 8, WGM = 8;
__host__ __device__ __forceinline__ int lds_byte(int r, int c) { const int st = (r >> 4) * 2 + (c >> 5), rr = r & 15, cc = c & 31, ob = rr * 64 + cc * 2; return st * 1024 + (ob ^ (((ob >> 9) & 1) << 5)); }
__host__ __device__ __forceinline__ void stage_rc(int b, int& R, int& C) { const int st = b / 1024, sb = b % 1024, swz = sb ^ (((sb >> 9) & 1) << 5); R = (st >> 1) * 16 + swz / 64; C = (st & 1) * 32 + (swz % 64) / 2; }
__host__ __device__ __forceinline__ int perm32(int rho) { const int n = rho >> 4, i = rho & 15; return 8 * (i >> 2) + 4 * n + (i & 3); }

struct Unit { int pm, pn; };
struct Gemm { const bf16* A; const bf16* Bt; int M, N, K; };

struct StaticOrder {
    int nM, nN, nwg, G, c;
    __host__ __device__ void init(int M, int N, int G_, int c_) { nM = M / BM; nN = N / BM; nwg = nM * nN; G = G_; c = c_; }
    __host__ __device__ bool next(int i, Unit& u) const {
        const long L = (long)i * G + c; if (L >= nwg) return false;
        int wgid = (int)L; { const int q = nwg / NXCD, r = nwg % NXCD, xcd = wgid % NXCD, off = wgid / NXCD; wgid = (xcd < r ? xcd * (q + 1) : r * (q + 1) + (xcd - r) * q) + off; }
        const int nig = WGM * nN, gid = wgid / nig, fm = gid * WGM, gsz = (nM - fm) < WGM ? (nM - fm) : WGM;
        u.pm = fm + ((wgid % nig) % gsz); u.pn = (wgid % nig) / gsz; return true;
    }
};

__device__ __forceinline__ unsigned cvt_pk_bf16(float lo, float hi) { unsigned r; asm volatile("v_cvt_pk_bf16_f32 %0, %1, %2" : "=v"(r) : "v"(lo), "v"(hi)); return r; }

struct Epi {
    int mode; bool perm;
    bf16* O; int ldc; const float* rs;
    const float* xold; float* xout; bf16* xb; float* rsout;
    const bf16* zs; const bf16* gatep; int gate_ld; const float* gb;
    __device__ __forceinline__ void operator()(const f32x4 (&acc)[2][2][4][2], const Unit& u, int wr, int wc, int fr, int fq) const {
        if (mode == 0) {
            const int row0 = u.pm * BM + wr * 64 + fr, col0 = u.pn * BM + wc * 32 + 8 * fq;
#pragma unroll
            for (int ai = 0; ai < 2; ++ai)
#pragma unroll
                for (int m = 0; m < 4; ++m) {
                    const int row = row0 + ai * HALF + m * 16;
                    float sc = 1.f;
                    if (rs) { const f32x4* p = (const f32x4*)(rs + (size_t)row * 16); const f32x4 a = p[0], b = p[1], c = p[2], d = p[3];
                        const float s = ((a[0] + a[1]) + (a[2] + a[3])) + ((b[0] + b[1]) + (b[2] + b[3])) + ((c[0] + c[1]) + (c[2] + c[3])) + ((d[0] + d[1]) + (d[2] + d[3]));
                        sc = __builtin_amdgcn_rsqf(s * (1.0f / 1024.0f) + EPS); }
                    bf16* rowp = O + (size_t)row * ldc + col0;
#pragma unroll
                    for (int bj = 0; bj < 2; ++bj) { const f32x4 v0 = acc[ai][bj][m][0] * sc, v1 = acc[ai][bj][m][1] * sc;
                        u32x4 w; w.x = cvt_pk_bf16(v0[0], v0[1]); w.y = cvt_pk_bf16(v0[2], v0[3]); w.z = cvt_pk_bf16(v1[0], v1[1]); w.w = cvt_pk_bf16(v1[2], v1[3]);
                        *(u32x4*)(rowp + bj * HALF) = w; }
                }
        } else if (mode == 1) {
            const int row0 = u.pm * BM + wr * 64 + fr, col0 = u.pn * BM + wc * 32 + 4 * fq;
#pragma unroll
            for (int ai = 0; ai < 2; ++ai)
#pragma unroll
                for (int m = 0; m < 4; ++m) {
                    const int row = row0 + ai * HALF + m * 16; const size_t off = (size_t)row * DM + col0; float ss = 0.f;
#pragma unroll
                    for (int bj = 0; bj < 2; ++bj)
#pragma unroll
                        for (int n = 0; n < 2; ++n) { const f32x4 xo = *(const f32x4*)(xold + off + bj * HALF + n * 16); const f32x4 x = xo + acc[ai][bj][m][n];
                            *(f32x4*)(xout + off + bj * HALF + n * 16) = x; ss += (x[0] * x[0] + x[1] * x[1]) + (x[2] * x[2] + x[3] * x[3]);
                            u32x2 w; w.x = cvt_pk_bf16(x[0], x[1]); w.y = cvt_pk_bf16(x[2], x[3]); *(u32x2*)(xb + off + bj * HALF + n * 16) = w; }
                    ss += __shfl_xor(ss, 16); ss += __shfl_xor(ss, 32);
                    if (fq == 0) rsout[(size_t)row * 16 + u.pn * 4 + wc] = ss;
                }
        } else {
            const int row0 = u.pm * BM + wr * 64 + fr, col0 = u.pn * BM + wc * 32 + 8 * fq;
#pragma unroll
            for (int bj = 0; bj < 2; ++bj) {
                const int col = col0 + bj * HALF; const f32x4 b0 = *(const f32x4*)(gb + col), b1 = *(const f32x4*)(gb + col + 4);
#pragma unroll
                for (int ai = 0; ai < 2; ++ai)
#pragma unroll
                    for (int m = 0; m < 4; ++m) {
                        const int row = row0 + ai * HALF + m * 16;
                        const u32x4 zw = *(const u32x4*)(zs + (size_t)row * S5W + col); const u32x4 gw = *(const u32x4*)(gatep + (size_t)row * gate_ld + col);
                        float z[8], g[8], o[8]; unpack8(zw, z); unpack8(gw, g);
                        const f32x4 a0 = acc[ai][bj][m][0] + b0, a1 = acc[ai][bj][m][1] + b1;
#pragma unroll
                        for (int e = 0; e < 4; ++e) { o[e] = z[e] * fast_sigmoid(a0[e]) * fast_silu(g[e]); o[4 + e] = z[4 + e] * fast_sigmoid(a1[e]) * fast_silu(g[4 + e]); }
                        u32x4 w; w.x = cvt_pk_bf16(o[0], o[1]); w.y = cvt_pk_bf16(o[2], o[3]); w.z = cvt_pk_bf16(o[4], o[5]); w.w = cvt_pk_bf16(o[6], o[7]);
                        *(u32x4*)(O + (size_t)row * ldc + col) = w;
                    }
            }
        }
    }
};

__device__ __forceinline__ void gemm_phase(LAS unsigned char* lds, const Gemm g, const StaticOrder& S, const Epi& E) {
    const int tid = threadIdx.x, wid = __builtin_amdgcn_readfirstlane(tid >> 6), lane = tid & 63, wr = wid >> 2, wc = wid & 3, fr = lane & 15, fq = lane >> 4;
    const int K = g.K, nt = K / BK;
    unsigned voffA[2], voffB[2];
#pragma unroll
    for (int i = 0; i < 2; ++i) { int R, C; stage_rc(tid * 16 + i * 8192, R, C); const int Rb = E.perm ? ((R & ~31) + perm32(R & 31)) : R;
        voffA[i] = (unsigned)(R * K + C) * 2u; voffB[i] = (unsigned)(Rb * K + C) * 2u; }
    const size_t kstep = (size_t)(BK * 2);
    const size_t hstep = (size_t)HALF * K * 2;
    const size_t tstep = 2 * hstep;
    const unsigned ldsw = (unsigned)wid * 1024u;
    const int aoff = lds_byte(wr * 64 + fr, fq * 8), boff = lds_byte(wc * 32 + fr, fq * 8);
#define PG8_SA(b, h) (((b) * 2 + (h)) * HTB)
#define PG8_SB(b, h) ((4 + (b) * 2 + (h)) * HTB)
#define PG8_STAGE(bufoff, gbase, voff) do { _Pragma("unroll") for (int _i = 0; _i < 2; ++_i) \
        __builtin_amdgcn_global_load_lds((const unsigned*)((const char*)(gbase) + (voff)[_i]), (LAS unsigned*)(lds + (bufoff) + ldsw + _i * 8192), 16, 0, 0); } while (0)
#define PG8_LDA(dst, b, h) do { _Pragma("unroll") for (int m = 0; m < 4; ++m) _Pragma("unroll") for (int k = 0; k < 2; ++k) dst[m][k] = *(const LAS bf16x8*)(lds + PG8_SA(b, h) + aoff + m * 2048 + k * 1024); } while (0)
#define PG8_LDB(dst, b, h) do { _Pragma("unroll") for (int n = 0; n < 2; ++n) _Pragma("unroll") for (int k = 0; k < 2; ++k) dst[n][k] = *(const LAS bf16x8*)(lds + PG8_SB(b, h) + boff + n * 2048 + k * 1024); } while (0)
#define PG8_MMA(ai, bj, At, Bt) do { __builtin_amdgcn_s_setprio(1); _Pragma("unroll") for (int m = 0; m < 4; ++m) _Pragma("unroll") for (int n = 0; n < 2; ++n) _Pragma("unroll") for (int k = 0; k < 2; ++k) \
        acc[ai][bj][m][n] = __builtin_amdgcn_mfma_f32_16x16x32_bf16(Bt[n][k], At[m][k], acc[ai][bj][m][n], 0, 0, 0); __builtin_amdgcn_s_setprio(0); } while (0)
#define PG8_WAIT_V(n) asm volatile("s_waitcnt vmcnt(" #n ")" ::: "memory")
#define PG8_WAIT_L(n) asm volatile("s_waitcnt lgkmcnt(" #n ")" ::: "memory")
#define PG8_BAR __builtin_amdgcn_s_barrier()
#define PG8_SCHED __builtin_amdgcn_sched_barrier(0)
    Unit cur, nxt; int ui = 0;
    if (!S.next(0, cur)) return;
    f32x4 acc[2][2][4][2];
#pragma unroll
    for (int a = 0; a < 2; ++a)
#pragma unroll
        for (int b = 0; b < 2; ++b)
#pragma unroll
            for (int m = 0; m < 4; ++m)
#pragma unroll
                for (int n = 0; n < 2; ++n) acc[a][b][m][n] = (f32x4){0.f, 0.f, 0.f, 0.f};
    bf16x8 At[4][2], B0[2][2], B1[2][2];
    const char* cA = (const char*)g.A + (size_t)cur.pm * tstep; const char* cB = (const char*)g.Bt + (size_t)cur.pn * tstep;
    PG8_STAGE(PG8_SB(0, 0), cB, voffB); PG8_STAGE(PG8_SB(0, 1), cB + hstep, voffB); PG8_STAGE(PG8_SA(0, 0), cA, voffA); PG8_STAGE(PG8_SA(0, 1), cA + hstep, voffA);
    if (wr == 1) PG8_BAR;
    PG8_WAIT_V(2); PG8_BAR;
    PG8_STAGE(PG8_SB(1, 0), cB + kstep, voffB); PG8_STAGE(PG8_SA(1, 0), cA + kstep, voffA); PG8_STAGE(PG8_SB(1, 1), cB + hstep + kstep, voffB);
    PG8_WAIT_V(6); PG8_BAR;
    for (;;) {
        const bool has_next = S.next(ui + 1, nxt);
        const char* nA = has_next ? (const char*)g.A + (size_t)nxt.pm * tstep : cA; const char* nB = has_next ? (const char*)g.Bt + (size_t)nxt.pn * tstep : cB;
        for (int t = 0; t < nt; t += 2) {
            const bool last = (t == nt - 2);
            const char* a1 = cA + (size_t)(t + 1) * kstep;
            const char* a2 = last ? nA : cA + (size_t)(t + 2) * kstep; const char* b2 = last ? nB : cB + (size_t)(t + 2) * kstep;
            const char* a3 = a2 + kstep; const char* b3 = b2 + kstep;
            PG8_LDB(B0, 0, 0); PG8_LDB(B1, 0, 1); PG8_SCHED; PG8_LDA(At, 0, 0); PG8_STAGE(PG8_SA(1, 1), a1 + hstep, voffA);
            PG8_WAIT_V(8); PG8_WAIT_L(0); PG8_BAR; PG8_MMA(0, 0, At, B0); PG8_MMA(0, 1, At, B1); PG8_BAR; PG8_SCHED;
            PG8_LDA(At, 0, 1); PG8_STAGE(PG8_SB(0, 0), b2, voffB); PG8_STAGE(PG8_SB(0, 1), b2 + hstep, voffB); PG8_STAGE(PG8_SA(0, 0), a2, voffA);
            PG8_WAIT_V(8); PG8_WAIT_L(0); PG8_BAR; PG8_MMA(1, 0, At, B0); PG8_MMA(1, 1, At, B1); PG8_BAR; PG8_SCHED;
            PG8_LDB(B0, 1, 0); PG8_LDB(B1, 1, 1); PG8_SCHED; PG8_LDA(At, 1, 0); PG8_STAGE(PG8_SA(0, 1), a2 + hstep, voffA);
            PG8_WAIT_V(8); PG8_WAIT_L(0); PG8_BAR; PG8_MMA(0, 0, At, B0); PG8_MMA(0, 1, At, B1); PG8_BAR; PG8_SCHED;
            PG8_LDA(At, 1, 1); PG8_STAGE(PG8_SB(1, 0), b3, voffB); PG8_STAGE(PG8_SB(1, 1), b3 + hstep, voffB); PG8_STAGE(PG8_SA(1, 0), a3, voffA);
            PG8_WAIT_V(8); PG8_WAIT_L(0); PG8_BAR; PG8_MMA(1, 0, At, B0); PG8_MMA(1, 1, At, B1); PG8_BAR; PG8_SCHED;
        }
        if (wr == 0) PG8_BAR;
        E(acc, cur, wr, wc, fr, fq);
        if (!has_next) break;
#pragma unroll
        for (int a = 0; a < 2; ++a)
#pragma unroll
            for (int b = 0; b < 2; ++b)
#pragma unroll
                for (int m = 0; m < 4; ++m)
#pragma unroll
                    for (int n = 0; n < 2; ++n) acc[a][b][m][n] = (f32x4){0.f, 0.f, 0.f, 0.f};
        cur = nxt; cA = nA; cB = nB; ++ui;
        if (wr == 1) PG8_BAR;
    }
    PG8_WAIT_V(0);
    PG8_BAR;
#undef PG8_SA
#undef PG8_SB
#undef PG8_STAGE
#undef PG8_LDA
#undef PG8_LDB
#undef PG8_MMA
#undef PG8_WAIT_V
#undef PG8_WAIT_L
#undef PG8_BAR
#undef PG8_SCHED
}
}

#define XB_TMO      128
#define XB_XCNT(j)  (256  + 64 * (j))
#define XB_XSUB(j)  (1280 + 64 * (j))
#define XB_XGEN(j)  (2304 + 64 * (j))
#define XB_TOP      3328
#define XB_TOPGEN   3392
#define XCD_BAR_WORDS 3456
#define XB_SPIN_CAP (1u << 18)
__device__ __forceinline__ unsigned xb_ld(unsigned* p)              { return __hip_atomic_load(p, __ATOMIC_RELAXED, __HIP_MEMORY_SCOPE_AGENT); }
__device__ __forceinline__ unsigned xb_add(unsigned* p, unsigned v) { return __hip_atomic_fetch_add(p, v, __ATOMIC_RELAXED, __HIP_MEMORY_SCOPE_AGENT); }
__device__ __forceinline__ unsigned xb_xcc_id() { return (unsigned)__builtin_amdgcn_s_getreg((3 << 11) | 20) & 0xFu; }
#define XB_SPIN(cond, bar) do { unsigned _sp = 0; while (cond) { __builtin_amdgcn_s_sleep(1); \
    if ((++_sp & 255u) == 0u) { if (xb_ld(&(bar)[XB_TMO])) break; if (_sp > XB_SPIN_CAP) { atomicAdd(&(bar)[XB_TMO], 1u); break; } } } } while (0)
struct XcdBarrier { unsigned* bar; unsigned x; volatile LAS unsigned* st; };
__device__ __forceinline__ XcdBarrier xcd_barrier_post(unsigned* bar, volatile LAS unsigned* st) {
    XcdBarrier b; b.bar = bar; b.x = xb_xcc_id(); b.st = st;
    if (threadIdx.x == 0) (void)xb_add(&bar[XB_XCNT(b.x)], 1u);
    return b;
}
__device__ __forceinline__ void xcd_barrier_complete(unsigned* bar, unsigned x, unsigned& nloc, unsigned& nx) {
    const unsigned G = gridDim.x * gridDim.y * gridDim.z;
    unsigned sum, cnt, mine, sp = 0u;
    for (;;) {
        sum = 0u; cnt = 0u; mine = 0u;
#pragma unroll
        for (unsigned j = 0; j < 16; ++j) { const unsigned c = xb_ld(&bar[XB_XCNT(j)]); sum += c; cnt += (c > 0u) ? 1u : 0u; mine = (j == x) ? c : mine; }
        if (sum == G) break;
        __builtin_amdgcn_s_sleep(1);
        if ((++sp & 255u) == 0u) { if (xb_ld(&bar[XB_TMO])) break; if (sp > XB_SPIN_CAP) { atomicAdd(&bar[XB_TMO], 1u); break; } }
    }
    nloc = mine > 0u ? mine : 1u; nx = cnt > 0u ? cnt : 1u;
}
__device__ __forceinline__ void xcd_barrier(const XcdBarrier& b) {
    asm volatile("s_waitcnt vmcnt(0)" ::: "memory");
    __syncthreads();
    if (threadIdx.x == 0) {
        unsigned* bar = b.bar;
        __builtin_amdgcn_s_waitcnt(0);
        unsigned nloc = b.st[0], nx = b.st[1];
        if (nloc == 0u) { xcd_barrier_complete(bar, b.x, nloc, nx); b.st[0] = nloc; b.st[1] = nx; }
        const unsigned old = xb_add(&bar[XB_XSUB(b.x)], 1u);
        const unsigned gen = old / nloc;
        if (old + 1u == (gen + 1u) * nloc) {
            __builtin_amdgcn_fence(__ATOMIC_RELEASE, "agent");
            asm volatile("s_waitcnt vmcnt(0)" ::: "memory");
            const unsigned og = xb_add(&bar[XB_TOP], 1u);
            const unsigned tg = og / nx;
            if (og + 1u == (tg + 1u) * nx) xb_add(&bar[XB_TOPGEN], 1u);
            else XB_SPIN(xb_ld(&bar[XB_TOPGEN]) == tg, bar);
            __builtin_amdgcn_fence(__ATOMIC_ACQUIRE, "agent");
            xb_add(&bar[XB_XGEN(b.x)], 1u);
            asm volatile("s_waitcnt vmcnt(0)" ::: "memory");
        } else {
            XB_SPIN(xb_ld(&bar[XB_XGEN(b.x)]) == gen, bar);
            __builtin_amdgcn_fence(__ATOMIC_ACQUIRE, "agent");
            asm volatile("s_waitcnt vmcnt(0)" ::: "memory");
        }
    }
    __syncthreads();
}

struct Args { const float* in[29]; float* out; unsigned char* ws; int ph_lo, ph_hi; };
struct Frame {
    LAS unsigned char* lds; volatile LAS unsigned* MISC; unsigned* ctl;
    int tid, lane, wave, vcu, G;
    unsigned char* ws; float* out;
};

__device__ __forceinline__ void p0_transpose_item(const float* W, const float* gain, int K, int N, bf16* WT, int qcols, float qscale, LAS float* scr, int item, int lane) {
    const int nblk = N / 32, kb = item / nblk, nb = item % nblk, k0 = 64 * kb, n0 = 32 * nb;
    const float cs = (n0 < qcols) ? qscale : 1.0f;
#pragma unroll 8
    for (int i = 0; i < 32; ++i) { const int kk = 2 * i + (lane >> 5); const float gk = gain ? gain[k0 + kk] : 1.0f;
        scr[kk * 33 + (lane & 31)] = W[(size_t)(k0 + kk) * N + n0 + (lane & 31)] * (gk * cs); }
    asm volatile("s_waitcnt lgkmcnt(0)" ::: "memory");
    const int c = lane & 7;
#pragma unroll
    for (int j = 0; j < 4; ++j) { const int n = (lane >> 3) + 8 * j; const LAS float* s = scr + (8 * c) * 33 + n;
        u32x4 o; o.x = pk2(s[0 * 33], s[1 * 33]); o.y = pk2(s[2 * 33], s[3 * 33]); o.z = pk2(s[4 * 33], s[5 * 33]); o.w = pk2(s[6 * 33], s[7 * 33]);
        *(u32x4*)(WT + (size_t)(n0 + n) * K + k0 + 8 * c) = o; }
    asm volatile("s_waitcnt lgkmcnt(0)" ::: "memory");
}

__device__ __forceinline__ void p0_prologue(Frame& F, const Args& a) {
    LAS float* scr = (LAS float*)(F.lds + F.wave * 16384);
    const int gw = F.vcu * NWAVES + F.wave, NGW = F.G * NWAVES, lane = F.lane;
    unsigned char* ws = F.ws;
    constexpr int I_IN0 = 16 * 80, I_OUT = 16 * 32, I_GLU = 8 * 16, I_IN1 = 16 * 128, I_QG = 16 * 64, I_KV = 16 * 64, I_O = 16 * 32;
    constexpr int NITEMS = I_IN0 + I_OUT + I_GLU + I_IN1 + I_OUT + 2 * I_QG + 2 * I_KV + 2 * I_O;
    for (int it = gw; it < NITEMS; it += NGW) {
        int r = it;
        if (r < I_IN0) { p0_transpose_item(a.in[4], a.in[3], DM, EVEN_IN, (bf16*)(ws + WS_W_IN0), 0, 1.f, scr, r, lane); continue; } r -= I_IN0;
        if (r < I_OUT) { p0_transpose_item(a.in[19], nullptr, DM, DM, (bf16*)(ws + WS_W_OUT0), 0, 1.f, scr, r, lane); continue; } r -= I_OUT;
        if (r < I_GLU) { p0_transpose_item(a.in[13], nullptr, S5W, S5W, (bf16*)(ws + WS_W_GLU), 0, 1.f, scr, r, lane); continue; } r -= I_GLU;
        if (r < I_IN1) { p0_transpose_item(a.in[21], a.in[20], DM, ODD_IN, (bf16*)(ws + WS_W_IN1), DM, QSCALE_ATT, scr, r, lane); continue; } r -= I_IN1;
        if (r < I_OUT) { p0_transpose_item(a.in[23], nullptr, DM, DM, (bf16*)(ws + WS_W_OUT1), 0, 1.f, scr, r, lane); continue; } r -= I_OUT;
        if (r < 2 * I_QG) { const int l = r / I_QG; p0_transpose_item(a.in[25] + (size_t)l * DM * 2048, a.in[24] + l * DM, DM, 2048, (bf16*)(ws + WS_W_QG) + (size_t)l * 2048 * DM, DM, QSCALE_XA, scr, r % I_QG, lane); continue; } r -= 2 * I_QG;
        if (r < 2 * I_KV) { const int l = r / I_KV; p0_transpose_item(a.in[26] + (size_t)l * DM * 2048, nullptr, DM, 2048, (bf16*)(ws + WS_W_KV) + (size_t)l * 2048 * DM, 0, 1.f, scr, r % I_KV, lane); continue; } r -= 2 * I_KV;
        { const int l = r / I_O; p0_transpose_item(a.in[27] + (size_t)l * DM * DM, nullptr, DM, DM, (bf16*)(ws + WS_W_O) + (size_t)l * DM * DM, 0, 1.f, scr, r % I_O, lane); }
    }
    for (int m = gw; m < BATCH * MEMLEN; m += NGW) {
        const f32x4* xr = (const f32x4*)(a.in[1] + (size_t)m * DM) + lane; const f32x4* gr = (const f32x4*)a.in[2] + lane;
        f32x4 v[4]; float s = 0.f;
#pragma unroll
        for (int j = 0; j < 4; ++j) { v[j] = xr[64 * j]; s += (v[j].x * v[j].x + v[j].y * v[j].y) + (v[j].z * v[j].z + v[j].w * v[j].w); }
        const float rstd = 1.0f / sqrtf(wave_sum(s) * (1.f / DM) + EPS);
        u32x2* o8 = (u32x2*)((bf16*)(ws + WS_MEMN) + (size_t)m * DM) + lane;
#pragma unroll
        for (int j = 0; j < 4; ++j) { const f32x4 g = gr[64 * j]; u32x2 w; w.x = pk2(v[j].x * rstd * g.x, v[j].y * rstd * g.y); w.y = pk2(v[j].z * rstd * g.z, v[j].w * rstd * g.w); o8[64 * j] = w; }
    }
    for (int m = gw; m < MTOK; m += NGW) {
        const f32x4* xr = (const f32x4*)(a.in[0] + (size_t)m * DM) + lane;
        u32x2* o8 = (u32x2*)((bf16*)(ws + WS_XB) + (size_t)m * DM) + lane;
        float* rs = (float*)(ws + WS_RS) + (size_t)m * 16;
#pragma unroll
        for (int j = 0; j < 4; ++j) { const f32x4 v = xr[64 * j]; const float s = wave_sum((v.x * v.x + v.y * v.y) + (v.z * v.z + v.w * v.w));
            u32x2 w; w.x = pk2(v.x, v.y); w.y = pk2(v.z, v.w); o8[64 * j] = w;
            if (lane < 4) rs[4 * j + lane] = (lane == 0) ? s : 0.f; }
    }
    {
        const int gt = (F.vcu * NWAVES + F.wave) * 64 + lane;
        if (gt < NGRP * NST) {
            const int g = gt >> 6;
            const float lr = a.in[5][gt], li = a.in[6][gt], dt = expf(a.in[7][g]);
            const float mag = expf(lr * dt); float sn, cs; sincosf(li * dt, &sn, &cs);
            const float are = mag * cs, aim = mag * sn;
            const float den = lr * lr + li * li, nr = are - 1.0f;
            const float cre = (nr * lr + aim * li) / den, cim = (aim * lr - nr * li) / den;
            float pr = are, pi = aim;
#pragma unroll
            for (int i = 0; i < 6; ++i) { const float t = pr * pr - pi * pi; pi = 2.f * pr * pi; pr = t; }
            ((f32x4*)(ws + WS_PAR))[gt] = (f32x4){are, aim, pr, pi};
            float* bb = (float*)(ws + WS_PAR + 65536) + (size_t)gt * 32;
            const float* br = a.in[8] + (size_t)gt * 16; const float* bi = a.in[9] + (size_t)gt * 16;
#pragma unroll
            for (int c = 0; c < 16; ++c) { bb[c] = cre * br[c] - cim * bi[c]; bb[16 + c] = cre * bi[c] + cim * br[c]; }
        }
    }
}

__device__ __forceinline__ void s5_pass_a(Frame& F) {
    const int gw = F.vcu * NWAVES + F.wave, NGW = F.G * NWAVES, lane = F.lane; const int vz = opaque0();
    const bf16* Z = (const bf16*)(F.ws + WS_Z);
    for (int unit = gw; unit < BATCH * NGRP * NCHUNK; unit += NGW) {
        const int ch = unit & 127, g = (unit >> 7) & 31, b = unit >> 12;
        const f32x4 pa = ((const f32x4*)(F.ws + WS_PAR))[g * 64 + lane];
        float bbr[16], bbi[16];
        { const f32x4* bp = (const f32x4*)((const float*)(F.ws + WS_PAR + 65536) + (size_t)(g * 64 + lane) * 32);
#pragma unroll
          for (int q = 0; q < 4; ++q) { const f32x4 v = bp[q], w = bp[4 + q]; bbr[4 * q] = v.x; bbr[4 * q + 1] = v.y; bbr[4 * q + 2] = v.z; bbr[4 * q + 3] = v.w; bbi[4 * q] = w.x; bbi[4 * q + 1] = w.y; bbi[4 * q + 2] = w.z; bbi[4 * q + 3] = w.w; } }
        float hr = 0.f, hi = 0.f;
        const bf16* up = Z + (size_t)(b * SEQ + ch * 64) * EVEN_IN + g * 16 + vz;
        for (int t = 0; t < 64; ++t) {
            const u32x4 w0 = *(const u32x4*)(up + (size_t)t * EVEN_IN), w1 = *(const u32x4*)(up + (size_t)t * EVEN_IN + 8);
            float u[16]; unpack8(w0, u); unpack8(w1, u + 8);
            float bur = 0.f, bui = 0.f;
#pragma unroll
            for (int c = 0; c < 16; ++c) { bur += bbr[c] * u[c]; bui += bbi[c] * u[c]; }
            const float nr = pa.x * hr - pa.y * hi + bur, ni = pa.x * hi + pa.y * hr + bui; hr = nr; hi = ni;
        }
        ((f32x2*)(F.ws + WS_SC))[(size_t)unit * 64 + lane] = (f32x2){hr, hi};
    }
}
__device__ __forceinline__ void s5_pass_c(Frame& F, const Args& a) {
    const int gw = F.vcu * NWAVES + F.wave, NGW = F.G * NWAVES, lane = F.lane; const int vz = opaque0();
    const bf16* Z = (const bf16*)(F.ws + WS_Z); bf16* ZS = (bf16*)(F.ws + WS_ZS);
    for (int unit = gw; unit < BATCH * NGRP * NCHUNK; unit += NGW) {
        const int ch = unit & 127, g = (unit >> 7) & 31, b = unit >> 12;
        const f32x4 pa = ((const f32x4*)(F.ws + WS_PAR))[g * 64 + lane];
        float bbr[16], bbi[16], cr[16], ci[16];
        { const f32x4* bp = (const f32x4*)((const float*)(F.ws + WS_PAR + 65536) + (size_t)(g * 64 + lane) * 32);
#pragma unroll
          for (int q = 0; q < 4; ++q) { const f32x4 v = bp[q], w = bp[4 + q]; bbr[4 * q] = v.x; bbr[4 * q + 1] = v.y; bbr[4 * q + 2] = v.z; bbr[4 * q + 3] = v.w; bbi[4 * q] = w.x; bbi[4 * q + 1] = w.y; bbi[4 * q + 2] = w.z; bbi[4 * q + 3] = w.w; } }
#pragma unroll
        for (int c = 0; c < 16; ++c) { cr[c] = a.in[10][(size_t)(g * 16 + c) * 64 + lane]; ci[c] = a.in[11][(size_t)(g * 16 + c) * 64 + lane]; }
        const int myc = (lane >> 2) & 15;
        const float dsk = a.in[12][g * 16 + myc];
        float hr = 0.f, hi = 0.f;
        { const f32x2* sc = (const f32x2*)(F.ws + WS_SC) + (size_t)(unit - ch) * 64 + lane + vz;
          for (int j = 0; j < ch; ++j) { const f32x2 s = sc[(size_t)j * 64]; const float nr = pa.z * hr - pa.w * hi + s.x, ni = pa.z * hi + pa.w * hr + s.y; hr = nr; hi = ni; } }
        const size_t row0 = (size_t)(b * SEQ + ch * 64);
        const bf16* up = Z + row0 * EVEN_IN + g * 16 + vz;
        for (int t = 0; t < 64; ++t) {
            const u32x4 w0 = *(const u32x4*)(up + (size_t)t * EVEN_IN), w1 = *(const u32x4*)(up + (size_t)t * EVEN_IN + 8);
            float u[16]; unpack8(w0, u); unpack8(w1, u + 8);
            float bur = 0.f, bui = 0.f;
#pragma unroll
            for (int c = 0; c < 16; ++c) { bur += bbr[c] * u[c]; bui += bbi[c] * u[c]; }
            const float nr = pa.x * hr - pa.y * hi + bur, ni = pa.x * hi + pa.y * hr + bui; hr = nr; hi = ni;
            float v[16];
#pragma unroll
            for (int c = 0; c < 16; ++c) v[c] = cr[c] * hr - ci[c] * hi;
#pragma unroll
            for (int half = 8; half >= 1; half >>= 1) {
                const bool up_ = (lane & (half * 4)) != 0;
#pragma unroll
                for (int i = 0; i < half; ++i) { const float keep = up_ ? v[i + half] : v[i], send = up_ ? v[i] : v[i + half]; v[i] = keep + __shfl_xor(send, half * 4); }
            }
            float y = v[0]; y += __shfl_xor(y, 1); y += __shfl_xor(y, 2);
            const float uc = bf2f(up[(size_t)t * EVEN_IN + myc]);
            y += dsk * uc;
            if ((lane & 3) == 0) ZS[(row0 + t) * S5W + g * 16 + myc] = (bf16)f2bf(gelu_tanh(y));
        }
    }
}

template <int S> __device__ __forceinline__ void conv_tap(float (&out)[64], const float (&w)[CONVK], const bf16* zrow0, int t0) {
    float v = 0.f;
    if (S >= 0 || t0 + S >= 0) { const bf16* zp = zrow0 + (long)S * EVEN_IN; v = bf2f(zp[1024]) * fast_sigmoid(bf2f(zp[1536])); }
#pragma unroll
    for (int k = 0; k < CONVK; ++k) { const int t = S + 30 - k; if (t >= 0 && t < 64) out[t] += w[k] * v; }
}
template <int... I> __device__ __forceinline__ void conv_taps(std::integer_sequence<int, I...>, float (&out)[64], const float (&w)[CONVK], const bf16* zrow0, int t0) {
    (conv_tap<I - 30>(out, w, zrow0, t0), ...);
}
__device__ __forceinline__ void conv_phase(Frame& F, const Args& a) {
    const int c = F.tid, lane = F.lane, wave = F.wave;
    const bf16* Z = (const bf16*)(F.ws + WS_Z); bf16* Y = (bf16*)(F.ws + WS_Y);
    LAS f32x2* red = (LAS f32x2*)F.lds;
    LAS f32x2* stats = (LAS f32x2*)(F.lds + 4096);
    float w[CONVK];
#pragma unroll
    for (int k = 0; k < CONVK; ++k) w[k] = a.in[15][k * 512 + c];
    const float cb = a.in[16][c], lng = a.in[17][c], lnb = a.in[18][c];
    for (int tile = F.vcu; tile < BATCH * NCHUNK; tile += F.G) {
        const int b = tile >> 7, t0 = (tile & 127) * 64; const size_t row0 = (size_t)b * SEQ + t0;
        float out[64];
#pragma unroll
        for (int t = 0; t < 64; ++t) out[t] = cb;
        conv_taps(std::make_integer_sequence<int, 94>{}, out, w, Z + row0 * EVEN_IN + c, t0);
        float r1[64];
#pragma unroll
        for (int t = 0; t < 64; ++t) r1[t] = out[t];
#pragma unroll
        for (int half = 32; half >= 1; half >>= 1) { const bool up_ = (lane & half) != 0;
#pragma unroll
            for (int i = 0; i < half; ++i) { const float keep = up_ ? r1[i + half] : r1[i], send = up_ ? r1[i] : r1[i + half]; r1[i] = keep + __shfl_xor(send, half); } }
        const float s1 = r1[0];
#pragma unroll
        for (int t = 0; t < 64; ++t) r1[t] = out[t] * out[t];
#pragma unroll
        for (int half = 32; half >= 1; half >>= 1) { const bool up_ = (lane & half) != 0;
#pragma unroll
            for (int i = 0; i < half; ++i) { const float keep = up_ ? r1[i + half] : r1[i], send = up_ ? r1[i] : r1[i + half]; r1[i] = keep + __shfl_xor(send, half); } }
        const float s2 = r1[0];
        __syncthreads();
        red[wave * 64 + lane] = (f32x2){s1, s2};
        __syncthreads();
        if (wave == 0) { float q1 = 0.f, q2 = 0.f;
#pragma unroll
            for (int i = 0; i < 8; ++i) { const f32x2 p = red[i * 64 + lane]; q1 += p.x; q2 += p.y; }
            const float mu = q1 * (1.f / 512.f); const float var = fmaxf(q2 * (1.f / 512.f) - mu * mu, 0.f);
            stats[lane] = (f32x2){mu, 1.0f / sqrtf(var + EPS)}; }
        __syncthreads();
#pragma unroll
        for (int t = 0; t < 64; ++t) { const f32x2 st = stats[t]; const float cn = (out[t] - st.x) * st.y * lng + lnb;
            const float gt = bf2f(Z[(row0 + t) * EVEN_IN + 2048 + c]);
            Y[(row0 + t) * DM + 512 + c] = (bf16)f2bf(fast_silu(cn) * fast_silu(gt)); }
    }
}

__device__ __forceinline__ void chunk_attn_simple(Frame& F, const Args& a) {
    const int gw = F.vcu * NWAVES + F.wave, NGW = F.G * NWAVES, lane = F.lane; const int vz = opaque0();
    const bf16* Z = (const bf16*)(F.ws + WS_Z); bf16* Y = (bf16*)(F.ws + WS_Y);
    for (int unit = gw; unit < BATCH * 16 * NCHUNK; unit += NGW) {
        const int ch = unit & 127, h = (unit >> 7) & 15, b = unit >> 11;
        const size_t qrow = (size_t)b * SEQ + ch * 64 + lane;
        float q[64], o[64];
        { const u32x4* qp = (const u32x4*)(Z + qrow * ODD_IN + h * 64);
#pragma unroll
          for (int i = 0; i < 8; ++i) unpack8(qp[i], q + 8 * i); }
#pragma unroll
        for (int d = 0; d < 64; ++d) o[d] = 0.f;
        float m = -1e30f, l = 0.f;
        const int k0 = (ch >= 8) ? (ch - 8) * 64 : 0, k1 = ch * 64 + 63, qpos = ch * 64 + lane;
        const float* bias = a.in[22] + h * 257;
        for (int kp = k0; kp <= k1; ++kp) {
            const bf16* kr = Z + ((size_t)b * SEQ + kp) * ODD_IN + 1024 + h * 64 + vz;
            float s = 0.f;
#pragma unroll
            for (int i = 0; i < 8; ++i) { float kk[8]; unpack8(((const u32x4*)kr)[i], kk);
#pragma unroll
                for (int e = 0; e < 8; ++e) s += q[8 * i + e] * kk[e]; }
            int dist = qpos - kp; dist = dist < -128 ? -128 : (dist > 128 ? 128 : dist);
            s += bias[dist + 128] * LOG2E;
            const float mn = fmaxf(m, s), alpha = __builtin_amdgcn_exp2f(m - mn), p = __builtin_amdgcn_exp2f(s - mn);
            l = l * alpha + p; m = mn;
            const bf16* vr = kr + 1024;
#pragma unroll
            for (int i = 0; i < 8; ++i) { float vv[8]; unpack8(((const u32x4*)vr)[i], vv);
#pragma unroll
                for (int e = 0; e < 8; ++e) o[8 * i + e] = o[8 * i + e] * alpha + p * vv[e]; }
        }
        const float rl = 1.0f / l;
        const u32x4* gp = (const u32x4*)(Z + qrow * ODD_IN + 3072 + h * 64); u32x4* yp = (u32x4*)(Y + qrow * DM + h * 64);
#pragma unroll
        for (int i = 0; i < 8; ++i) { float gg[8]; unpack8(gp[i], gg); float r[8];
#pragma unroll
            for (int e = 0; e < 8; ++e) r[e] = o[8 * i + e] * rl * fast_silu(gg[e]);
            u32x4 wv; wv.x = pk2(r[0], r[1]); wv.y = pk2(r[2], r[3]); wv.z = pk2(r[4], r[5]); wv.w = pk2(r[6], r[7]); yp[i] = wv; }
    }
}

__device__ __forceinline__ void xattn_simple(Frame& F, int layer) {
    const int gw = F.vcu * NWAVES + F.wave, NGW = F.G * NWAVES, lane = F.lane; const int vz = opaque0();
    const bf16* QG = (const bf16*)(F.ws + WS_Z); const bf16* KV = (const bf16*)(F.ws + WS_KV); bf16* Y = (bf16*)(F.ws + WS_Y);
    const int qi = lane >> 2, part = lane & 3;
    for (int unit = gw; unit < BATCH * 4 * (SEQ / 16); unit += NGW) {
        const int qt = unit & 511, hx = (unit >> 9) & 3, b = unit >> 11;
        const size_t qrow = (size_t)b * SEQ + qt * 16 + qi;
        float q[64], o[64];
        { const u32x4* qp = (const u32x4*)(QG + qrow * 2048 + hx * 256 + part * 64);
#pragma unroll
          for (int i = 0; i < 8; ++i) unpack8(qp[i], q + 8 * i); }
#pragma unroll
        for (int d = 0; d < 64; ++d) o[d] = 0.f;
        float m = -1e30f, l = 0.f;
        for (int j = 0; j < MEMLEN; ++j) {
            const bf16* kr = KV + ((size_t)b * MEMLEN + j) * 4096 + layer * 2048 + hx * 256 + part * 64 + vz;
            float s = 0.f;
#pragma unroll
            for (int i = 0; i < 8; ++i) { float kk[8]; unpack8(((const u32x4*)kr)[i], kk);
#pragma unroll
                for (int e = 0; e < 8; ++e) s += q[8 * i + e] * kk[e]; }
            s += __shfl_xor(s, 1); s += __shfl_xor(s, 2);
            const float mn = fmaxf(m, s), alpha = __builtin_amdgcn_exp2f(m - mn), p = __builtin_amdgcn_exp2f(s - mn);
            l = l * alpha + p; m = mn;
            const bf16* vr = kr + 1024;
#pragma unroll
            for (int i = 0; i < 8; ++i) { float vv[8]; unpack8(((const u32x4*)vr)[i], vv);
#pragma unroll
                for (int e = 0; e < 8; ++e) o[8 * i + e] = o[8 * i + e] * alpha + p * vv[e]; }
        }
        const float rl = 1.0f / l;
        const u32x4* gp = (const u32x4*)(QG + qrow * 2048 + 1024 + hx * 256 + part * 64); u32x4* yp = (u32x4*)(Y + qrow * DM + hx * 256 + part * 64);
#pragma unroll
        for (int i = 0; i < 8; ++i) { float gg[8]; unpack8(gp[i], gg); float r[8];
#pragma unroll
            for (int e = 0; e < 8; ++e) r[e] = o[8 * i + e] * rl * fast_silu(gg[e]);
            u32x4 wv; wv.x = pk2(r[0], r[1]); wv.y = pk2(r[2], r[3]); wv.z = pk2(r[4], r[5]); wv.w = pk2(r[6], r[7]); yp[i] = wv; }
    }
}

__device__ __forceinline__ void final_norm(Frame& F, const Args& a) {
    const int gw = F.vcu * NWAVES + F.wave, NGW = F.G * NWAVES, lane = F.lane;
    const f32x4* gr = (const f32x4*)a.in[28] + lane;
    for (int m = gw; m < MTOK; m += NGW) {
        f32x4* xr = (f32x4*)(F.out + (size_t)m * DM) + lane;
        f32x4 v[4]; float s = 0.f;
#pragma unroll
        for (int j = 0; j < 4; ++j) { v[j] = xr[64 * j]; s += (v[j].x * v[j].x + v[j].y * v[j].y) + (v[j].z * v[j].z + v[j].w * v[j].w); }
        const float rstd = 1.0f / sqrtf(wave_sum(s) * (1.f / DM) + EPS);
#pragma unroll
        for (int j = 0; j < 4; ++j) { const f32x4 g = gr[64 * j]; xr[64 * j] = (f32x4){v[j].x * rstd * g.x, v[j].y * rstd * g.y, v[j].z * rstd * g.z, v[j].w * rstd * g.w}; }
    }
}

constexpr int NPH = 17;
__global__ void __launch_bounds__(NWAVES * 64, 2) trunk_fwd(Args args) {
    extern __shared__ __attribute__((aligned(16))) unsigned char lds[];
    Frame F;
    F.lds = (LAS unsigned char*)lds;
    F.MISC = (volatile LAS unsigned*)(F.lds + MISC_OFF);
    F.tid = threadIdx.x; F.lane = F.tid & 63; F.wave = __builtin_amdgcn_readfirstlane(F.tid >> 6);
    F.G = gridDim.x; { const int bx = blockIdx.x; F.vcu = (F.G % 8 == 0) ? (bx % 8) * (F.G / 8) + bx / 8 : bx; }
    F.ws = args.ws; F.out = args.out; F.ctl = (unsigned*)(args.ws + WS_CTL);
    for (int u = F.tid; u < (LDS_BYTES - LDSCTL_OFF) / 4; u += NWAVES * 64) ((LAS unsigned*)(F.lds + LDSCTL_OFF))[u] = 0u;
    __syncthreads();
    const int lo = args.ph_lo, hi = args.ph_hi;
    const bool multi = (hi - lo) > 1;
    XcdBarrier bar; bar.bar = F.ctl + CW_BAR; bar.x = 0; bar.st = nullptr;
    if (multi) bar = xcd_barrier_post(F.ctl + CW_BAR, F.MISC + 8);
#define IN(k) (lo <= (k) && (k) < hi)
#define SEAM(k) do { if (IN(k) && IN((k) + 1)) xcd_barrier(bar); } while (0)
    unsigned char* ws = args.ws;
    bf16* const XB = (bf16*)(ws + WS_XB); bf16* const Y = (bf16*)(ws + WS_Y); bf16* const Z = (bf16*)(ws + WS_Z); bf16* const ZS = (bf16*)(ws + WS_ZS);
    float* const RS = (float*)(ws + WS_RS);
    pg8::Epi E0{}; E0.mode = 0; E0.perm = true;
    pg8::Epi E1{}; E1.mode = 1; E1.perm = false; E1.xout = args.out; E1.xb = XB; E1.rsout = RS; E1.xold = args.out;

    if (IN(0)) { p0_prologue(F, args); } SEAM(0);
    if (IN(1)) {
        { pg8::Gemm g{XB, (const bf16*)(ws + WS_W_IN0), MTOK, EVEN_IN, DM}; pg8::StaticOrder S; S.init(MTOK, EVEN_IN, F.G, (int)blockIdx.x);
          pg8::Epi E = E0; E.O = Z; E.ldc = EVEN_IN; E.rs = RS; pg8::gemm_phase(F.lds, g, S, E); }
        { pg8::Gemm g{(const bf16*)(ws + WS_MEMN), (const bf16*)(ws + WS_W_KV), BATCH * MEMLEN, 4096, DM}; pg8::StaticOrder S; S.init(BATCH * MEMLEN, 4096, F.G, (int)blockIdx.x);
          pg8::Epi E = E0; E.O = (bf16*)(ws + WS_KV); E.ldc = 4096; E.rs = nullptr; pg8::gemm_phase(F.lds, g, S, E); }
    } SEAM(1);
    if (IN(2)) { s5_pass_a(F); conv_phase(F, args); } SEAM(2);
    if (IN(3)) { s5_pass_c(F, args); } SEAM(3);
    if (IN(4)) { pg8::Gemm g{ZS, (const bf16*)(ws + WS_W_GLU), MTOK, S5W, S5W}; pg8::StaticOrder S; S.init(MTOK, S5W, F.G, (int)blockIdx.x);
        pg8::Epi E{}; E.mode = 2; E.perm = true; E.O = Y; E.ldc = DM; E.zs = ZS; E.gatep = Z + 512; E.gate_ld = EVEN_IN; E.gb = args.in[14];
        pg8::gemm_phase(F.lds, g, S, E); } SEAM(4);
    if (IN(5)) { pg8::Gemm g{Y, (const bf16*)(ws + WS_W_OUT0), MTOK, DM, DM}; pg8::StaticOrder S; S.init(MTOK, DM, F.G, (int)blockIdx.x);
        pg8::Epi E = E1; E.xold = args.in[0]; pg8::gemm_phase(F.lds, g, S, E); } SEAM(5);
    if (IN(6)) { pg8::Gemm g{XB, (const bf16*)(ws + WS_W_QG), MTOK, 2048, DM}; pg8::StaticOrder S; S.init(MTOK, 2048, F.G, (int)blockIdx.x);
        pg8::Epi E = E0; E.O = Z; E.ldc = 2048; E.rs = RS; pg8::gemm_phase(F.lds, g, S, E); } SEAM(6);
    if (IN(7)) { xattn_simple(F, 0); } SEAM(7);
    if (IN(8)) { pg8::Gemm g{Y, (const bf16*)(ws + WS_W_O), MTOK, DM, DM}; pg8::StaticOrder S; S.init(MTOK, DM, F.G, (int)blockIdx.x);
        pg8::gemm_phase(F.lds, g, S, E1); } SEAM(8);
    if (IN(9)) { pg8::Gemm g{XB, (const bf16*)(ws + WS_W_IN1), MTOK, ODD_IN, DM}; pg8::StaticOrder S; S.init(MTOK, ODD_IN, F.G, (int)blockIdx.x);
        pg8::Epi E = E0; E.O = Z; E.ldc = ODD_IN; E.rs = RS; pg8::gemm_phase(F.lds, g, S, E); } SEAM(9);
    if (IN(10)) { chunk_attn_simple(F, args); } SEAM(10);
    if (IN(11)) { pg8::Gemm g{Y, (const bf16*)(ws + WS_W_OUT1), MTOK, DM, DM}; pg8::StaticOrder S; S.init(MTOK, DM, F.G, (int)blockIdx.x);
        pg8::gemm_phase(F.lds, g, S, E1); } SEAM(11);
    if (IN(12)) { pg8::Gemm g{XB, (const bf16*)(ws + WS_W_QG) + (size_t)2048 * DM, MTOK, 2048, DM}; pg8::StaticOrder S; S.init(MTOK, 2048, F.G, (int)blockIdx.x);
        pg8::Epi E = E0; E.O = Z; E.ldc = 2048; E.rs = RS; pg8::gemm_phase(F.lds, g, S, E); } SEAM(12);
    if (IN(13)) { xattn_simple(F, 1); } SEAM(13);
    if (IN(14)) { pg8::Gemm g{Y, (const bf16*)(ws + WS_W_O) + (size_t)DM * DM, MTOK, DM, DM}; pg8::StaticOrder S; S.init(MTOK, DM, F.G, (int)blockIdx.x);
        pg8::gemm_phase(F.lds, g, S, E1); } SEAM(14);
    if (IN(15)) { final_norm(F, args); }
#undef IN
#undef SEAM
}

extern "C" void kernel_launch(void* const* d_in, const int* in_sizes, int n_in, void* d_out, int out_size, void* d_ws, size_t ws_size, hipStream_t stream) {
    static int grid = 0;
    if (grid == 0) {
        if (n_in != 29 || out_size != MTOK * DM || ws_size < WS_END) { fprintf(stderr, "kernel_launch: unexpected shapes: n_in %d out %d ws %zu\n", n_in, out_size, ws_size); grid = -1; return; }
        int dev = 0, cus = 0, per_cu = 0;
        if (hipGetDevice(&dev) != hipSuccess || hipDeviceGetAttribute(&cus, hipDeviceAttributeMultiprocessorCount, dev) != hipSuccess) { grid = -1; return; }
        if (hipFuncSetAttribute((const void*)trunk_fwd, hipFuncAttributeMaxDynamicSharedMemorySize, LDS_BYTES) != hipSuccess) { fprintf(stderr, "kernel_launch: hipFuncSetAttribute failed\n"); grid = -1; return; }
        if (hipOccupancyMaxActiveBlocksPerMultiprocessor(&per_cu, (const void*)trunk_fwd, NWAVES * 64, LDS_BYTES) != hipSuccess || per_cu < 1) { fprintf(stderr, "kernel_launch: occupancy query reports %d\n", per_cu); per_cu = 1; }
        (void)hipGetLastError();
        grid = cus;
        if (grid > cus * per_cu) grid = cus * per_cu;
    }
    if (grid < 0) return;
    (void)hipMemsetAsync((char*)d_ws + WS_CTL, 0, CTL_ZERO_BYTES, stream);
    Args a{};
    for (int i = 0; i < 29; ++i) a.in[i] = (const float*)d_in[i];
    a.out = (float*)d_out; a.ws = (unsigned char*)d_ws;
    if (MK_N_LAUNCHES == 1) { a.ph_lo = 0; a.ph_hi = NPH; hipLaunchKernelGGL(trunk_fwd, dim3(grid), dim3(NWAVES * 64), LDS_BYTES, stream, a); }
    else { for (int p = 0; p < 16; ++p) { a.ph_lo = p; a.ph_hi = p + 1; hipLaunchKernelGGL(trunk_fwd, dim3(grid), dim3(NWAVES * 64), LDS_BYTES, stream, a); } }
}
```

```cpp
#include <hip/hip_runtime.h>
#include <cstdio>
#include <cstdint>
#include <utility>

#ifndef MK_N_LAUNCHES
#define MK_N_LAUNCHES 1
#endif

#define GAS __attribute__((address_space(1)))
#define LAS __attribute__((address_space(3)))
typedef unsigned short bf16;
typedef short bf16x8 __attribute__((ext_vector_type(8)));
typedef float f32x4 __attribute__((ext_vector_type(4)));
typedef float f32x2 __attribute__((ext_vector_type(2)));
typedef unsigned u32x4 __attribute__((ext_vector_type(4)));
typedef unsigned u32x2 __attribute__((ext_vector_type(2)));

constexpr int BATCH = 4, SEQ = 8192, DM = 1024, MTOK = BATCH * SEQ;
constexpr int EVEN_IN = 2560, ODD_IN = 4096, S5W = 512, NGRP = 32, NST = 64, CONVK = 31;
constexpr int MEMLEN = 256, NCHUNK = SEQ / 64;
constexpr float EPS = 1e-6f, LOG2E = 1.4426950408889634f;
constexpr float QSCALE_ATT = 0.125f * LOG2E;
constexpr float QSCALE_XA = 0.0625f * LOG2E;
constexpr int NWAVES = 8;

constexpr size_t MiB = 1u << 20;
constexpr size_t WS_CTL = 0, CTL_ZERO_BYTES = 1 * MiB;
constexpr size_t WS_W_IN0 = 2 * MiB, WS_W_OUT0 = 7 * MiB, WS_W_GLU = 9 * MiB, WS_W_IN1 = 10 * MiB, WS_W_OUT1 = 18 * MiB;
constexpr size_t WS_W_QG = 20 * MiB, WS_W_KV = 28 * MiB, WS_W_O = 36 * MiB, WS_MEMN = 40 * MiB, WS_KP = 42 * MiB, WS_VP = 46 * MiB;
constexpr size_t WS_PAR = 50 * MiB, WS_RS = 51 * MiB, WS_SC = 53 * MiB;
constexpr size_t WS_XB = 64 * MiB, WS_Y = 128 * MiB, WS_ZS = 192 * MiB, WS_Z = 224 * MiB, WS_END = 480 * MiB;
constexpr int CW_BAR = 4096;

constexpr int RING_BYTES = 131072, LDSCTL_OFF = RING_BYTES, MISC_OFF = LDSCTL_OFF + 320, LDS_BYTES = 147456;

#define RLX_AGENT __ATOMIC_RELAXED, __HIP_MEMORY_SCOPE_AGENT
__device__ __forceinline__ unsigned f2bf(float f) { unsigned u = __builtin_bit_cast(unsigned, f); return (u + 0x7fffu + ((u >> 16) & 1u)) >> 16; }
__device__ __forceinline__ unsigned pk2(float lo, float hi) { return f2bf(lo) | (f2bf(hi) << 16); }
__device__ __forceinline__ float bflo(unsigned w) { return __uint_as_float(w << 16); }
__device__ __forceinline__ float bfhi(unsigned w) { return __uint_as_float(w & 0xffff0000u); }
__device__ __forceinline__ float bf2f(unsigned short b) { return __uint_as_float((unsigned)b << 16); }
__device__ __forceinline__ int opaque0() { int z; asm volatile("v_mov_b32 %0, 0" : "=v"(z)); return z; }
__device__ __forceinline__ float fast_sigmoid(float x) { return __builtin_amdgcn_rcpf(1.0f + __builtin_amdgcn_exp2f(-x * LOG2E)); }
__device__ __forceinline__ float fast_silu(float x) { return x * fast_sigmoid(x); }
__device__ __forceinline__ float gelu_tanh(float y) { const float x = 0.7978845608028654f * (y + 0.044715f * y * y * y); return y * fast_sigmoid(2.0f * x); }
__device__ __forceinline__ float wave_sum(float v) {
#pragma unroll
    for (int o = 1; o < 64; o <<= 1) v += __shfl_xor(v, o);
    return v;
}
__device__ __forceinline__ void unpack8(const u32x4 w, float* f) {
    f[0] = bflo(w.x); f[1] = bfhi(w.x); f[2] = bflo(w.y); f[3] = bfhi(w.y); f[4] = bflo(w.z); f[5] = bfhi(w.z); f[6] = bflo(w.w); f[7] = bfhi(w.w);
}

namespace pg8 {
constexpr int BM = 256, BK = 64, HALF = 128, HTB = HALF * BK * 2, STAGE_BYTES = 8 * HTB, NXCD = 8, WGM = 8;
__host__ __device__ __forceinline__ int lds_byte(int r, int c) { const int st = (r >> 4) * 2 + (c >> 5), rr = r & 15, cc = c & 31, ob = rr * 64 + cc * 2; return st * 1024 + (ob ^ (((ob >> 9) & 1) << 5)); }
__host__ __device__ __forceinline__ void stage_rc(int b, int& R, int& C) { const int st = b / 1024, sb = b % 1024, swz = sb ^ (((sb >> 9) & 1) << 5); R = (st >> 1) * 16 + swz / 64; C = (st & 1) * 32 + (swz % 64) / 2; }
__host__ __device__ __forceinline__ int perm32(int rho) { const int n = rho >> 4, i = rho & 15; return 8 * (i >> 2) + 4 * n + (i & 3); }

struct Unit { int pm, pn; };
struct Gemm { const bf16* A; const bf16* Bt; int M, N, K; };

struct StaticOrder {
    int nM, nN, nwg, G, c;
    __host__ __device__ void init(int M, int N, int G_, int c_) { nM = M / BM; nN = N / BM; nwg = nM * nN; G = G_; c = c_; }
    __host__ __device__ bool next(int i, Unit& u) const {
        const long L = (long)i * G + c; if (L >= nwg) return false;
        int wgid = (int)L; { const int q = nwg / NXCD, r = nwg % NXCD, xcd = wgid % NXCD, off = wgid / NXCD; wgid = (xcd < r ? xcd * (q + 1) : r * (q + 1) + (xcd - r) * q) + off; }
        const int nig = WGM * nN, gid = wgid / nig, fm = gid * WGM, gsz = (nM - fm) < WGM ? (nM - fm) : WGM;
        u.pm = fm + ((wgid % nig) % gsz); u.pn = (wgid % nig) / gsz; return true;
    }
};

__device__ __forceinline__ unsigned cvt_pk_bf16(float lo, float hi) { unsigned r; asm volatile("v_cvt_pk_bf16_f32 %0, %1, %2" : "=v"(r) : "v"(lo), "v"(hi)); return r; }

struct Epi {
    int mode; bool perm;
    bf16* O; int ldc; const float* rs;
    const float* xold; float* xout; bf16* xb; float* rsout;
    const bf16* zs; const bf16* gatep; int gate_ld; const float* gb;
    __device__ __forceinline__ void operator()(const f32x4 (&acc)[2][2][4][2], const Unit& u, int wr, int wc, int fr, int fq) const {
        if (mode == 0) {
            const int row0 = u.pm * BM + wr * 64 + fr, col0 = u.pn * BM + wc * 32 + 8 * fq;
#pragma unroll
            for (int ai = 0; ai < 2; ++ai)
#pragma unroll
                for (int m = 0; m < 4; ++m) {
                    const int row = row0 + ai * HALF + m * 16;
                    float sc = 1.f;
                    if (rs) { const f32x4* p = (const f32x4*)(rs + (size_t)row * 16); const f32x4 a = p[0], b = p[1], c = p[2], d = p[3];
                        const float s = ((a[0] + a[1]) + (a[2] + a[3])) + ((b[0] + b[1]) + (b[2] + b[3])) + ((c[0] + c[1]) + (c[2] + c[3])) + ((d[0] + d[1]) + (d[2] + d[3]));
                        sc = __builtin_amdgcn_rsqf(s * (1.0f / 1024.0f) + EPS); }
                    bf16* rowp = O + (size_t)row * ldc + col0;
#pragma unroll
                    for (int bj = 0; bj < 2; ++bj) { const f32x4 v0 = acc[ai][bj][m][0] * sc, v1 = acc[ai][bj][m][1] * sc;
                        u32x4 w; w.x = cvt_pk_bf16(v0[0], v0[1]); w.y = cvt_pk_bf16(v0[2], v0[3]); w.z = cvt_pk_bf16(v1[0], v1[1]); w.w = cvt_pk_bf16(v1[2], v1[3]);
                        *(u32x4*)(rowp + bj * HALF) = w; }
                }
        } else if (mode == 1) {
            const int row0 = u.pm * BM + wr * 64 + fr, col0 = u.pn * BM + wc * 32 + 4 * fq;
#pragma unroll
            for (int ai = 0; ai < 2; ++ai)
#pragma unroll
                for (int m = 0; m < 4; ++m) {
                    const int row = row0 + ai * HALF + m * 16; const size_t off = (size_t)row * DM + col0; float ss = 0.f;
#pragma unroll
                    for (int bj = 0; bj < 2; ++bj)
#pragma unroll
                        for (int n = 0; n < 2; ++n) { const f32x4 xo = *(const f32x4*)(xold + off + bj * HALF + n * 16); const f32x4 x = xo + acc[ai][bj][m][n];
                            *(f32x4*)(xout + off + bj * HALF + n * 16) = x; ss += (x[0] * x[0] + x[1] * x[1]) + (x[2] * x[2] + x[3] * x[3]);
                            u32x2 w; w.x = cvt_pk_bf16(x[0], x[1]); w.y = cvt_pk_bf16(x[2], x[3]); *(u32x2*)(xb + off + bj * HALF + n * 16) = w; }
                    ss += __shfl_xor(ss, 16); ss += __shfl_xor(ss, 32);
                    if (fq == 0) rsout[(size_t)row * 16 + u.pn * 4 + wc] = ss;
                }
        } else if (mode == 5) {
            const int row0 = u.pm * BM + wr * 64 + fr, col0 = u.pn * BM + wc * 32 + 8 * fq;
            const int quarter = u.pn >> 2; bf16* const Oq = O + (size_t)quarter * ((size_t)MTOK * 1024);
#pragma unroll
            for (int ai = 0; ai < 2; ++ai)
#pragma unroll
                for (int m = 0; m < 4; ++m) {
                    const int row = row0 + ai * HALF + m * 16;
                    float sc;
                    { const f32x4* p = (const f32x4*)(rs + (size_t)row * 16); const f32x4 a = p[0], b = p[1], c = p[2], d = p[3];
                      const float s = ((a[0] + a[1]) + (a[2] + a[3])) + ((b[0] + b[1]) + (b[2] + b[3])) + ((c[0] + c[1]) + (c[2] + c[3])) + ((d[0] + d[1]) + (d[2] + d[3]));
                      sc = __builtin_amdgcn_rsqf(s * (1.0f / 1024.0f) + EPS); }
                    const int bb = row >> 13, tt = row & 8191, chunk = tt >> 6, key = tt & 63;
#pragma unroll
                    for (int bj = 0; bj < 2; ++bj) { const int cc = (col0 + bj * HALF) & 1023, h = cc >> 6, dc = (cc & 63) >> 3;
                        const f32x4 v0 = acc[ai][bj][m][0] * sc, v1 = acc[ai][bj][m][1] * sc;
                        u32x4 w; w.x = cvt_pk_bf16(v0[0], v0[1]); w.y = cvt_pk_bf16(v0[2], v0[3]); w.z = cvt_pk_bf16(v1[0], v1[1]); w.w = cvt_pk_bf16(v1[2], v1[3]);
                        size_t off;
                        if (quarter == 1) off = ((size_t)(((bb * 16 + h) * 128 + chunk) * 8 + dc) * 64 + key) * 8;
                        else if (quarter == 2) off = (size_t)((bb * 16 + h) * 128 + chunk) * 4096 + key * 64 + ((dc ^ (((key >> 1) & 1) << 2)) * 8);
                        else off = (size_t)row * 1024 + cc;
                        *(u32x4*)(Oq + off) = w; }
                }
        } else if (mode == 3) {
            const int row0 = u.pm * BM + wr * 64 + fr, col0 = u.pn * BM + wc * 32 + 8 * fq;
#pragma unroll
            for (int ai = 0; ai < 2; ++ai)
#pragma unroll
                for (int m = 0; m < 4; ++m) {
                    const int row = row0 + ai * HALF + m * 16, b = row >> 8, key = row & 255;
#pragma unroll
                    for (int bj = 0; bj < 2; ++bj) { const int col = col0 + bj * HALF, l = col >> 10, hx = (col >> 8) & 3, dc = (col & 255) >> 3;
                        const f32x4 v0 = acc[ai][bj][m][0], v1 = acc[ai][bj][m][1];
                        u32x4 w; w.x = cvt_pk_bf16(v0[0], v0[1]); w.y = cvt_pk_bf16(v0[2], v0[3]); w.z = cvt_pk_bf16(v1[0], v1[1]); w.w = cvt_pk_bf16(v1[2], v1[3]);
                        *(u32x4*)(O + ((size_t)((((l * 4 + b) * 4 + hx) * 32 + dc) * 256 + key)) * 8) = w; }
                }
        } else if (mode == 4) {
            const int row0 = u.pm * BM + wr * 64 + fr, col0 = u.pn * BM + wc * 32 + 8 * fq;
#pragma unroll
            for (int ai = 0; ai < 2; ++ai)
#pragma unroll
                for (int m = 0; m < 4; ++m) {
                    const int row = row0 + ai * HALF + m * 16, l = row >> 10, hx = (row >> 8) & 3, d = row & 255;
#pragma unroll
                    for (int bj = 0; bj < 2; ++bj) { const int col = col0 + bj * HALF, b = col >> 8, kg = (col & 255) >> 2;
                        const f32x4 v0 = acc[ai][bj][m][0], v1 = acc[ai][bj][m][1];
                        u32x2 w0, w1; w0.x = cvt_pk_bf16(v0[0], v0[1]); w0.y = cvt_pk_bf16(v0[2], v0[3]); w1.x = cvt_pk_bf16(v1[0], v1[1]); w1.y = cvt_pk_bf16(v1[2], v1[3]);
                        bf16* p = O + ((size_t)((((l * 4 + b) * 4 + hx) * 64 + kg) * 256 + d)) * 4;
                        *(u32x2*)p = w0; *(u32x2*)(p + 256 * 4) = w1; }
                }
        } else {
            const int row0 = u.pm * BM + wr * 64 + fr, col0 = u.pn * BM + wc * 32 + 8 * fq;
#pragma unroll
            for (int bj = 0; bj < 2; ++bj) {
                const int col = col0 + bj * HALF; const f32x4 b0 = *(const f32x4*)(gb + col), b1 = *(const f32x4*)(gb + col + 4);
#pragma unroll
                for (int ai = 0; ai < 2; ++ai)
#pragma unroll
                    for (int m = 0; m < 4; ++m) {
                        const int row = row0 + ai * HALF + m * 16;
                        const u32x4 zw = *(const u32x4*)(zs + (size_t)row * S5W + col); const u32x4 gw = *(const u32x4*)(gatep + (size_t)row * gate_ld + col);
                        float z[8], g[8], o[8]; unpack8(zw, z); unpack8(gw, g);
                        const f32x4 a0 = acc[ai][bj][m][0] + b0, a1 = acc[ai][bj][m][1] + b1;
#pragma unroll
                        for (int e = 0; e < 4; ++e) { o[e] = z[e] * fast_sigmoid(a0[e]) * fast_silu(g[e]); o[4 + e] = z[4 + e] * fast_sigmoid(a1[e]) * fast_silu(g[4 + e]); }
                        u32x4 w; w.x = cvt_pk_bf16(o[0], o[1]); w.y = cvt_pk_bf16(o[2], o[3]); w.z = cvt_pk_bf16(o[4], o[5]); w.w = cvt_pk_bf16(o[6], o[7]);
                        *(u32x4*)(O + (size_t)row * ldc + col) = w;
                    }
            }
        }
    }
};

__device__ __forceinline__ void gemm_phase(LAS unsigned char* lds, const Gemm g, const StaticOrder& S, const Epi& E) {
    const int tid = threadIdx.x, wid = __builtin_amdgcn_readfirstlane(tid >> 6), lane = tid & 63, wr = wid >> 2, wc = wid & 3, fr = lane & 15, fq = lane >> 4;
    const int K = g.K, nt = K / BK;
    unsigned voffA[2], voffB[2];
#pragma unroll
    for (int i = 0; i < 2; ++i) { int R, C; stage_rc(tid * 16 + i * 8192, R, C); const int Rb = E.perm ? ((R & ~31) + perm32(R & 31)) : R;
        voffA[i] = (unsigned)(R * K + C) * 2u; voffB[i] = (unsigned)(Rb * K + C) * 2u; }
    const size_t kstep = (size_t)(BK * 2);
    const size_t hstep = (size_t)HALF * K * 2;
    const size_t tstep = 2 * hstep;
    const unsigned ldsw = (unsigned)wid * 1024u;
    const int aoff = lds_byte(wr * 64 + fr, fq * 8), boff = lds_byte(wc * 32 + fr, fq * 8);
#define PG8_SA(b, h) (((b) * 2 + (h)) * HTB)
#define PG8_SB(b, h) ((4 + (b) * 2 + (h)) * HTB)
#define PG8_STAGE(bufoff, gbase, voff) do { _Pragma("unroll") for (int _i = 0; _i < 2; ++_i) \
        __builtin_amdgcn_global_load_lds((const unsigned*)((const char*)(gbase) + (voff)[_i]), (LAS unsigned*)(lds + (bufoff) + ldsw + _i * 8192), 16, 0, 0); } while (0)
#define PG8_LDA(dst, b, h) do { _Pragma("unroll") for (int m = 0; m < 4; ++m) _Pragma("unroll") for (int k = 0; k < 2; ++k) dst[m][k] = *(const LAS bf16x8*)(lds + PG8_SA(b, h) + aoff + m * 2048 + k * 1024); } while (0)
#define PG8_LDB(dst, b, h) do { _Pragma("unroll") for (int n = 0; n < 2; ++n) _Pragma("unroll") for (int k = 0; k < 2; ++k) dst[n][k] = *(const LAS bf16x8*)(lds + PG8_SB(b, h) + boff + n * 2048 + k * 1024); } while (0)
#define PG8_MMA(ai, bj, At, Bt) do { __builtin_amdgcn_s_setprio(1); _Pragma("unroll") for (int m = 0; m < 4; ++m) _Pragma("unroll") for (int n = 0; n < 2; ++n) _Pragma("unroll") for (int k = 0; k < 2; ++k) \
        acc[ai][bj][m][n] = __builtin_amdgcn_mfma_f32_16x16x32_bf16(Bt[n][k], At[m][k], acc[ai][bj][m][n], 0, 0, 0); __builtin_amdgcn_s_setprio(0); } while (0)
#define PG8_WAIT_V(n) asm volatile("s_waitcnt vmcnt(" #n ")" ::: "memory")
#define PG8_WAIT_L(n) asm volatile("s_waitcnt lgkmcnt(" #n ")" ::: "memory")
#define PG8_BAR __builtin_amdgcn_s_barrier()
#define PG8_SCHED __builtin_amdgcn_sched_barrier(0)
    Unit cur, nxt; int ui = 0;
    if (!S.next(0, cur)) return;
    f32x4 acc[2][2][4][2];
#pragma unroll
    for (int a = 0; a < 2; ++a)
#pragma unroll
        for (int b = 0; b < 2; ++b)
#pragma unroll
            for (int m = 0; m < 4; ++m)
#pragma unroll
                for (int n = 0; n < 2; ++n) acc[a][b][m][n] = (f32x4){0.f, 0.f, 0.f, 0.f};
    bf16x8 At[4][2], B0[2][2], B1[2][2];
    const char* cA = (const char*)g.A + (size_t)cur.pm * tstep; const char* cB = (const char*)g.Bt + (size_t)cur.pn * tstep;
    PG8_STAGE(PG8_SB(0, 0), cB, voffB); PG8_STAGE(PG8_SB(0, 1), cB + hstep, voffB); PG8_STAGE(PG8_SA(0, 0), cA, voffA); PG8_STAGE(PG8_SA(0, 1), cA + hstep, voffA);
    if (wr == 1) PG8_BAR;
    PG8_WAIT_V(2); PG8_BAR;
    PG8_STAGE(PG8_SB(1, 0), cB + kstep, voffB); PG8_STAGE(PG8_SA(1, 0), cA + kstep, voffA); PG8_STAGE(PG8_SB(1, 1), cB + hstep + kstep, voffB);
    PG8_WAIT_V(6); PG8_BAR;
    for (;;) {
        const bool has_next = S.next(ui + 1, nxt);
        const char* nA = has_next ? (const char*)g.A + (size_t)nxt.pm * tstep : cA; const char* nB = has_next ? (const char*)g.Bt + (size_t)nxt.pn * tstep : cB;
        for (int t = 0; t < nt; t += 2) {
            const bool last = (t == nt - 2);
            const char* a1 = cA + (size_t)(t + 1) * kstep;
            const char* a2 = last ? nA : cA + (size_t)(t + 2) * kstep; const char* b2 = last ? nB : cB + (size_t)(t + 2) * kstep;
            const char* a3 = a2 + kstep; const char* b3 = b2 + kstep;
            PG8_LDB(B0, 0, 0); PG8_LDB(B1, 0, 1); PG8_SCHED; PG8_LDA(At, 0, 0); PG8_STAGE(PG8_SA(1, 1), a1 + hstep, voffA);
            PG8_WAIT_V(8); PG8_WAIT_L(0); PG8_BAR; PG8_MMA(0, 0, At, B0); PG8_MMA(0, 1, At, B1); PG8_BAR; PG8_SCHED;
            PG8_LDA(At, 0, 1); PG8_STAGE(PG8_SB(0, 0), b2, voffB); PG8_STAGE(PG8_SB(0, 1), b2 + hstep, voffB); PG8_STAGE(PG8_SA(0, 0), a2, voffA);
            PG8_WAIT_V(8); PG8_WAIT_L(0); PG8_BAR; PG8_MMA(1, 0, At, B0); PG8_MMA(1, 1, At, B1); PG8_BAR; PG8_SCHED;
            PG8_LDB(B0, 1, 0); PG8_LDB(B1, 1, 1); PG8_SCHED; PG8_LDA(At, 1, 0); PG8_STAGE(PG8_SA(0, 1), a2 + hstep, voffA);
            PG8_WAIT_V(8); PG8_WAIT_L(0); PG8_BAR; PG8_MMA(0, 0, At, B0); PG8_MMA(0, 1, At, B1); PG8_BAR; PG8_SCHED;
            PG8_LDA(At, 1, 1); PG8_STAGE(PG8_SB(1, 0), b3, voffB); PG8_STAGE(PG8_SB(1, 1), b3 + hstep, voffB); PG8_STAGE(PG8_SA(1, 0), a3, voffA);
            PG8_WAIT_V(8); PG8_WAIT_L(0); PG8_BAR; PG8_MMA(1, 0, At, B0); PG8_MMA(1, 1, At, B1); PG8_BAR; PG8_SCHED;
        }
        if (wr == 0) PG8_BAR;
        E(acc, cur, wr, wc, fr, fq);
        if (!has_next) break;
#pragma unroll
        for (int a = 0; a < 2; ++a)
#pragma unroll
            for (int b = 0; b < 2; ++b)
#pragma unroll
                for (int m = 0; m < 4; ++m)
#pragma unroll
                    for (int n = 0; n < 2; ++n) acc[a][b][m][n] = (f32x4){0.f, 0.f, 0.f, 0.f};
        cur = nxt; cA = nA; cB = nB; ++ui;
        if (wr == 1) PG8_BAR;
    }
    PG8_WAIT_V(0);
    PG8_BAR;
#undef PG8_SA
#undef PG8_SB
#undef PG8_STAGE
#undef PG8_LDA
#undef PG8_LDB
#undef PG8_MMA
#undef PG8_WAIT_V
#undef PG8_WAIT_L
#undef PG8_BAR
#undef PG8_SCHED
}
}

#define XB_TMO      128
#define XB_XCNT(j)  (256  + 64 * (j))
#define XB_XSUB(j)  (1280 + 64 * (j))
#define XB_XGEN(j)  (2304 + 64 * (j))
#define XB_TOP      3328
#define XB_TOPGEN   3392
#define XCD_BAR_WORDS 3456
#define XB_SPIN_CAP (1u << 18)
__device__ __forceinline__ unsigned xb_ld(unsigned* p)              { return __hip_atomic_load(p, __ATOMIC_RELAXED, __HIP_MEMORY_SCOPE_AGENT); }
__device__ __forceinline__ unsigned xb_add(unsigned* p, unsigned v) { return __hip_atomic_fetch_add(p, v, __ATOMIC_RELAXED, __HIP_MEMORY_SCOPE_AGENT); }
__device__ __forceinline__ unsigned xb_xcc_id() { return (unsigned)__builtin_amdgcn_s_getreg((3 << 11) | 20) & 0xFu; }
#define XB_SPIN(cond, bar) do { unsigned _sp = 0; while (cond) { __builtin_amdgcn_s_sleep(1); \
    if ((++_sp & 255u) == 0u) { if (xb_ld(&(bar)[XB_TMO])) break; if (_sp > XB_SPIN_CAP) { atomicAdd(&(bar)[XB_TMO], 1u); break; } } } } while (0)
struct XcdBarrier { unsigned* bar; unsigned x; volatile LAS unsigned* st; };
__device__ __forceinline__ XcdBarrier xcd_barrier_post(unsigned* bar, volatile LAS unsigned* st) {
    XcdBarrier b; b.bar = bar; b.x = xb_xcc_id(); b.st = st;
    if (threadIdx.x == 0) (void)xb_add(&bar[XB_XCNT(b.x)], 1u);
    return b;
}
__device__ __forceinline__ void xcd_barrier_complete(unsigned* bar, unsigned x, unsigned& nloc, unsigned& nx) {
    const unsigned G = gridDim.x * gridDim.y * gridDim.z;
    unsigned sum, cnt, mine, sp = 0u;
    for (;;) {
        sum = 0u; cnt = 0u; mine = 0u;
#pragma unroll
        for (unsigned j = 0; j < 16; ++j) { const unsigned c = xb_ld(&bar[XB_XCNT(j)]); sum += c; cnt += (c > 0u) ? 1u : 0u; mine = (j == x) ? c : mine; }
        if (sum == G) break;
        __builtin_amdgcn_s_sleep(1);
        if ((++sp & 255u) == 0u) { if (xb_ld(&bar[XB_TMO])) break; if (sp > XB_SPIN_CAP) { atomicAdd(&bar[XB_TMO], 1u); break; } }
    }
    nloc = mine > 0u ? mine : 1u; nx = cnt > 0u ? cnt : 1u;
}
__device__ __forceinline__ void xcd_barrier(const XcdBarrier& b) {
    asm volatile("s_waitcnt vmcnt(0)" ::: "memory");
    __syncthreads();
    if (threadIdx.x == 0) {
        unsigned* bar = b.bar;
        __builtin_amdgcn_s_waitcnt(0);
        unsigned nloc = b.st[0], nx = b.st[1];
        if (nloc == 0u) { xcd_barrier_complete(bar, b.x, nloc, nx); b.st[0] = nloc; b.st[1] = nx; }
        const unsigned old = xb_add(&bar[XB_XSUB(b.x)], 1u);
        const unsigned gen = old / nloc;
        if (old + 1u == (gen + 1u) * nloc) {
            __builtin_amdgcn_fence(__ATOMIC_RELEASE, "agent");
            asm volatile("s_waitcnt vmcnt(0)" ::: "memory");
            const unsigned og = xb_add(&bar[XB_TOP], 1u);
            const unsigned tg = og / nx;
            if (og + 1u == (tg + 1u) * nx) xb_add(&bar[XB_TOPGEN], 1u);
            else XB_SPIN(xb_ld(&bar[XB_TOPGEN]) == tg, bar);
            __builtin_amdgcn_fence(__ATOMIC_ACQUIRE, "agent");
            xb_add(&bar[XB_XGEN(b.x)], 1u);
            asm volatile("s_waitcnt vmcnt(0)" ::: "memory");
        } else {
            XB_SPIN(xb_ld(&bar[XB_XGEN(b.x)]) == gen, bar);
            __builtin_amdgcn_fence(__ATOMIC_ACQUIRE, "agent");
            asm volatile("s_waitcnt vmcnt(0)" ::: "memory");
        }
    }
    __syncthreads();
}

struct Args { const float* in[29]; float* out; unsigned char* ws; int ph_lo, ph_hi; };
struct Frame {
    LAS unsigned char* lds; volatile LAS unsigned* MISC; unsigned* ctl;
    int tid, lane, wave, vcu, G;
    unsigned char* ws; float* out;
};

__device__ __forceinline__ void p0_transpose_item(const float* W, const float* gain, int K, int N, bf16* WT, int qcols, float qscale, LAS float* scr, int item, int lane, int kvsplit = 0) {
    const int nblk = N / 32, kb = item / nblk, nb = item % nblk, k0 = 64 * kb, n0 = 32 * nb;
    const float cs = (n0 < qcols) ? qscale : 1.0f;
#pragma unroll 8
    for (int i = 0; i < 32; ++i) { const int kk = 2 * i + (lane >> 5); const float gk = gain ? gain[k0 + kk] : 1.0f;
        scr[kk * 33 + (lane & 31)] = W[(size_t)(k0 + kk) * N + n0 + (lane & 31)] * (gk * cs); }
    asm volatile("s_waitcnt lgkmcnt(0)" ::: "memory");
    const int c = lane & 7;
#pragma unroll
    for (int j = 0; j < 4; ++j) { const int n = (lane >> 3) + 8 * j; const LAS float* s = scr + (8 * c) * 33 + n;
        u32x4 o; o.x = pk2(s[0 * 33], s[1 * 33]); o.y = pk2(s[2 * 33], s[3 * 33]); o.z = pk2(s[4 * 33], s[5 * 33]); o.w = pk2(s[6 * 33], s[7 * 33]);
        const int drow = kvsplit ? ((n0 < 1024) ? (n0 + n) : (n0 + n + 1024)) : (n0 + n);
        *(u32x4*)(WT + (size_t)drow * K + k0 + 8 * c) = o; }
    asm volatile("s_waitcnt lgkmcnt(0)" ::: "memory");
}

__device__ __forceinline__ void p0_prologue(Frame& F, const Args& a) {
    LAS float* scr = (LAS float*)(F.lds + F.wave * 16384);
    const int gw = F.vcu * NWAVES + F.wave, NGW = F.G * NWAVES, lane = F.lane;
    unsigned char* ws = F.ws;
    constexpr int I_IN0 = 16 * 80, I_OUT = 16 * 32, I_GLU = 8 * 16, I_IN1 = 16 * 128, I_QG = 16 * 64, I_KV = 16 * 64, I_O = 16 * 32;
    constexpr int NITEMS = I_IN0 + I_OUT + I_GLU + I_IN1 + I_OUT + 2 * I_QG + 2 * I_KV + 2 * I_O;
    for (int it = gw; it < NITEMS; it += NGW) {
        int r = it;
        if (r < I_IN0) { p0_transpose_item(a.in[4], a.in[3], DM, EVEN_IN, (bf16*)(ws + WS_W_IN0), 0, 1.f, scr, r, lane); continue; } r -= I_IN0;
        if (r < I_OUT) { p0_transpose_item(a.in[19], nullptr, DM, DM, (bf16*)(ws + WS_W_OUT0), 0, 1.f, scr, r, lane); continue; } r -= I_OUT;
        if (r < I_GLU) { p0_transpose_item(a.in[13], nullptr, S5W, S5W, (bf16*)(ws + WS_W_GLU), 0, 1.f, scr, r, lane); continue; } r -= I_GLU;
        if (r < I_IN1) { p0_transpose_item(a.in[21], a.in[20], DM, ODD_IN, (bf16*)(ws + WS_W_IN1), DM, QSCALE_ATT, scr, r, lane); continue; } r -= I_IN1;
        if (r < I_OUT) { p0_transpose_item(a.in[23], nullptr, DM, DM, (bf16*)(ws + WS_W_OUT1), 0, 1.f, scr, r, lane); continue; } r -= I_OUT;
        if (r < 2 * I_QG) { const int l = r / I_QG; p0_transpose_item(a.in[25] + (size_t)l * DM * 2048, a.in[24] + l * DM, DM, 2048, (bf16*)(ws + WS_W_QG) + (size_t)l * 2048 * DM, DM, QSCALE_XA, scr, r % I_QG, lane); continue; } r -= 2 * I_QG;
        if (r < 2 * I_KV) { const int l = r / I_KV; p0_transpose_item(a.in[26] + (size_t)l * DM * 2048, nullptr, DM, 2048, (bf16*)(ws + WS_W_KV) + (size_t)l * 1024 * DM, 0, 1.f, scr, r % I_KV, lane, 1); continue; } r -= 2 * I_KV;
        { const int l = r / I_O; p0_transpose_item(a.in[27] + (size_t)l * DM * DM, nullptr, DM, DM, (bf16*)(ws + WS_W_O) + (size_t)l * DM * DM, 0, 1.f, scr, r % I_O, lane); }
    }
    for (int m = gw; m < BATCH * MEMLEN; m += NGW) {
        const f32x4* xr = (const f32x4*)(a.in[1] + (size_t)m * DM) + lane; const f32x4* gr = (const f32x4*)a.in[2] + lane;
        f32x4 v[4]; float s = 0.f;
#pragma unroll
        for (int j = 0; j < 4; ++j) { v[j] = xr[64 * j]; s += (v[j].x * v[j].x + v[j].y * v[j].y) + (v[j].z * v[j].z + v[j].w * v[j].w); }
        const float rstd = 1.0f / sqrtf(wave_sum(s) * (1.f / DM) + EPS);
        u32x2* o8 = (u32x2*)((bf16*)(ws + WS_MEMN) + (size_t)m * DM) + lane;
#pragma unroll
        for (int j = 0; j < 4; ++j) { const f32x4 g = gr[64 * j]; u32x2 w; w.x = pk2(v[j].x * rstd * g.x, v[j].y * rstd * g.y); w.y = pk2(v[j].z * rstd * g.z, v[j].w * rstd * g.w); o8[64 * j] = w; }
    }
    for (int m = gw; m < MTOK; m += NGW) {
        const f32x4* xr = (const f32x4*)(a.in[0] + (size_t)m * DM) + lane;
        u32x2* o8 = (u32x2*)((bf16*)(ws + WS_XB) + (size_t)m * DM) + lane;
        float* rs = (float*)(ws + WS_RS) + (size_t)m * 16;
#pragma unroll
        for (int j = 0; j < 4; ++j) { const f32x4 v = xr[64 * j]; const float s = wave_sum((v.x * v.x + v.y * v.y) + (v.z * v.z + v.w * v.w));
            u32x2 w; w.x = pk2(v.x, v.y); w.y = pk2(v.z, v.w); o8[64 * j] = w;
            if (lane < 4) rs[4 * j + lane] = (lane == 0) ? s : 0.f; }
    }
    {
        const int gt = (F.vcu * NWAVES + F.wave) * 64 + lane;
        if (gt < NGRP * NST) {
            const int g = gt >> 6;
            const float lr = a.in[5][gt], li = a.in[6][gt], dt = expf(a.in[7][g]);
            const float mag = expf(lr * dt); float sn, cs; sincosf(li * dt, &sn, &cs);
            const float are = mag * cs, aim = mag * sn;
            const float den = lr * lr + li * li, nr = are - 1.0f;
            const float cre = (nr * lr + aim * li) / den, cim = (aim * lr - nr * li) / den;
            float pr = are, pi = aim;
#pragma unroll
            for (int i = 0; i < 6; ++i) { const float t = pr * pr - pi * pi; pi = 2.f * pr * pi; pr = t; }
            ((f32x4*)(ws + WS_PAR))[gt] = (f32x4){are, aim, pr, pi};
            float* bb = (float*)(ws + WS_PAR + 65536) + (size_t)gt * 32;
            const float* br = a.in[8] + (size_t)gt * 16; const float* bi = a.in[9] + (size_t)gt * 16;
#pragma unroll
            for (int c = 0; c < 16; ++c) { bb[c] = cre * br[c] - cim * bi[c]; bb[16 + c] = cre * bi[c] + cim * br[c]; }
        }
    }
}

__device__ __forceinline__ void s5_pass_a(Frame& F) {
    const int gw = F.vcu * NWAVES + F.wave, NGW = F.G * NWAVES, lane = F.lane; const int vz = opaque0();
    const bf16* Z = (const bf16*)(F.ws + WS_Z);
    for (int unit = gw; unit < BATCH * NGRP * NCHUNK; unit += NGW) {
        const int ch = unit & 127, g = (unit >> 7) & 31, b = unit >> 12;
        const f32x4 pa = ((const f32x4*)(F.ws + WS_PAR))[g * 64 + lane];
        float bbr[16], bbi[16];
        { const f32x4* bp = (const f32x4*)((const float*)(F.ws + WS_PAR + 65536) + (size_t)(g * 64 + lane) * 32);
#pragma unroll
          for (int q = 0; q < 4; ++q) { const f32x4 v = bp[q], w = bp[4 + q]; bbr[4 * q] = v.x; bbr[4 * q + 1] = v.y; bbr[4 * q + 2] = v.z; bbr[4 * q + 3] = v.w; bbi[4 * q] = w.x; bbi[4 * q + 1] = w.y; bbi[4 * q + 2] = w.z; bbi[4 * q + 3] = w.w; } }
        float hr = 0.f, hi = 0.f;
        const bf16* up = Z + (size_t)(b * SEQ + ch * 64) * EVEN_IN + g * 16 + vz;
        for (int t = 0; t < 64; ++t) {
            const u32x4 w0 = *(const u32x4*)(up + (size_t)t * EVEN_IN), w1 = *(const u32x4*)(up + (size_t)t * EVEN_IN + 8);
            float u[16]; unpack8(w0, u); unpack8(w1, u + 8);
            float bur = 0.f, bui = 0.f;
#pragma unroll
            for (int c = 0; c < 16; ++c) { bur += bbr[c] * u[c]; bui += bbi[c] * u[c]; }
            const float nr = pa.x * hr - pa.y * hi + bur, ni = pa.x * hi + pa.y * hr + bui; hr = nr; hi = ni;
        }
        ((f32x2*)(F.ws + WS_SC))[(size_t)unit * 64 + lane] = (f32x2){hr, hi};
    }
}
__device__ __forceinline__ void s5_pass_c(Frame& F, const Args& a) {
    const int gw = F.vcu * NWAVES + F.wave, NGW = F.G * NWAVES, lane = F.lane; const int vz = opaque0();
    const bf16* Z = (const bf16*)(F.ws + WS_Z); bf16* ZS = (bf16*)(F.ws + WS_ZS);
    for (int unit = gw; unit < BATCH * NGRP * NCHUNK; unit += NGW) {
        const int ch = unit & 127, g = (unit >> 7) & 31, b = unit >> 12;
        const f32x4 pa = ((const f32x4*)(F.ws + WS_PAR))[g * 64 + lane];
        float bbr[16], bbi[16], cr[16], ci[16];
        { const f32x4* bp = (const f32x4*)((const float*)(F.ws + WS_PAR + 65536) + (size_t)(g * 64 + lane) * 32);
#pragma unroll
          for (int q = 0; q < 4; ++q) { const f32x4 v = bp[q], w = bp[4 + q]; bbr[4 * q] = v.x; bbr[4 * q + 1] = v.y; bbr[4 * q + 2] = v.z; bbr[4 * q + 3] = v.w; bbi[4 * q] = w.x; bbi[4 * q + 1] = w.y; bbi[4 * q + 2] = w.z; bbi[4 * q + 3] = w.w; } }
#pragma unroll
        for (int c = 0; c < 16; ++c) { cr[c] = a.in[10][(size_t)(g * 16 + c) * 64 + lane]; ci[c] = a.in[11][(size_t)(g * 16 + c) * 64 + lane]; }
        const int myc = (lane >> 2) & 15;
        const float dsk = a.in[12][g * 16 + myc];
        float hr = 0.f, hi = 0.f;
        { const f32x2* sc = (const f32x2*)(F.ws + WS_SC) + (size_t)(unit - ch) * 64 + lane + vz;
          for (int j = 0; j < ch; ++j) { const f32x2 s = sc[(size_t)j * 64]; const float nr = pa.z * hr - pa.w * hi + s.x, ni = pa.z * hi + pa.w * hr + s.y; hr = nr; hi = ni; } }
        const size_t row0 = (size_t)(b * SEQ + ch * 64);
        const bf16* up = Z + row0 * EVEN_IN + g * 16 + vz;
        for (int t = 0; t < 64; ++t) {
            const u32x4 w0 = *(const u32x4*)(up + (size_t)t * EVEN_IN), w1 = *(const u32x4*)(up + (size_t)t * EVEN_IN + 8);
            float u[16]; unpack8(w0, u); unpack8(w1, u + 8);
            float bur = 0.f, bui = 0.f;
#pragma unroll
            for (int c = 0; c < 16; ++c) { bur += bbr[c] * u[c]; bui += bbi[c] * u[c]; }
            const float nr = pa.x * hr - pa.y * hi + bur, ni = pa.x * hi + pa.y * hr + bui; hr = nr; hi = ni;
            float v[16];
#pragma unroll
            for (int c = 0; c < 16; ++c) v[c] = cr[c] * hr - ci[c] * hi;
#pragma unroll
            for (int half = 8; half >= 1; half >>= 1) {
                const bool up_ = (lane & (half * 4)) != 0;
#pragma unroll
                for (int i = 0; i < half; ++i) { const float keep = up_ ? v[i + half] : v[i], send = up_ ? v[i] : v[i + half]; v[i] = keep + __shfl_xor(send, half * 4); }
            }
            float y = v[0]; y += __shfl_xor(y, 1); y += __shfl_xor(y, 2);
            const float uc = bf2f(up[(size_t)t * EVEN_IN + myc]);
            y += dsk * uc;
            if ((lane & 3) == 0) ZS[(row0 + t) * S5W + g * 16 + myc] = (bf16)f2bf(gelu_tanh(y));
        }
    }
}

template <int S> __device__ __forceinline__ void conv_tap(float (&out)[64], const float (&w)[CONVK], const bf16* zrow0, int t0) {
    float v = 0.f;
    if (S >= 0 || t0 + S >= 0) { const bf16* zp = zrow0 + (long)S * EVEN_IN; v = bf2f(zp[1024]) * fast_sigmoid(bf2f(zp[1536])); }
#pragma unroll
    for (int k = 0; k < CONVK; ++k) { const int t = S + 30 - k; if (t >= 0 && t < 64) out[t] += w[k] * v; }
}
template <int... I> __device__ __forceinline__ void conv_taps(std::integer_sequence<int, I...>, float (&out)[64], const float (&w)[CONVK], const bf16* zrow0, int t0) {
    (conv_tap<I - 30>(out, w, zrow0, t0), ...);
}
__device__ __forceinline__ void conv_phase(Frame& F, const Args& a) {
    const int c = F.tid, lane = F.lane, wave = F.wave;
    const bf16* Z = (const bf16*)(F.ws + WS_Z); bf16* Y = (bf16*)(F.ws + WS_Y);
    LAS f32x2* red = (LAS f32x2*)F.lds;
    LAS f32x2* stats = (LAS f32x2*)(F.lds + 4096);
    float w[CONVK];
#pragma unroll
    for (int k = 0; k < CONVK; ++k) w[k] = a.in[15][k * 512 + c];
    const float cb = a.in[16][c], lng = a.in[17][c], lnb = a.in[18][c];
    for (int tile = F.vcu; tile < BATCH * NCHUNK; tile += F.G) {
        const int b = tile >> 7, t0 = (tile & 127) * 64; const size_t row0 = (size_t)b * SEQ + t0;
        float out[64];
#pragma unroll
        for (int t = 0; t < 64; ++t) out[t] = cb;
        conv_taps(std::make_integer_sequence<int, 94>{}, out, w, Z + row0 * EVEN_IN + c, t0);
        float r1[64];
#pragma unroll
        for (int t = 0; t < 64; ++t) r1[t] = out[t];
#pragma unroll
        for (int half = 32; half >= 1; half >>= 1) { const bool up_ = (lane & half) != 0;
#pragma unroll
            for (int i = 0; i < half; ++i) { const float keep = up_ ? r1[i + half] : r1[i], send = up_ ? r1[i] : r1[i + half]; r1[i] = keep + __shfl_xor(send, half); } }
        const float s1 = r1[0];
#pragma unroll
        for (int t = 0; t < 64; ++t) r1[t] = out[t] * out[t];
#pragma unroll
        for (int half = 32; half >= 1; half >>= 1) { const bool up_ = (lane & half) != 0;
#pragma unroll
            for (int i = 0; i < half; ++i) { const float keep = up_ ? r1[i + half] : r1[i], send = up_ ? r1[i] : r1[i + half]; r1[i] = keep + __shfl_xor(send, half); } }
        const float s2 = r1[0];
        __syncthreads();
        red[wave * 64 + lane] = (f32x2){s1, s2};
        __syncthreads();
        if (wave == 0) { float q1 = 0.f, q2 = 0.f;
#pragma unroll
            for (int i = 0; i < 8; ++i) { const f32x2 p = red[i * 64 + lane]; q1 += p.x; q2 += p.y; }
            const float mu = q1 * (1.f / 512.f); const float var = fmaxf(q2 * (1.f / 512.f) - mu * mu, 0.f);
            stats[lane] = (f32x2){mu, 1.0f / sqrtf(var + EPS)}; }
        __syncthreads();
#pragma unroll
        for (int t = 0; t < 64; ++t) { const f32x2 st = stats[t]; const float cn = (out[t] - st.x) * st.y * lng + lnb;
            const float gt = bf2f(Z[(row0 + t) * EVEN_IN + 2048 + c]);
            Y[(row0 + t) * DM + 512 + c] = (bf16)f2bf(fast_silu(cn) * fast_silu(gt)); }
    }
}

typedef float f32x16 __attribute__((ext_vector_type(16)));
typedef short s16x4 __attribute__((ext_vector_type(4)));
__device__ __forceinline__ s16x4 tr_read(const LAS unsigned char* p) { return __builtin_bit_cast(s16x4, __builtin_amdgcn_ds_read_tr16_b64_v4i16((LAS s16x4*)p)); }
__device__ __forceinline__ int crow16(int reg, int hi) { return (reg & 3) + 8 * (reg >> 2) + 4 * hi; }
__device__ __forceinline__ void chunk_attn_mfma(Frame& F, const Args& a) {
    const int lane = F.lane, w = F.wave, r = lane & 31, hi = lane >> 5;
    const int hh = w >> 2, cc = (w >> 1) & 1, half = w & 1;
    LAS unsigned char* const lds = F.lds; LAS float* const btab = (LAS float*)(lds + 98304);
    const bf16* ZQ = (const bf16*)(F.ws + WS_Z); const bf16* ZK = ZQ + (size_t)MTOK * 1024; const bf16* ZV = ZK + (size_t)MTOK * 1024; const bf16* ZG = ZV + (size_t)MTOK * 1024;
    bf16* Y = (bf16*)(F.ws + WS_Y);
    const int q4 = (lane & 15) >> 2, p4 = lane & 3, dsel = (lane >> 4) & 1, sw = (q4 >> 1) & 1;
    const int vlane = (4 * hi + q4) * 128 + (2 * dsel + (p4 >> 1)) * 16 + (p4 & 1) * 8;
#define CA_DMA_TILE(trel) do { const int T_ = tbase + (trel); if (T_ >= 0) { _Pragma("unroll") for (int i_ = 0; i_ < 4; ++i_) { const int piece_ = 4 * w + i_, sub_ = piece_ >> 3; \
        const bf16* src_ = ((sub_ < 2) ? ZK : ZV) + (size_t)((b * 16 + 2 * hp + (sub_ & 1)) * 128 + T_) * 4096 + (piece_ & 7) * 512 + lane * 8; \
        __builtin_amdgcn_global_load_lds((const unsigned*)src_, (LAS unsigned*)(lds + ((trel) % 3) * 32768 + piece_ * 1024), 16, 0, 0); } } } while (0)
    for (int u = F.vcu; u < BATCH * 8 * 64; u += F.G) {
        const int cp = u & 63, hp = (u >> 6) & 7, b = u >> 9;
        const int c = 2 * cp + cc, h = 2 * hp + hh, tbase = 2 * cp - 8;
        __syncthreads();
        for (int i = F.tid; i < 2 * 257; i += NWAVES * 64) { const int hs = i / 257, ix = i - hs * 257; btab[hs * 260 + ix] = a.in[22][(2 * hp + hs) * 257 + ix] * LOG2E; }
        const size_t qrow = (size_t)b * SEQ + c * 64 + half * 32 + r;
        bf16x8 qf[4];
#pragma unroll
        for (int s4 = 0; s4 < 4; ++s4) qf[s4] = *(const bf16x8*)(ZQ + qrow * 1024 + h * 64 + 16 * s4 + 8 * hi);
        CA_DMA_TILE(0); CA_DMA_TILE(1);
        __syncthreads();
        const float cfar = btab[hh * 260 + 256];
        float m = 0.f, l = 0.f; bool first = true;
        f32x16 o0, o1, negm;
#pragma unroll
        for (int e = 0; e < 16; ++e) { o0[e] = 0.f; o1[e] = 0.f; negm[e] = cfar; }
#pragma unroll
        for (int s = 0; s < 9; ++s) {
            if (s + 2 <= 9) CA_DMA_TILE(s + 2);
            const int T = tbase + s + cc;
            if (T >= 0) {
                const int bsel = (s + cc) % 3;
                const LAS unsigned char* kb = lds + bsel * 32768 + hh * 8192 + (hi * 64 + r) * 16;
                const LAS unsigned char* vb = lds + bsel * 32768 + 16384 + hh * 8192 + vlane;
                f32x16 p0, p1;
                if (s >= 6) {
                    const int dq = 64 * (8 - s) + half * 32 + r - 4 * hi;
#pragma unroll
                    for (int e = 0; e < 16; ++e) { const int d0 = dq - ((e & 3) + 8 * (e >> 2)); const int i0 = (d0 > 128 ? 128 : d0) + 128, i1 = (d0 - 32 > 128 ? 128 : d0 - 32) + 128;
                        p0[e] = btab[hh * 260 + i0] - m; p1[e] = btab[hh * 260 + i1] - m; }
                } else { p0 = negm; p1 = negm; }
#pragma unroll
                for (int s4 = 0; s4 < 4; ++s4) {
                    const bf16x8 k0 = *(const LAS bf16x8*)(kb + (2 * s4) * 1024), k1 = *(const LAS bf16x8*)(kb + (2 * s4) * 1024 + 512);
                    p0 = __builtin_amdgcn_mfma_f32_32x32x16_bf16(k0, qf[s4], p0, 0, 0, 0);
                    p1 = __builtin_amdgcn_mfma_f32_32x32x16_bf16(k1, qf[s4], p1, 0, 0, 0);
                }
                float rm = fmaxf(p0[0], p1[0]);
#pragma unroll
                for (int e = 1; e < 16; ++e) rm = fmaxf(rm, fmaxf(p0[e], p1[e]));
                rm = fmaxf(rm, __shfl_xor(rm, 32));
                if (first) {
                    m = rm;
#pragma unroll
                    for (int e = 0; e < 16; ++e) { p0[e] -= rm; p1[e] -= rm; negm[e] = cfar - m; }
                    first = false;
                } else if (__any(rm > 0.f)) {
                    const float dl = fmaxf(rm, 0.f), al = __builtin_amdgcn_exp2f(-dl);
                    m += dl; l *= al;
#pragma unroll
                    for (int e = 0; e < 16; ++e) { p0[e] -= dl; p1[e] -= dl; o0[e] *= al; o1[e] *= al; negm[e] = cfar - m; }
                }
                float ps = 0.f;
#pragma unroll
                for (int e = 0; e < 16; ++e) { p0[e] = __builtin_amdgcn_exp2f(p0[e]); p1[e] = __builtin_amdgcn_exp2f(p1[e]); ps += p0[e] + p1[e]; }
                l += ps;
                u32x4 pf[2][2];
#pragma unroll
                for (int s2 = 0; s2 < 2; ++s2) {
                    u32x4 t; t.x = pk2(p0[8 * s2 + 0], p0[8 * s2 + 1]); t.y = pk2(p0[8 * s2 + 2], p0[8 * s2 + 3]); t.z = pk2(p0[8 * s2 + 4], p0[8 * s2 + 5]); t.w = pk2(p0[8 * s2 + 6], p0[8 * s2 + 7]); pf[0][s2] = t;
                    u32x4 v; v.x = pk2(p1[8 * s2 + 0], p1[8 * s2 + 1]); v.y = pk2(p1[8 * s2 + 2], p1[8 * s2 + 3]); v.z = pk2(p1[8 * s2 + 4], p1[8 * s2 + 5]); v.w = pk2(p1[8 * s2 + 6], p1[8 * s2 + 7]); pf[1][s2] = v;
                }
#pragma unroll
                for (int kh = 0; kh < 2; ++kh)
#pragma unroll
                    for (int s2 = 0; s2 < 2; ++s2) {
                        const LAS unsigned char* vk = vb + (32 * kh + 16 * s2) * 128;
                        const s16x4 a0 = tr_read(vk + sw * 64), a1 = tr_read(vk + 8 * 128 + sw * 64);
                        const s16x4 c0 = tr_read(vk + (1 - sw) * 64), c1 = tr_read(vk + 8 * 128 + (1 - sw) * 64);
                        const bf16x8 vf0 = (bf16x8){a0[0], a0[1], a0[2], a0[3], a1[0], a1[1], a1[2], a1[3]};
                        const bf16x8 vf1 = (bf16x8){c0[0], c0[1], c0[2], c0[3], c1[0], c1[1], c1[2], c1[3]};
                        o0 = __builtin_amdgcn_mfma_f32_32x32x16_bf16(vf0, __builtin_bit_cast(bf16x8, pf[kh][s2]), o0, 0, 0, 0);
                        o1 = __builtin_amdgcn_mfma_f32_32x32x16_bf16(vf1, __builtin_bit_cast(bf16x8, pf[kh][s2]), o1, 0, 0, 0);
                    }
            }
            if (s < 8) __syncthreads();
        }
        l += __shfl_xor(l, 32);
        const float rl = 1.0f / l;
        const bf16* gp = ZG + qrow * 1024 + h * 64 + 4 * hi; bf16* yp = Y + qrow * DM + h * 64 + 4 * hi;
#pragma unroll
        for (int i = 0; i < 4; ++i) {
            const u32x2 g0 = *(const u32x2*)(gp + 8 * i), g1 = *(const u32x2*)(gp + 32 + 8 * i);
            u32x2 y0, y1;
            y0.x = pk2(o0[4 * i] * rl * fast_silu(bflo(g0.x)), o0[4 * i + 1] * rl * fast_silu(bfhi(g0.x))); y0.y = pk2(o0[4 * i + 2] * rl * fast_silu(bflo(g0.y)), o0[4 * i + 3] * rl * fast_silu(bfhi(g0.y)));
            y1.x = pk2(o1[4 * i] * rl * fast_silu(bflo(g1.x)), o1[4 * i + 1] * rl * fast_silu(bfhi(g1.x))); y1.y = pk2(o1[4 * i + 2] * rl * fast_silu(bflo(g1.y)), o1[4 * i + 3] * rl * fast_silu(bfhi(g1.y)));
            *(u32x2*)(yp + 8 * i) = y0; *(u32x2*)(yp + 32 + 8 * i) = y1;
        }
    }
#undef CA_DMA_TILE
}

__device__ __forceinline__ void xattn_mfma(Frame& F, int layer) {
    const int lane = F.lane, w = F.wave, r = lane & 31, hi = lane >> 5;
    const bf16* QG = (const bf16*)(F.ws + WS_Z); bf16* Y = (bf16*)(F.ws + WS_Y);
    LAS unsigned char* const lds = F.lds;
#define XA_DMA_K(ds, bufoff) do { _Pragma("unroll") for (int i_ = 0; i_ < 4; ++i_) { const int piece_ = w * 4 + i_; \
        __builtin_amdgcn_global_load_lds((const unsigned*)(kbase + (size_t)(ds) * 16384 + piece_ * 512 + lane * 8), (LAS unsigned*)(lds + (bufoff) + piece_ * 1024), 16, 0, 0); } } while (0)
#define XA_DMA_V(ds, bufoff) do { _Pragma("unroll") for (int i_ = 0; i_ < 4; ++i_) { const int piece_ = w * 4 + i_, p_ = piece_ * 64 + lane, kg_ = p_ >> 5, dp_ = p_ & 31; \
        __builtin_amdgcn_global_load_lds((const unsigned*)(vbase + ((size_t)kg_ * 256 + 64 * (ds) + 2 * dp_) * 4), (LAS unsigned*)(lds + (bufoff) + piece_ * 1024), 16, 0, 0); } } while (0)
    for (int u = F.vcu; u < BATCH * 4 * (SEQ / 256); u += F.G) {
        const int qb = u & 31, hx = (u >> 5) & 3, b = u >> 7;
        const size_t qrow = (size_t)b * SEQ + qb * 256 + w * 32 + r;
        const bf16* qptr = QG + qrow * 2048 + hx * 256 + 8 * hi;
        const bf16* kbase = (const bf16*)(F.ws + WS_KP) + (size_t)((layer * 4 + b) * 4 + hx) * (32 * 256 * 8);
        const bf16* vbase = (const bf16*)(F.ws + WS_VP) + (size_t)((layer * 4 + b) * 4 + hx) * (64 * 256 * 4);
        f32x16 sacc[8];
#pragma unroll
        for (int kt = 0; kt < 8; ++kt)
#pragma unroll
            for (int e = 0; e < 16; ++e) sacc[kt][e] = 0.f;
        bf16x8 qn[4];
#pragma unroll
        for (int s = 0; s < 4; ++s) qn[s] = *(const bf16x8*)(qptr + 16 * s);
        XA_DMA_K(0, 0);
#pragma unroll
        for (int ds = 0; ds < 4; ++ds) {
            __syncthreads();
            bf16x8 qf[4];
#pragma unroll
            for (int s = 0; s < 4; ++s) qf[s] = qn[s];
            if (ds < 3) {
#pragma unroll
                for (int s = 0; s < 4; ++s) qn[s] = *(const bf16x8*)(qptr + 64 * (ds + 1) + 16 * s);
                XA_DMA_K(ds + 1, ((ds + 1) & 1) * 32768);
            } else { XA_DMA_V(0, 0); }
            const LAS unsigned char* kb = lds + (ds & 1) * 32768 + (hi * 256 + r) * 16;
#pragma unroll
            for (int kt = 0; kt < 8; ++kt)
#pragma unroll
                for (int s = 0; s < 4; ++s) {
                    const bf16x8 kf = *(const LAS bf16x8*)(kb + (2 * s * 256 + 32 * kt) * 16);
                    sacc[kt] = __builtin_amdgcn_mfma_f32_32x32x16_bf16(kf, qf[s], sacc[kt], 0, 0, 0);
                }
        }
        float m = sacc[0][0];
#pragma unroll
        for (int kt = 0; kt < 8; ++kt)
#pragma unroll
            for (int e = 0; e < 16; ++e) m = fmaxf(m, sacc[kt][e]);
        m = fmaxf(m, __shfl_xor(m, 32));
        float l = 0.f;
        u32x4 pf[8][2];
#pragma unroll
        for (int kt = 0; kt < 8; ++kt) {
#pragma unroll
            for (int e = 0; e < 16; ++e) { const float p = __builtin_amdgcn_exp2f(sacc[kt][e] - m); sacc[kt][e] = p; l += p; }
#pragma unroll
            for (int s2 = 0; s2 < 2; ++s2) { u32x4 t; t.x = pk2(sacc[kt][8 * s2 + 0], sacc[kt][8 * s2 + 1]); t.y = pk2(sacc[kt][8 * s2 + 2], sacc[kt][8 * s2 + 3]);
                t.z = pk2(sacc[kt][8 * s2 + 4], sacc[kt][8 * s2 + 5]); t.w = pk2(sacc[kt][8 * s2 + 6], sacc[kt][8 * s2 + 7]); pf[kt][s2] = t; }
        }
        l += __shfl_xor(l, 32);
        const float rl = 1.0f / l;
        __builtin_amdgcn_sched_barrier(0);
        const bf16* gp = QG + qrow * 2048 + 1024 + hx * 256 + 4 * hi; bf16* yp = Y + qrow * DM + hx * 256 + 4 * hi;
        u32x2 gq[8][4];
#pragma unroll
        for (int t = 0; t < 8; ++t)
#pragma unroll
            for (int i = 0; i < 4; ++i) gq[t][i] = *(const u32x2*)(gp + 32 * t + 8 * i);
        __builtin_amdgcn_sched_barrier(0);
#pragma unroll
        for (int ds = 0; ds < 4; ++ds) {
            __syncthreads();
            if (ds < 3) XA_DMA_V(ds + 1, ((ds + 1) & 1) * 32768);
            const LAS unsigned char* vb = lds + (ds & 1) * 32768 + (hi * 64 + r) * 8;
#pragma unroll
            for (int dt = 0; dt < 2; ++dt) {
                f32x16 oacc;
#pragma unroll
                for (int e = 0; e < 16; ++e) oacc[e] = 0.f;
#pragma unroll
                for (int kt = 0; kt < 8; ++kt)
#pragma unroll
                    for (int s2 = 0; s2 < 2; ++s2) {
                        const int kg = 8 * kt + 4 * s2;
                        const s16x4 v0 = *(const LAS s16x4*)(vb + (kg * 64 + 32 * dt) * 8), v1 = *(const LAS s16x4*)(vb + ((kg + 2) * 64 + 32 * dt) * 8);
                        const bf16x8 vf = (bf16x8){v0[0], v0[1], v0[2], v0[3], v1[0], v1[1], v1[2], v1[3]};
                        oacc = __builtin_amdgcn_mfma_f32_32x32x16_bf16(vf, __builtin_bit_cast(bf16x8, pf[kt][s2]), oacc, 0, 0, 0);
                    }
                const int t = 2 * ds + dt;
#pragma unroll
                for (int i = 0; i < 4; ++i) {
                    const u32x2 gw = gq[t][i];
                    const float g0 = bflo(gw.x), g1 = bfhi(gw.x), g2 = bflo(gw.y), g3 = bfhi(gw.y);
                    u32x2 o; o.x = pk2(oacc[4 * i] * rl * fast_silu(g0), oacc[4 * i + 1] * rl * fast_silu(g1)); o.y = pk2(oacc[4 * i + 2] * rl * fast_silu(g2), oacc[4 * i + 3] * rl * fast_silu(g3));
                    *(u32x2*)(yp + 32 * t + 8 * i) = o;
                }
                __builtin_amdgcn_sched_barrier(0);
            }
        }
    }
#undef XA_DMA_K
#undef XA_DMA_V
}

__device__ __forceinline__ void final_norm(Frame& F, const Args& a) {
    const int gw = F.vcu * NWAVES + F.wave, NGW = F.G * NWAVES, lane = F.lane;
    const f32x4* gr = (const f32x4*)a.in[28] + lane;
    for (int m = gw; m < MTOK; m += NGW) {
        f32x4* xr = (f32x4*)(F.out + (size_t)m * DM) + lane;
        f32x4 v[4]; float s = 0.f;
#pragma unroll
        for (int j = 0; j < 4; ++j) { v[j] = xr[64 * j]; s += (v[j].x * v[j].x + v[j].y * v[j].y) + (v[j].z * v[j].z + v[j].w * v[j].w); }
        const float rstd = 1.0f / sqrtf(wave_sum(s) * (1.f / DM) + EPS);
#pragma unroll
        for (int j = 0; j < 4; ++j) { const f32x4 g = gr[64 * j]; xr[64 * j] = (f32x4){v[j].x * rstd * g.x, v[j].y * rstd * g.y, v[j].z * rstd * g.z, v[j].w * rstd * g.w}; }
    }
}

constexpr int NPH = 17;
__global__ void __launch_bounds__(NWAVES * 64, 2) trunk_fwd(Args args) {
    extern __shared__ __attribute__((aligned(16))) unsigned char lds[];
    Frame F;
    F.lds = (LAS unsigned char*)lds;
    F.MISC = (volatile LAS unsigned*)(F.lds + MISC_OFF);
    F.tid = threadIdx.x; F.lane = F.tid & 63; F.wave = __builtin_amdgcn_readfirstlane(F.tid >> 6);
    F.G = gridDim.x; { const int bx = blockIdx.x; F.vcu = (F.G % 8 == 0) ? (bx % 8) * (F.G / 8) + bx / 8 : bx; }
    F.ws = args.ws; F.out = args.out; F.ctl = (unsigned*)(args.ws + WS_CTL);
    for (int u = F.tid; u < (LDS_BYTES - LDSCTL_OFF) / 4; u += NWAVES * 64) ((LAS unsigned*)(F.lds + LDSCTL_OFF))[u] = 0u;
    __syncthreads();
    const int lo = args.ph_lo, hi = args.ph_hi;
    const bool multi = (hi - lo) > 1;
    XcdBarrier bar; bar.bar = F.ctl + CW_BAR; bar.x = 0; bar.st = nullptr;
    if (multi) bar = xcd_barrier_post(F.ctl + CW_BAR, F.MISC + 8);
#define IN(k) (lo <= (k) && (k) < hi)
#define SEAM(k) do { if (IN(k) && IN((k) + 1)) xcd_barrier(bar); } while (0)
    unsigned char* ws = args.ws;
    bf16* const XB = (bf16*)(ws + WS_XB); bf16* const Y = (bf16*)(ws + WS_Y); bf16* const Z = (bf16*)(ws + WS_Z); bf16* const ZS = (bf16*)(ws + WS_ZS);
    float* const RS = (float*)(ws + WS_RS);
    pg8::Epi E0{}; E0.mode = 0; E0.perm = true;
    pg8::Epi E1{}; E1.mode = 1; E1.perm = false; E1.xout = args.out; E1.xb = XB; E1.rsout = RS; E1.xold = args.out;

    if (IN(0)) { p0_prologue(F, args); } SEAM(0);
    if (IN(1)) {
        { pg8::Gemm g{XB, (const bf16*)(ws + WS_W_IN0), MTOK, EVEN_IN, DM}; pg8::StaticOrder S; S.init(MTOK, EVEN_IN, F.G, (int)blockIdx.x);
          pg8::Epi E = E0; E.O = Z; E.ldc = EVEN_IN; E.rs = RS; pg8::gemm_phase(F.lds, g, S, E); }
        { pg8::Gemm g{(const bf16*)(ws + WS_MEMN), (const bf16*)(ws + WS_W_KV), BATCH * MEMLEN, 2048, DM}; pg8::StaticOrder S; S.init(BATCH * MEMLEN, 2048, F.G, (int)blockIdx.x);
          pg8::Epi E = E0; E.mode = 3; E.O = (bf16*)(ws + WS_KP); pg8::gemm_phase(F.lds, g, S, E); }
        { pg8::Gemm g{(const bf16*)(ws + WS_W_KV) + (size_t)2048 * DM, (const bf16*)(ws + WS_MEMN), 2048, BATCH * MEMLEN, DM}; pg8::StaticOrder S; S.init(2048, BATCH * MEMLEN, F.G, (int)((blockIdx.x + F.G - 32) % F.G));
          pg8::Epi E = E0; E.mode = 4; E.O = (bf16*)(ws + WS_VP); pg8::gemm_phase(F.lds, g, S, E); }
    } SEAM(1);
    if (IN(2)) { s5_pass_a(F); conv_phase(F, args); } SEAM(2);
    if (IN(3)) { s5_pass_c(F, args); } SEAM(3);
    if (IN(4)) { pg8::Gemm g{ZS, (const bf16*)(ws + WS_W_GLU), MTOK, S5W, S5W}; pg8::StaticOrder S; S.init(MTOK, S5W, F.G, (int)blockIdx.x);
        pg8::Epi E{}; E.mode = 2; E.perm = true; E.O = Y; E.ldc = DM; E.zs = ZS; E.gatep = Z + 512; E.gate_ld = EVEN_IN; E.gb = args.in[14];
        pg8::gemm_phase(F.lds, g, S, E); } SEAM(4);
    if (IN(5)) { pg8::Gemm g{Y, (const bf16*)(ws + WS_W_OUT0), MTOK, DM, DM}; pg8::StaticOrder S; S.init(MTOK, DM, F.G, (int)blockIdx.x);
        pg8::Epi E = E1; E.xold = args.in[0]; pg8::gemm_phase(F.lds, g, S, E); } SEAM(5);
    if (IN(6)) { pg8::Gemm g{XB, (const bf16*)(ws + WS_W_QG), MTOK, 2048, DM}; pg8::StaticOrder S; S.init(MTOK, 2048, F.G, (int)blockIdx.x);
        pg8::Epi E = E0; E.O = Z; E.ldc = 2048; E.rs = RS; pg8::gemm_phase(F.lds, g, S, E); } SEAM(6);
    if (IN(7)) { xattn_mfma(F, 0); } SEAM(7);
    if (IN(8)) { pg8::Gemm g{Y, (const bf16*)(ws + WS_W_O), MTOK, DM, DM}; pg8::StaticOrder S; S.init(MTOK, DM, F.G, (int)blockIdx.x);
        pg8::gemm_phase(F.lds, g, S, E1); } SEAM(8);
    if (IN(9)) { pg8::Gemm g{XB, (const bf16*)(ws + WS_W_IN1), MTOK, ODD_IN, DM}; pg8::StaticOrder S; S.init(MTOK, ODD_IN, F.G, (int)blockIdx.x);
        pg8::Epi E = E0; E.mode = 5; E.O = Z; E.rs = RS; pg8::gemm_phase(F.lds, g, S, E); } SEAM(9);
    if (IN(10)) { chunk_attn_mfma(F, args); } SEAM(10);
    if (IN(11)) { pg8::Gemm g{Y, (const bf16*)(ws + WS_W_OUT1), MTOK, DM, DM}; pg8::StaticOrder S; S.init(MTOK, DM, F.G, (int)blockIdx.x);
        pg8::gemm_phase(F.lds, g, S, E1); } SEAM(11);
    if (IN(12)) { pg8::Gemm g{XB, (const bf16*)(ws + WS_W_QG) + (size_t)2048 * DM, MTOK, 2048, DM}; pg8::StaticOrder S; S.init(MTOK, 2048, F.G, (int)blockIdx.x);
        pg8::Epi E = E0; E.O = Z; E.ldc = 2048; E.rs = RS; pg8::gemm_phase(F.lds, g, S, E); } SEAM(12);
    if (IN(13)) { xattn_mfma(F, 1); } SEAM(13);
    if (IN(14)) { pg8::Gemm g{Y, (const bf16*)(ws + WS_W_O) + (size_t)DM * DM, MTOK, DM, DM}; pg8::StaticOrder S; S.init(MTOK, DM, F.G, (int)blockIdx.x);
        pg8::gemm_phase(F.lds, g, S, E1); } SEAM(14);
    if (IN(15)) { final_norm(F, args); }
#undef IN
#undef SEAM
}

extern "C" void kernel_launch(void* const* d_in, const int* in_sizes, int n_in, void* d_out, int out_size, void* d_ws, size_t ws_size, hipStream_t stream) {
    static int grid = 0;
    if (grid == 0) {
        if (n_in != 29 || out_size != MTOK * DM || ws_size < WS_END) { fprintf(stderr, "kernel_launch: unexpected shapes: n_in %d out %d ws %zu\n", n_in, out_size, ws_size); grid = -1; return; }
        int dev = 0, cus = 0, per_cu = 0;
        if (hipGetDevice(&dev) != hipSuccess || hipDeviceGetAttribute(&cus, hipDeviceAttributeMultiprocessorCount, dev) != hipSuccess) { grid = -1; return; }
        if (hipFuncSetAttribute((const void*)trunk_fwd, hipFuncAttributeMaxDynamicSharedMemorySize, LDS_BYTES) != hipSuccess) { fprintf(stderr, "kernel_launch: hipFuncSetAttribute failed\n"); grid = -1; return; }
        if (hipOccupancyMaxActiveBlocksPerMultiprocessor(&per_cu, (const void*)trunk_fwd, NWAVES * 64, LDS_BYTES) != hipSuccess || per_cu < 1) { fprintf(stderr, "kernel_launch: occupancy query reports %d\n", per_cu); per_cu = 1; }
        (void)hipGetLastError();
        grid = cus;
        if (grid > cus * per_cu) grid = cus * per_cu;
    }
    if (grid < 0) return;
    (void)hipMemsetAsync((char*)d_ws + WS_CTL, 0, CTL_ZERO_BYTES, stream);
    Args a{};
    for (int i = 0; i < 29; ++i) a.in[i] = (const float*)d_in[i];
    a.out = (float*)d_out; a.ws = (unsigned char*)d_ws;
    if (MK_N_LAUNCHES == 1) { a.ph_lo = 0; a.ph_hi = NPH; hipLaunchKernelGGL(trunk_fwd, dim3(grid), dim3(NWAVES * 64), LDS_BYTES, stream, a); }
    else { for (int p = 0; p < 16; ++p) { a.ph_lo = p; a.ph_hi = p + 1; hipLaunchKernelGGL(trunk_fwd, dim3(grid), dim3(NWAVES * 64), LDS_BYTES, stream, a); } }
}
```

```cpp
#include <hip/hip_runtime.h>
#include <cstdio>
#include <cstdint>
#include <utility>

#ifndef MK_N_LAUNCHES
#define MK_N_LAUNCHES 1
#endif
#ifndef DUP_MASK
#define DUP_MASK 0u
#endif

#define GAS __attribute__((address_space(1)))
#define LAS __attribute__((address_space(3)))
typedef unsigned short bf16;
typedef short bf16x8 __attribute__((ext_vector_type(8)));
typedef float f32x4 __attribute__((ext_vector_type(4)));
typedef float f32x2 __attribute__((ext_vector_type(2)));
typedef unsigned u32x4 __attribute__((ext_vector_type(4)));
typedef unsigned u32x2 __attribute__((ext_vector_type(2)));
typedef float f32x16 __attribute__((ext_vector_type(16)));
typedef short s16x4 __attribute__((ext_vector_type(4)));
__host__ __device__ __forceinline__ int crow16(int reg, int hi) { return (reg & 3) + 8 * (reg >> 2) + 4 * hi; }

constexpr int BATCH = 4, SEQ = 8192, DM = 1024, MTOK = BATCH * SEQ;
constexpr int EVEN_IN = 2560, ODD_IN = 4096, S5W = 512, NGRP = 32, NST = 64, CONVK = 31;
constexpr int MEMLEN = 256, NCHUNK = SEQ / 64;
constexpr float EPS = 1e-6f, LOG2E = 1.4426950408889634f;
constexpr float QSCALE_ATT = 0.125f * LOG2E;
constexpr float QSCALE_XA = 0.0625f * LOG2E;
constexpr int NWAVES = 8;

constexpr size_t MiB = 1u << 20;
constexpr size_t WS_CTL = 0, CTL_ZERO_BYTES = 1 * MiB;
constexpr size_t WS_W_IN0 = 2 * MiB, WS_W_OUT0 = 7 * MiB, WS_W_GLU = 9 * MiB, WS_W_IN1 = 10 * MiB, WS_W_OUT1 = 18 * MiB;
constexpr size_t WS_W_QG = 20 * MiB, WS_W_KV = 28 * MiB, WS_W_O = 36 * MiB, WS_MEMN = 40 * MiB, WS_KP = 42 * MiB, WS_VP = 46 * MiB;
constexpr size_t WS_PAR = 50 * MiB, WS_RS = 51 * MiB, WS_SC = 53 * MiB;
constexpr size_t WS_XB = 64 * MiB, WS_Y = 128 * MiB, WS_ZS = 192 * MiB, WS_Z = 224 * MiB, WS_END = 480 * MiB;
constexpr int CW_BAR = 4096, CW_FIN = 8192;

constexpr int RING_BYTES = 143360, LDSCTL_OFF = RING_BYTES, MISC_OFF = LDSCTL_OFF + 320, LDS_BYTES = 147456;

#define RLX_AGENT __ATOMIC_RELAXED, __HIP_MEMORY_SCOPE_AGENT
__device__ __forceinline__ unsigned f2bf(float f) { unsigned u = __builtin_bit_cast(unsigned, f); return (u + 0x7fffu + ((u >> 16) & 1u)) >> 16; }
typedef __bf16 bf16x2_t __attribute__((ext_vector_type(2)));
__device__ __forceinline__ unsigned pk2(float lo, float hi) { const f32x2 v = {lo, hi}; const bf16x2_t b = __builtin_convertvector(v, bf16x2_t); return __builtin_bit_cast(unsigned, b); }
__device__ __forceinline__ float bflo(unsigned w) { return __uint_as_float(w << 16); }
__device__ __forceinline__ float bfhi(unsigned w) { return __uint_as_float(w & 0xffff0000u); }
__device__ __forceinline__ float bf2f(unsigned short b) { return __uint_as_float((unsigned)b << 16); }
__device__ __forceinline__ int lane_id_v() { int l; asm volatile("v_mbcnt_lo_u32_b32 %0, -1, 0\n\tv_mbcnt_hi_u32_b32 %0, -1, %0" : "=v"(l)); return l; }
__device__ __forceinline__ bf16x8 gload16_asm(const void* p) { bf16x8 v; asm volatile("global_load_dwordx4 %0, %1, off" : "=v"(v) : "v"(p) : "memory"); return v; }
__device__ __forceinline__ void glds16_asm(const void* gsrc, unsigned lds_dst) { unsigned keep;
    asm volatile("s_mov_b32 %0, m0\n\ts_mov_b32 m0, %2\n\ts_nop 0\n\tglobal_load_lds_dwordx4 %1, off\n\ts_mov_b32 m0, %0" : "=&s"(keep) : "v"(gsrc), "s"(lds_dst) : "memory"); }
__device__ __forceinline__ float max3_asm(float a, float b, float c) { float r; asm("v_max3_f32 %0, %1, %2, %3" : "=v"(r) : "v"(a), "v"(b), "v"(c)); return r; }
__device__ __forceinline__ float max2_asm(float a, float b) { float r; asm("v_max_f32_e32 %0, %1, %2" : "=v"(r) : "v"(a), "v"(b)); return r; }
__device__ __forceinline__ int opaque0() { int z; asm volatile("v_mov_b32 %0, 0" : "=v"(z)); return z; }
__device__ __forceinline__ float fast_sigmoid(float x) { return __builtin_amdgcn_rcpf(1.0f + __builtin_amdgcn_exp2f(-x * LOG2E)); }
__device__ __forceinline__ float fast_silu(float x) { return x * fast_sigmoid(x); }
__device__ __forceinline__ float gelu_tanh(float y) { const float x = 0.7978845608028654f * (y + 0.044715f * y * y * y); return y * fast_sigmoid(2.0f * x); }
__device__ __forceinline__ float wave_sum(float v) {
    v += __builtin_bit_cast(float, __builtin_amdgcn_update_dpp(0, __builtin_bit_cast(int, v), 0xB1, 0xF, 0xF, true));
    v += __builtin_bit_cast(float, __builtin_amdgcn_update_dpp(0, __builtin_bit_cast(int, v), 0x4E, 0xF, 0xF, true));
    v += __builtin_bit_cast(float, __builtin_amdgcn_update_dpp(0, __builtin_bit_cast(int, v), 0x141, 0xF, 0xF, true));
    v += __builtin_bit_cast(float, __builtin_amdgcn_update_dpp(0, __builtin_bit_cast(int, v), 0x140, 0xF, 0xF, true));
    const int b = __builtin_bit_cast(int, v);
    const float r0 = __builtin_bit_cast(float, __builtin_amdgcn_readlane(b, 0)), r1 = __builtin_bit_cast(float, __builtin_amdgcn_readlane(b, 16));
    const float r2 = __builtin_bit_cast(float, __builtin_amdgcn_readlane(b, 32)), r3 = __builtin_bit_cast(float, __builtin_amdgcn_readlane(b, 48));
    return (r0 + r1) + (r2 + r3);
}
__device__ __forceinline__ void unpack8(const u32x4 w, float* f) {
    f[0] = bflo(w.x); f[1] = bfhi(w.x); f[2] = bflo(w.y); f[3] = bfhi(w.y); f[4] = bflo(w.z); f[5] = bfhi(w.z); f[6] = bflo(w.w); f[7] = bfhi(w.w);
}

namespace pg8 {
constexpr int BM = 256, BK = 64, HALF = 128, HTB = HALF * BK * 2, STAGE_BYTES = 8 * HTB, NXCD = 8, WGM = 8;
__host__ __device__ __forceinline__ int lds_byte(int r, int c) { const int st = (r >> 4) * 2 + (c >> 5), rr = r & 15, cc = c & 31, ob = rr * 64 + cc * 2; return st * 1024 + (ob ^ (((ob >> 9) & 1) << 5)); }
__host__ __device__ __forceinline__ void stage_rc(int b, int& R, int& C) { const int st = b / 1024, sb = b % 1024, swz = sb ^ (((sb >> 9) & 1) << 5); R = (st >> 1) * 16 + swz / 64; C = (st & 1) * 32 + (swz % 64) / 2; }
__host__ __device__ __forceinline__ int perm32(int rho) { const int n = rho >> 4, i = rho & 15; return 8 * (i >> 2) + 4 * n + (i & 3); }

struct Unit { int pm, pn; };
struct Gemm { const bf16* A; const bf16* Bt; int M, N, K; };

struct StaticOrder {
    int nM, nN, nwg, G, c;
    __host__ __device__ void init(int M, int N, int G_, int c_) { nM = M / BM; nN = N / BM; nwg = nM * nN; G = G_; c = c_; }
    __host__ __device__ bool next(int i, Unit& u) const {
        const long L = (long)i * G + c; if (L >= nwg) return false;
        int wgid = (int)L; { const int q = nwg / NXCD, r = nwg % NXCD, xcd = wgid % NXCD, off = wgid / NXCD; wgid = (xcd < r ? xcd * (q + 1) : r * (q + 1) + (xcd - r) * q) + off; }
        const int nig = WGM * nN, gid = wgid / nig, fm = gid * WGM, gsz = (nM - fm) < WGM ? (nM - fm) : WGM;
        u.pm = fm + ((wgid % nig) % gsz); u.pn = (wgid % nig) / gsz; return true;
    }
};

__device__ __forceinline__ unsigned cvt_pk_bf16(float lo, float hi) { unsigned r; asm volatile("v_cvt_pk_bf16_f32 %0, %1, %2" : "=v"(r) : "v"(lo), "v"(hi)); return r; }

struct Epi {
    int mode; bool perm;
    unsigned act_silu, act_sig;
    const float* fin_g; unsigned* fin_cnt; float* fin_out;
    bf16* O; int ldc; const float* rs;
    const float* xold; float* xout; bf16* xb; float* rsout;
    const bf16* zs; const bf16* gatep; int gate_ld; const float* gb;
    __device__ __forceinline__ void operator()(f32x4 (&acc)[2][2][4][2], const Unit& u, int wr, int wc, int fr, int fq) const {
        if (mode == 0) {
            const int row0 = u.pm * BM + wr * 64 + fr, col0 = u.pn * BM + wc * 32 + 8 * fq;
            const int act = ((act_silu >> u.pn) & 1u) ? 1 : (((act_sig >> u.pn) & 1u) ? 2 : 0);
#pragma unroll
            for (int ai = 0; ai < 2; ++ai)
#pragma unroll
                for (int m = 0; m < 4; ++m) {
                    const int row = row0 + ai * HALF + m * 16;
                    float sc = 1.f;
                    if (rs) { const f32x4* p = (const f32x4*)(rs + (size_t)row * 16); const f32x4 a = p[0], b = p[1], c = p[2], d = p[3];
                        const float s = ((a[0] + a[1]) + (a[2] + a[3])) + ((b[0] + b[1]) + (b[2] + b[3])) + ((c[0] + c[1]) + (c[2] + c[3])) + ((d[0] + d[1]) + (d[2] + d[3]));
                        sc = __builtin_amdgcn_rsqf(s * (1.0f / 1024.0f) + EPS); }
                    bf16* rowp = O + (size_t)row * ldc + col0;
#pragma unroll
                    for (int bj = 0; bj < 2; ++bj) { f32x4 v0 = acc[ai][bj][m][0] * sc, v1 = acc[ai][bj][m][1] * sc;
                        if (act) {
#pragma unroll
                            for (int e = 0; e < 4; ++e) { const float s0 = fast_sigmoid(v0[e]), s1 = fast_sigmoid(v1[e]); v0[e] = (act == 1) ? v0[e] * s0 : s0; v1[e] = (act == 1) ? v1[e] * s1 : s1; } }
                        u32x4 w; w.x = cvt_pk_bf16(v0[0], v0[1]); w.y = cvt_pk_bf16(v0[2], v0[3]); w.z = cvt_pk_bf16(v1[0], v1[1]); w.w = cvt_pk_bf16(v1[2], v1[3]);
                        *(u32x4*)(rowp + bj * HALF) = w; }
                }
        } else if (mode == 1) {
            const int row0 = u.pm * BM + wr * 64 + fr, col0 = u.pn * BM + wc * 32 + 4 * fq;
#pragma unroll
            for (int ai = 0; ai < 2; ++ai)
#pragma unroll
                for (int m = 0; m < 4; ++m) {
                    const int row = row0 + ai * HALF + m * 16; const size_t off = (size_t)row * DM + col0; float ss = 0.f;
#pragma unroll
                    for (int bj = 0; bj < 2; ++bj)
#pragma unroll
                        for (int n = 0; n < 2; ++n) { const f32x4 xo = *(const f32x4*)(xold + off + bj * HALF + n * 16); const f32x4 x = xo + acc[ai][bj][m][n];
                            *(f32x4*)(xout + off + bj * HALF + n * 16) = x; ss += (x[0] * x[0] + x[1] * x[1]) + (x[2] * x[2] + x[3] * x[3]);
                            u32x2 w; w.x = cvt_pk_bf16(x[0], x[1]); w.y = cvt_pk_bf16(x[2], x[3]); *(u32x2*)(xb + off + bj * HALF + n * 16) = w; }
                    ss += __shfl_xor(ss, 16); ss += __shfl_xor(ss, 32);
                    if (fq == 0) rsout[(size_t)row * 16 + u.pn * 4 + wc] = ss;
                }
        } else if (mode == 6) {
            const int row0 = u.pm * BM + wr * 64 + fr, col0 = u.pn * BM + wc * 32 + 4 * fq;
#pragma unroll
            for (int ai = 0; ai < 2; ++ai)
#pragma unroll
                for (int m = 0; m < 4; ++m) {
                    const int row = row0 + ai * HALF + m * 16; const size_t off = (size_t)row * DM + col0; float ss = 0.f;
#pragma unroll
                    for (int bj = 0; bj < 2; ++bj)
#pragma unroll
                        for (int n = 0; n < 2; ++n) { const f32x4 x = *(const f32x4*)(xold + off + bj * HALF + n * 16) + acc[ai][bj][m][n]; acc[ai][bj][m][n] = x;
                            ss += (x[0] * x[0] + x[1] * x[1]) + (x[2] * x[2] + x[3] * x[3]); }
                    ss += __shfl_xor(ss, 16); ss += __shfl_xor(ss, 32);
                    if (fq == 0) __hip_atomic_store(rsout + (size_t)row * 16 + u.pn * 4 + wc, ss, __ATOMIC_RELAXED, __HIP_MEMORY_SCOPE_AGENT);
                }
            asm volatile("s_waitcnt vmcnt(0)" ::: "memory");
            unsigned* cnt = fin_cnt + 64 * u.pm;
            if (fr == 0 && fq == 0) __hip_atomic_fetch_add(cnt, 1u, __ATOMIC_RELAXED, __HIP_MEMORY_SCOPE_AGENT);
            for (unsigned sp = 0; sp < (1u << 20); ++sp) {
                if ((unsigned)__builtin_amdgcn_readfirstlane((int)__hip_atomic_load(cnt, __ATOMIC_RELAXED, __HIP_MEMORY_SCOPE_AGENT)) >= 32u) break;
                __builtin_amdgcn_s_sleep(2);
            }
#pragma unroll
            for (int ai = 0; ai < 2; ++ai)
#pragma unroll
                for (int m = 0; m < 4; ++m) {
                    const int row = row0 + ai * HALF + m * 16; const size_t off = (size_t)row * DM + col0;
                    const float* sl = rsout + (size_t)row * 16 + 4 * fq;
                    float t = (__hip_atomic_load(sl, __ATOMIC_RELAXED, __HIP_MEMORY_SCOPE_AGENT) + __hip_atomic_load(sl + 1, __ATOMIC_RELAXED, __HIP_MEMORY_SCOPE_AGENT))
                            + (__hip_atomic_load(sl + 2, __ATOMIC_RELAXED, __HIP_MEMORY_SCOPE_AGENT) + __hip_atomic_load(sl + 3, __ATOMIC_RELAXED, __HIP_MEMORY_SCOPE_AGENT));
                    t += __shfl_xor(t, 16); t += __shfl_xor(t, 32);
                    const float rstd = __builtin_amdgcn_rsqf(t * (1.0f / 1024.0f) + EPS);
#pragma unroll
                    for (int bj = 0; bj < 2; ++bj)
#pragma unroll
                        for (int n = 0; n < 2; ++n) { const f32x4 g = *(const f32x4*)(fin_g + col0 + bj * HALF + n * 16);
                            *(f32x4*)(fin_out + off + bj * HALF + n * 16) = acc[ai][bj][m][n] * rstd * g; }
                }
        } else if (mode == 5) {
            const int row0 = u.pm * BM + wr * 64 + fr, col0 = u.pn * BM + wc * 32 + 8 * fq;
            const int quarter = u.pn >> 2; bf16* const Oq = O + (size_t)quarter * ((size_t)MTOK * 1024);
#pragma unroll
            for (int ai = 0; ai < 2; ++ai)
#pragma unroll
                for (int m = 0; m < 4; ++m) {
                    const int row = row0 + ai * HALF + m * 16;
                    float sc;
                    { const f32x4* p = (const f32x4*)(rs + (size_t)row * 16); const f32x4 a = p[0], b = p[1], c = p[2], d = p[3];
                      const float s = ((a[0] + a[1]) + (a[2] + a[3])) + ((b[0] + b[1]) + (b[2] + b[3])) + ((c[0] + c[1]) + (c[2] + c[3])) + ((d[0] + d[1]) + (d[2] + d[3]));
                      sc = __builtin_amdgcn_rsqf(s * (1.0f / 1024.0f) + EPS); }
                    const int bb = row >> 13, tt = row & 8191, chunk = tt >> 6, key = tt & 63;
#pragma unroll
                    for (int bj = 0; bj < 2; ++bj) { const int cc = (col0 + bj * HALF) & 1023, h = cc >> 6, dc = (cc & 63) >> 3;
                        f32x4 v0 = acc[ai][bj][m][0] * sc, v1 = acc[ai][bj][m][1] * sc;
                        if (quarter == 3) {
#pragma unroll
                            for (int e = 0; e < 4; ++e) { v0[e] *= fast_sigmoid(v0[e]); v1[e] *= fast_sigmoid(v1[e]); } }
                        u32x4 w; w.x = cvt_pk_bf16(v0[0], v0[1]); w.y = cvt_pk_bf16(v0[2], v0[3]); w.z = cvt_pk_bf16(v1[0], v1[1]); w.w = cvt_pk_bf16(v1[2], v1[3]);
                        size_t off;
                        if (quarter == 1) off = ((size_t)(((bb * 16 + h) * 128 + chunk) * 8 + dc) * 64 + key) * 8;
                        else if (quarter == 2) off = (size_t)((bb * 16 + h) * 128 + chunk) * 4096 + key * 64 + ((dc ^ (((key >> 1) & 1) << 2)) * 8);
                        else off = (size_t)row * 1024 + cc;
                        *(u32x4*)(Oq + off) = w; }
                }
        } else if (mode == 3) {
            const int row0 = u.pm * BM + wr * 64 + fr, col0 = u.pn * BM + wc * 32 + 8 * fq;
#pragma unroll
            for (int ai = 0; ai < 2; ++ai)
#pragma unroll
                for (int m = 0; m < 4; ++m) {
                    const int row = row0 + ai * HALF + m * 16, b = row >> 8, key = row & 255;
#pragma unroll
                    for (int bj = 0; bj < 2; ++bj) { const int col = col0 + bj * HALF, l = col >> 10, hx = (col >> 8) & 3, dc = (col & 255) >> 3;
                        const f32x4 v0 = acc[ai][bj][m][0], v1 = acc[ai][bj][m][1];
                        u32x4 w; w.x = cvt_pk_bf16(v0[0], v0[1]); w.y = cvt_pk_bf16(v0[2], v0[3]); w.z = cvt_pk_bf16(v1[0], v1[1]); w.w = cvt_pk_bf16(v1[2], v1[3]);
                        *(u32x4*)(O + ((size_t)((((l * 4 + b) * 4 + hx) * 32 + dc) * 256 + key)) * 8) = w; }
                }
        } else if (mode == 4) {
            const int row0 = u.pm * BM + wr * 64 + fr, col0 = u.pn * BM + wc * 32 + 8 * fq;
#pragma unroll
            for (int ai = 0; ai < 2; ++ai)
#pragma unroll
                for (int m = 0; m < 4; ++m) {
                    const int row = row0 + ai * HALF + m * 16, l = row >> 10, hx = (row >> 8) & 3, d = row & 255;
#pragma unroll
                    for (int bj = 0; bj < 2; ++bj) { const int col = col0 + bj * HALF, b = col >> 8, kg = (col & 255) >> 2;
                        const f32x4 v0 = acc[ai][bj][m][0], v1 = acc[ai][bj][m][1];
                        u32x2 w0, w1; w0.x = cvt_pk_bf16(v0[0], v0[1]); w0.y = cvt_pk_bf16(v0[2], v0[3]); w1.x = cvt_pk_bf16(v1[0], v1[1]); w1.y = cvt_pk_bf16(v1[2], v1[3]);
                        bf16* p = O + ((size_t)((((l * 4 + b) * 4 + hx) * 64 + kg) * 256 + d)) * 4;
                        *(u32x2*)p = w0; *(u32x2*)(p + 256 * 4) = w1; }
                }
        } else {
            const int row0 = u.pm * BM + wr * 64 + fr, col0 = u.pn * BM + wc * 32 + 8 * fq;
#pragma unroll
            for (int bj = 0; bj < 2; ++bj) {
                const int col = col0 + bj * HALF; const f32x4 b0 = *(const f32x4*)(gb + col), b1 = *(const f32x4*)(gb + col + 4);
#pragma unroll
                for (int ai = 0; ai < 2; ++ai)
#pragma unroll
                    for (int m = 0; m < 4; ++m) {
                        const int row = row0 + ai * HALF + m * 16;
                        const u32x4 zw = *(const u32x4*)(zs + (size_t)row * S5W + col); const u32x4 gw = *(const u32x4*)(gatep + (size_t)row * gate_ld + col);
                        float z[8], g[8], o[8]; unpack8(zw, z); unpack8(gw, g);
                        const f32x4 a0 = acc[ai][bj][m][0] + b0, a1 = acc[ai][bj][m][1] + b1;
#pragma unroll
                        for (int e = 0; e < 4; ++e) { o[e] = z[e] * fast_sigmoid(a0[e]) * g[e]; o[4 + e] = z[4 + e] * fast_sigmoid(a1[e]) * g[4 + e]; }
                        u32x4 w; w.x = cvt_pk_bf16(o[0], o[1]); w.y = cvt_pk_bf16(o[2], o[3]); w.z = cvt_pk_bf16(o[4], o[5]); w.w = cvt_pk_bf16(o[6], o[7]);
                        *(u32x4*)(O + (size_t)row * ldc + col) = w;
                    }
            }
        }
    }
};

__device__ __forceinline__ void gemm_phase(LAS unsigned char* lds, const Gemm g, const StaticOrder& S, const Epi& E) {
    const int lane = lane_id_v(), wid = __builtin_amdgcn_readfirstlane(threadIdx.x >> 6), tid = wid * 64 + lane, wr = wid >> 2, wc = wid & 3, fr = lane & 15, fq = lane >> 4;
    const int K = g.K, nt = K / BK;
    unsigned voffA[2], voffB[2];
#pragma unroll
    for (int i = 0; i < 2; ++i) { int R, C; stage_rc(tid * 16 + i * 8192, R, C); const int Rb = E.perm ? ((R & ~31) + perm32(R & 31)) : R;
        voffA[i] = (unsigned)(R * K + C) * 2u; voffB[i] = (unsigned)(Rb * K + C) * 2u; }
    const size_t kstep = (size_t)(BK * 2);
    const size_t hstep = (size_t)HALF * K * 2;
    const size_t tstep = 2 * hstep;
    const unsigned ldsw = (unsigned)wid * 1024u;
    const int aoff = lds_byte(wr * 64 + fr, fq * 8), boff = lds_byte(wc * 32 + fr, fq * 8);
#define PG8_SA(b, h) (((b) * 2 + (h)) * HTB)
#define PG8_SB(b, h) ((4 + (b) * 2 + (h)) * HTB)
#define PG8_STAGE(bufoff, gbase, voff) do { _Pragma("unroll") for (int _i = 0; _i < 2; ++_i) \
        __builtin_amdgcn_global_load_lds((const unsigned*)((const char*)(gbase) + (voff)[_i]), (LAS unsigned*)(lds + (bufoff) + ldsw + _i * 8192), 16, 0, 0); } while (0)
#define PG8_LDA(dst, b, h) do { _Pragma("unroll") for (int m = 0; m < 4; ++m) _Pragma("unroll") for (int k = 0; k < 2; ++k) dst[m][k] = *(const LAS bf16x8*)(lds + PG8_SA(b, h) + aoff + m * 2048 + k * 1024); } while (0)
#define PG8_LDB(dst, b, h) do { _Pragma("unroll") for (int n = 0; n < 2; ++n) _Pragma("unroll") for (int k = 0; k < 2; ++k) dst[n][k] = *(const LAS bf16x8*)(lds + PG8_SB(b, h) + boff + n * 2048 + k * 1024); } while (0)
#define PG8_MMA(ai, bj, At, Bt) do { __builtin_amdgcn_s_setprio(1); _Pragma("unroll") for (int m = 0; m < 4; ++m) _Pragma("unroll") for (int n = 0; n < 2; ++n) _Pragma("unroll") for (int k = 0; k < 2; ++k) \
        acc[ai][bj][m][n] = __builtin_amdgcn_mfma_f32_16x16x32_bf16(Bt[n][k], At[m][k], acc[ai][bj][m][n], 0, 0, 0); __builtin_amdgcn_s_setprio(0); } while (0)
#define PG8_WAIT_V(n) asm volatile("s_waitcnt vmcnt(" #n ")" ::: "memory")
#define PG8_WAIT_L(n) asm volatile("s_waitcnt lgkmcnt(" #n ")" ::: "memory")
#define PG8_BAR __builtin_amdgcn_s_barrier()
#define PG8_SCHED __builtin_amdgcn_sched_barrier(0)
    Unit cur, nxt; int ui = 0;
    if (!S.next(0, cur)) return;
    f32x4 acc[2][2][4][2];
#pragma unroll
    for (int a = 0; a < 2; ++a)
#pragma unroll
        for (int b = 0; b < 2; ++b)
#pragma unroll
            for (int m = 0; m < 4; ++m)
#pragma unroll
                for (int n = 0; n < 2; ++n) acc[a][b][m][n] = (f32x4){0.f, 0.f, 0.f, 0.f};
    bf16x8 At[4][2], B0[2][2], B1[2][2];
    const char* cA = (const char*)g.A + (size_t)cur.pm * tstep; const char* cB = (const char*)g.Bt + (size_t)cur.pn * tstep;
    PG8_STAGE(PG8_SB(0, 0), cB, voffB); PG8_STAGE(PG8_SB(0, 1), cB + hstep, voffB); PG8_STAGE(PG8_SA(0, 0), cA, voffA); PG8_STAGE(PG8_SA(0, 1), cA + hstep, voffA);
    if (wr == 1) PG8_BAR;
    PG8_WAIT_V(2); PG8_BAR;
    PG8_STAGE(PG8_SB(1, 0), cB + kstep, voffB); PG8_STAGE(PG8_SA(1, 0), cA + kstep, voffA); PG8_STAGE(PG8_SB(1, 1), cB + hstep + kstep, voffB);
    PG8_WAIT_V(6); PG8_BAR;
    for (;;) {
        const bool has_next = S.next(ui + 1, nxt);
        const char* nA = has_next ? (const char*)g.A + (size_t)nxt.pm * tstep : cA; const char* nB = has_next ? (const char*)g.Bt + (size_t)nxt.pn * tstep : cB;
        for (int t = 0; t < nt; t += 2) {
            const bool last = (t == nt - 2);
            const char* a1 = cA + (size_t)(t + 1) * kstep;
            const char* a2 = last ? nA : cA + (size_t)(t + 2) * kstep; const char* b2 = last ? nB : cB + (size_t)(t + 2) * kstep;
            const char* a3 = a2 + kstep; const char* b3 = b2 + kstep;
            PG8_LDB(B0, 0, 0); PG8_LDB(B1, 0, 1); PG8_SCHED; PG8_LDA(At, 0, 0); PG8_STAGE(PG8_SA(1, 1), a1 + hstep, voffA);
            PG8_WAIT_V(8); PG8_WAIT_L(0); PG8_BAR; PG8_MMA(0, 0, At, B0); PG8_MMA(0, 1, At, B1); PG8_BAR; PG8_SCHED;
            PG8_LDA(At, 0, 1); PG8_STAGE(PG8_SB(0, 0), b2, voffB); PG8_STAGE(PG8_SB(0, 1), b2 + hstep, voffB); PG8_STAGE(PG8_SA(0, 0), a2, voffA);
            PG8_WAIT_V(8); PG8_WAIT_L(0); PG8_BAR; PG8_MMA(1, 0, At, B0); PG8_MMA(1, 1, At, B1); PG8_BAR; PG8_SCHED;
            PG8_LDB(B0, 1, 0); PG8_LDB(B1, 1, 1); PG8_SCHED; PG8_LDA(At, 1, 0); PG8_STAGE(PG8_SA(0, 1), a2 + hstep, voffA);
            PG8_WAIT_V(8); PG8_WAIT_L(0); PG8_BAR; PG8_MMA(0, 0, At, B0); PG8_MMA(0, 1, At, B1); PG8_BAR; PG8_SCHED;
            PG8_LDA(At, 1, 1); PG8_STAGE(PG8_SB(1, 0), b3, voffB); PG8_STAGE(PG8_SB(1, 1), b3 + hstep, voffB); PG8_STAGE(PG8_SA(1, 0), a3, voffA);
            PG8_WAIT_V(8); PG8_WAIT_L(0); PG8_BAR; PG8_MMA(1, 0, At, B0); PG8_MMA(1, 1, At, B1); PG8_BAR; PG8_SCHED;
        }
        if (wr == 0) PG8_BAR;
        E(acc, cur, wr, wc, fr, fq);
        if (!has_next) break;
#pragma unroll
        for (int a = 0; a < 2; ++a)
#pragma unroll
            for (int b = 0; b < 2; ++b)
#pragma unroll
                for (int m = 0; m < 4; ++m)
#pragma unroll
                    for (int n = 0; n < 2; ++n) acc[a][b][m][n] = (f32x4){0.f, 0.f, 0.f, 0.f};
        cur = nxt; cA = nA; cB = nB; ++ui;
        if (wr == 1) PG8_BAR;
    }
    PG8_WAIT_V(0);
    PG8_BAR;
#undef PG8_SA
#undef PG8_SB
#undef PG8_STAGE
#undef PG8_LDA
#undef PG8_LDB
#undef PG8_MMA
#undef PG8_WAIT_V
#undef PG8_WAIT_L
#undef PG8_BAR
#undef PG8_SCHED
}
}

#define XB_TMO      128
#define XB_XCNT(j)  (256  + 64 * (j))
#define XB_XSUB(j)  (1280 + 64 * (j))
#define XB_XGEN(j)  (2304 + 64 * (j))
#define XB_TOP      3328
#define XB_TOPGEN   3392
#define XCD_BAR_WORDS 3456
#define XB_SPIN_CAP (1u << 18)
__device__ __forceinline__ unsigned xb_ld(unsigned* p)              { return __hip_atomic_load(p, __ATOMIC_RELAXED, __HIP_MEMORY_SCOPE_AGENT); }
__device__ __forceinline__ unsigned xb_add(unsigned* p, unsigned v) { return __hip_atomic_fetch_add(p, v, __ATOMIC_RELAXED, __HIP_MEMORY_SCOPE_AGENT); }
__device__ __forceinline__ unsigned xb_xcc_id() { return (unsigned)__builtin_amdgcn_s_getreg((3 << 11) | 20) & 0xFu; }
#define XB_SPIN(cond, bar) do { unsigned _sp = 0; while (cond) { __builtin_amdgcn_s_sleep(1); \
    if ((++_sp & 255u) == 0u) { if (xb_ld(&(bar)[XB_TMO])) break; if (_sp > XB_SPIN_CAP) { atomicAdd(&(bar)[XB_TMO], 1u); break; } } } } while (0)
struct XcdBarrier { unsigned* bar; unsigned x; volatile LAS unsigned* st; };
__device__ __forceinline__ XcdBarrier xcd_barrier_post(unsigned* bar, volatile LAS unsigned* st) {
    XcdBarrier b; b.bar = bar; b.x = xb_xcc_id(); b.st = st;
    if (threadIdx.x == 0) (void)xb_add(&bar[XB_XCNT(b.x)], 1u);
    return b;
}
__device__ __forceinline__ void xcd_barrier_complete(unsigned* bar, unsigned x, unsigned& nloc, unsigned& nx) {
    const unsigned G = gridDim.x * gridDim.y * gridDim.z;
    unsigned sum, cnt, mine, sp = 0u;
    for (;;) {
        sum = 0u; cnt = 0u; mine = 0u;
#pragma unroll
        for (unsigned j = 0; j < 16; ++j) { const unsigned c = xb_ld(&bar[XB_XCNT(j)]); sum += c; cnt += (c > 0u) ? 1u : 0u; mine = (j == x) ? c : mine; }
        if (sum == G) break;
        __builtin_amdgcn_s_sleep(1);
        if ((++sp & 255u) == 0u) { if (xb_ld(&bar[XB_TMO])) break; if (sp > XB_SPIN_CAP) { atomicAdd(&bar[XB_TMO], 1u); break; } }
    }
    nloc = mine > 0u ? mine : 1u; nx = cnt > 0u ? cnt : 1u;
}
__device__ __forceinline__ void xcd_barrier(const XcdBarrier& b) {
    asm volatile("s_waitcnt vmcnt(0)" ::: "memory");
    __syncthreads();
    if (threadIdx.x == 0) {
        unsigned* bar = b.bar;
        __builtin_amdgcn_s_waitcnt(0);
        unsigned nloc = b.st[0], nx = b.st[1];
        if (nloc == 0u) { xcd_barrier_complete(bar, b.x, nloc, nx); b.st[0] = nloc; b.st[1] = nx; }
        const unsigned old = xb_add(&bar[XB_XSUB(b.x)], 1u);
        const unsigned gen = old / nloc;
        if (old + 1u == (gen + 1u) * nloc) {
            __builtin_amdgcn_fence(__ATOMIC_RELEASE, "agent");
            asm volatile("s_waitcnt vmcnt(0)" ::: "memory");
            const unsigned og = xb_add(&bar[XB_TOP], 1u);
            const unsigned tg = og / nx;
            if (og + 1u == (tg + 1u) * nx) xb_add(&bar[XB_TOPGEN], 1u);
            else XB_SPIN(xb_ld(&bar[XB_TOPGEN]) == tg, bar);
            __builtin_amdgcn_fence(__ATOMIC_ACQUIRE, "agent");
            xb_add(&bar[XB_XGEN(b.x)], 1u);
            asm volatile("s_waitcnt vmcnt(0)" ::: "memory");
        } else {
            XB_SPIN(xb_ld(&bar[XB_XGEN(b.x)]) == gen, bar);
            __builtin_amdgcn_fence(__ATOMIC_ACQUIRE, "agent");
            asm volatile("s_waitcnt vmcnt(0)" ::: "memory");
        }
    }
    __syncthreads();
}

struct Args { const float* in[29]; float* out; unsigned char* ws; int ph_lo, ph_hi; };
struct Frame {
    LAS unsigned char* lds; volatile LAS unsigned* MISC; unsigned* ctl;
    int wave, vcu, G;
    unsigned char* ws; float* out;
};

__device__ __forceinline__ void p0_transpose_item(const float* W, const float* gain, int K, int N, bf16* WT, int qcols, float qscale, LAS float* scr, int item, int lane, int kvsplit = 0) {
    const int nblk = N / 32, kb = item / nblk, nb = item % nblk, k0 = 64 * kb, n0 = 32 * nb;
    const float cs = (n0 < qcols) ? qscale : 1.0f;
    float wv[32];
#pragma unroll
    for (int i = 0; i < 32; ++i) wv[i] = W[(size_t)(k0 + 2 * i + (lane >> 5)) * N + n0 + (lane & 31)];
    if (gain) {
#pragma unroll
        for (int i = 0; i < 32; ++i) wv[i] *= gain[k0 + 2 * i + (lane >> 5)];
    }
#pragma unroll
    for (int i = 0; i < 32; ++i) scr[(2 * i + (lane >> 5)) * 33 + (lane & 31)] = wv[i] * cs;
    asm volatile("s_waitcnt lgkmcnt(0)" ::: "memory");
    const int c = lane & 7;
#pragma unroll
    for (int j = 0; j < 4; ++j) { const int n = (lane >> 3) + 8 * j; const LAS float* s = scr + (8 * c) * 33 + n;
        u32x4 o; o.x = pk2(s[0 * 33], s[1 * 33]); o.y = pk2(s[2 * 33], s[3 * 33]); o.z = pk2(s[4 * 33], s[5 * 33]); o.w = pk2(s[6 * 33], s[7 * 33]);
        const int drow = kvsplit ? ((n0 < 1024) ? (n0 + n) : (n0 + n + 1024)) : (n0 + n);
        *(u32x4*)(WT + (size_t)drow * K + k0 + 8 * c) = o; }
    asm volatile("s_waitcnt lgkmcnt(0)" ::: "memory");
}

__device__ __forceinline__ void p0_prologue(Frame& F, const Args& a) {
    LAS float* scr = (LAS float*)(F.lds + F.wave * 16384);
    const int gw = F.vcu * NWAVES + F.wave, NGW = F.G * NWAVES, lane = lane_id_v();
    unsigned char* ws = F.ws;
    constexpr int I_IN0 = 16 * 80, I_OUT = 16 * 32, I_GLU = 8 * 16, I_IN1 = 16 * 128, I_QG = 16 * 64, I_KV = 16 * 64, I_O = 16 * 32;
    constexpr int NITEMS = I_IN0 + I_OUT + I_GLU + I_IN1 + I_OUT + 2 * I_QG + 2 * I_KV + 2 * I_O;
    for (int it = gw; it < NITEMS; it += NGW) {
        int r = it;
        if (r < I_IN0) { p0_transpose_item(a.in[4], a.in[3], DM, EVEN_IN, (bf16*)(ws + WS_W_IN0), 0, 1.f, scr, r, lane); continue; } r -= I_IN0;
        if (r < I_OUT) { p0_transpose_item(a.in[19], nullptr, DM, DM, (bf16*)(ws + WS_W_OUT0), 0, 1.f, scr, r, lane); continue; } r -= I_OUT;
        if (r < I_GLU) { p0_transpose_item(a.in[13], nullptr, S5W, S5W, (bf16*)(ws + WS_W_GLU), 0, 1.f, scr, r, lane); continue; } r -= I_GLU;
        if (r < I_IN1) { p0_transpose_item(a.in[21], a.in[20], DM, ODD_IN, (bf16*)(ws + WS_W_IN1), DM, QSCALE_ATT, scr, r, lane); continue; } r -= I_IN1;
        if (r < I_OUT) { p0_transpose_item(a.in[23], nullptr, DM, DM, (bf16*)(ws + WS_W_OUT1), 0, 1.f, scr, r, lane); continue; } r -= I_OUT;
        if (r < 2 * I_QG) { const int l = r / I_QG; p0_transpose_item(a.in[25] + (size_t)l * DM * 2048, a.in[24] + l * DM, DM, 2048, (bf16*)(ws + WS_W_QG) + (size_t)l * 2048 * DM, DM, QSCALE_XA, scr, r % I_QG, lane); continue; } r -= 2 * I_QG;
        if (r < 2 * I_KV) { const int l = r / I_KV; p0_transpose_item(a.in[26] + (size_t)l * DM * 2048, nullptr, DM, 2048, (bf16*)(ws + WS_W_KV) + (size_t)l * 1024 * DM, 0, 1.f, scr, r % I_KV, lane, 1); continue; } r -= 2 * I_KV;
        { const int l = r / I_O; p0_transpose_item(a.in[27] + (size_t)l * DM * DM, nullptr, DM, DM, (bf16*)(ws + WS_W_O) + (size_t)l * DM * DM, 0, 1.f, scr, r % I_O, lane); }
    }
    for (int m = gw; m < BATCH * MEMLEN; m += NGW) {
        const f32x4* xr = (const f32x4*)(a.in[1] + (size_t)m * DM) + lane; const f32x4* gr = (const f32x4*)a.in[2] + lane;
        f32x4 v[4]; float s = 0.f;
#pragma unroll
        for (int j = 0; j < 4; ++j) { v[j] = xr[64 * j]; s += (v[j].x * v[j].x + v[j].y * v[j].y) + (v[j].z * v[j].z + v[j].w * v[j].w); }
        const float rstd = 1.0f / sqrtf(wave_sum(s) * (1.f / DM) + EPS);
        u32x2* o8 = (u32x2*)((bf16*)(ws + WS_MEMN) + (size_t)m * DM) + lane;
#pragma unroll
        for (int j = 0; j < 4; ++j) { const f32x4 g = gr[64 * j]; u32x2 w; w.x = pk2(v[j].x * rstd * g.x, v[j].y * rstd * g.y); w.y = pk2(v[j].z * rstd * g.z, v[j].w * rstd * g.w); o8[64 * j] = w; }
    }
    for (int m0 = gw * 4; m0 < MTOK; m0 += NGW * 4) {
        f32x4 v[4][4];
#pragma unroll
        for (int q = 0; q < 4; ++q)
#pragma unroll
            for (int j = 0; j < 4; ++j) v[q][j] = ((const f32x4*)(a.in[0] + (size_t)(m0 + q) * DM) + lane)[64 * j];
#pragma unroll
        for (int q = 0; q < 4; ++q) {
            u32x2* o8 = (u32x2*)((bf16*)(ws + WS_XB) + (size_t)(m0 + q) * DM) + lane;
            float* rs = (float*)(ws + WS_RS) + (size_t)(m0 + q) * 16;
            float sj[4];
#pragma unroll
            for (int j = 0; j < 4; ++j) { const f32x4 x = v[q][j]; sj[j] = wave_sum((x.x * x.x + x.y * x.y) + (x.z * x.z + x.w * x.w));
                u32x2 w; w.x = pk2(x.x, x.y); w.y = pk2(x.z, x.w); o8[64 * j] = w; }
            if (lane < 16) rs[lane] = (lane & 3) ? 0.f : ((lane >> 2) == 0 ? sj[0] : ((lane >> 2) == 1 ? sj[1] : ((lane >> 2) == 2 ? sj[2] : sj[3])));
        }
    }
    {
        const int gt = (F.vcu * NWAVES + F.wave) * 64 + lane;
        if (gt < NGRP * NST) {
            const int g = gt >> 6;
            const float lr = a.in[5][gt], li = a.in[6][gt], dt = expf(a.in[7][g]);
            const float mag = expf(lr * dt); float sn, cs; sincosf(li * dt, &sn, &cs);
            const float are = mag * cs, aim = mag * sn;
            const float den = lr * lr + li * li, nr = are - 1.0f;
            const float cre = (nr * lr + aim * li) / den, cim = (aim * lr - nr * li) / den;
            float pr = are, pi = aim;
#pragma unroll
            for (int i = 0; i < 6; ++i) { const float t = pr * pr - pi * pi; pi = 2.f * pr * pi; pr = t; }
            ((f32x4*)(ws + WS_PAR))[gt] = (f32x4){are, aim, pr, pi};
            float* bb = (float*)(ws + WS_PAR + 65536) + (size_t)gt * 32;
            const float* br = a.in[8] + (size_t)gt * 16; const float* bi = a.in[9] + (size_t)gt * 16;
            const int p = gt & 63;
            bf16* bbt_re = (bf16*)(ws + WS_PAR + 524288) + (size_t)((g * 4 + 2 * (p >> 5)) * 32 + (p & 31)) * 16; bf16* bbt_im = bbt_re + 32 * 16;
#pragma unroll
            for (int c = 0; c < 16; ++c) { const float xr = cre * br[c] - cim * bi[c], xi = cre * bi[c] + cim * br[c]; bb[c] = xr; bb[16 + c] = xi; bbt_re[c] = (bf16)f2bf(xr); bbt_im[c] = (bf16)f2bf(xi); }
            bf16* cmt = (bf16*)(ws + WS_PAR + 655360) + (size_t)g * 16 * 128 + 2 * p;
#pragma unroll
            for (int co = 0; co < 16; ++co) { cmt[co * 128] = (bf16)f2bf(a.in[10][(size_t)(g * 16 + co) * 64 + p]); cmt[co * 128 + 1] = (bf16)f2bf(-a.in[11][(size_t)(g * 16 + co) * 64 + p]); }
        }
    }
}

#define S5_CMAC(dr, di, ar, ai, xr, xi) do { const float t_r = (ar) * (xr) - (ai) * (xi), t_i = (ar) * (xi) + (ai) * (xr); dr += t_r; di += t_i; } while (0)
template <bool FULL> __device__ __forceinline__ void s5_scan_tile(f32x16& zr, f32x16& zi, const float (&pw)[8], float& cr, float& ci, int hi) {
#pragma unroll
    for (int i = 0; i < 4; ++i)
#pragma unroll
        for (int e = 1; e < 4; ++e) S5_CMAC(zr[4 * i + e], zi[4 * i + e], pw[0], pw[1], zr[4 * i + e - 1], zi[4 * i + e - 1]);
#pragma unroll
    for (int i = 0; i < 4; ++i) {
        const auto xr = __builtin_amdgcn_permlane32_swap(__float_as_uint(zr[4 * i + 3]), __float_as_uint(zr[4 * i + 3]), false, false);
        const auto xi = __builtin_amdgcn_permlane32_swap(__float_as_uint(zi[4 * i + 3]), __float_as_uint(zi[4 * i + 3]), false, false);
        const float er = __uint_as_float(xr[0]), orr = __uint_as_float(xr[1]), ei = __uint_as_float(xi[0]), oi = __uint_as_float(xi[1]);
        float ner = er, nei = ei; S5_CMAC(ner, nei, pw[6], pw[7], cr, ci);
        const float cinr = hi ? ner : cr, cini = hi ? nei : ci;
        float nor = orr, noi = oi; S5_CMAC(nor, noi, pw[6], pw[7], ner, nei);
        cr = nor; ci = noi;
        if (FULL) {
#pragma unroll
            for (int e = 0; e < 4; ++e) S5_CMAC(zr[4 * i + e], zi[4 * i + e], pw[2 * e], pw[2 * e + 1], cinr, cini);
        }
    }
}
template <bool FULL> __device__ __forceinline__ void s5_phase(Frame& F, const Args& a) {
    const int gw = F.vcu * NWAVES + F.wave, NGW = F.G * NWAVES;
    const bf16* Z = (const bf16*)(F.ws + WS_Z); bf16* ZS = (bf16*)(F.ws + WS_ZS);
    f32x2* SR = (f32x2*)(F.ws + WS_SC);
    LAS unsigned char* const hb = F.lds + F.wave * (64 * 272);
    for (int wu = gw; wu < BATCH * NGRP * 16; wu += NGW) {
        const int lane = lane_id_v(), r = lane & 31, hi = lane >> 5;
        LAS unsigned char* const hbw = hb + (4 * hi) * 272 + r * 4; LAS unsigned char* const hbr = hb + (lane & 15) * 272 + (lane >> 4) * 16;
        const int rho = wu & 15, g = (wu >> 4) & 31, b = wu >> 9;
        const f32x4 pA = ((const f32x4*)(F.ws + WS_PAR))[g * 64 + r], pB = ((const f32x4*)(F.ws + WS_PAR))[g * 64 + 32 + r];
        float pwA[8], pwB[8];
        pwA[0] = pA.x; pwA[1] = pA.y; pwA[2] = pA.x * pA.x - pA.y * pA.y; pwA[3] = 2.f * pA.x * pA.y; pwA[4] = pwA[2] * pA.x - pwA[3] * pA.y; pwA[5] = pwA[2] * pA.y + pwA[3] * pA.x;
        pwA[6] = pwA[2] * pwA[2] - pwA[3] * pwA[3]; pwA[7] = 2.f * pwA[2] * pwA[3];
        pwB[0] = pB.x; pwB[1] = pB.y; pwB[2] = pB.x * pB.x - pB.y * pB.y; pwB[3] = 2.f * pB.x * pB.y; pwB[4] = pwB[2] * pB.x - pwB[3] * pB.y; pwB[5] = pwB[2] * pB.y + pwB[3] * pB.x;
        pwB[6] = pwB[2] * pwB[2] - pwB[3] * pwB[3]; pwB[7] = 2.f * pwB[2] * pwB[3];
        bf16x8 bbf[4];
#pragma unroll
        for (int ct = 0; ct < 4; ++ct) bbf[ct] = *(const bf16x8*)((const bf16*)(F.ws + WS_PAR + 524288) + (size_t)((g * 4 + ct) * 32 + r) * 16 + 8 * hi);
        bf16x8 cm[4]; f32x4 dsk = (f32x4){0.f, 0.f, 0.f, 0.f};
        float cAr = 0.f, cAi = 0.f, cBr = 0.f, cBi = 0.f;
        if (FULL) {
#pragma unroll
            for (int ks = 0; ks < 4; ++ks) cm[ks] = *(const bf16x8*)((const bf16*)(F.ws + WS_PAR + 655360) + (size_t)(g * 16 + (lane & 15)) * 128 + 32 * ks + 8 * (lane >> 4));
            dsk = *(const f32x4*)(a.in[12] + g * 16 + 4 * (lane >> 4));
            float qAr = pA.z, qAi = pA.w, qBr = pB.z, qBi = pB.w;
#pragma unroll
            for (int i = 0; i < 3; ++i) { float t = qAr * qAr - qAi * qAi; qAi = 2.f * qAr * qAi; qAr = t; t = qBr * qBr - qBi * qBi; qBi = 2.f * qBr * qBi; qBr = t; }
            const f32x2* sr = SR + (size_t)(wu - rho) * 64 + r;
            for (int j = 0; j < rho; ++j) { const f32x2 sA = sr[(size_t)j * 64], sB = sr[(size_t)j * 64 + 32];
                float nr = sA.x, ni = sA.y; S5_CMAC(nr, ni, qAr, qAi, cAr, cAi); cAr = nr; cAi = ni;
                nr = sB.x; ni = sB.y; S5_CMAC(nr, ni, qBr, qBi, cBr, cBi); cBr = nr; cBi = ni; }
        }
        for (int c8 = 0; c8 < 8; ++c8) {
            const size_t row0 = (size_t)b * SEQ + (size_t)(rho * 8 + c8) * 64;
#pragma unroll
            for (int tt = 0; tt < 2; ++tt) {
                const bf16x8 uf = *(const bf16x8*)(Z + (row0 + 32 * tt + r) * EVEN_IN + g * 16 + 8 * hi);
                f32x16 acc[4];
#pragma unroll
                for (int ct = 0; ct < 4; ++ct) {
#pragma unroll
                    for (int e = 0; e < 16; ++e) acc[ct][e] = 0.f;
                    acc[ct] = __builtin_amdgcn_mfma_f32_32x32x16_bf16(uf, bbf[ct], acc[ct], 0, 0, 0);
                }
                s5_scan_tile<FULL>(acc[0], acc[1], pwA, cAr, cAi, hi);
                s5_scan_tile<FULL>(acc[2], acc[3], pwB, cBr, cBi, hi);
                if (FULL) {
#pragma unroll
                    for (int e = 0; e < 16; ++e) { LAS unsigned char* rowp = hbw + (32 * tt + (e & 3) + 8 * (e >> 2)) * 272;
                        *(LAS unsigned*)(rowp) = pk2(acc[0][e], acc[1][e]);
                        *(LAS unsigned*)(rowp + 128) = pk2(acc[2][e], acc[3][e]); }
                }
                __builtin_amdgcn_sched_barrier(0);
            }
            if (FULL) {
                const int tl = lane & 15, kq = lane >> 4;
#pragma unroll
                for (int tk = 0; tk < 4; ++tk) {
                    f32x4 y = (f32x4){0.f, 0.f, 0.f, 0.f};
                    const int tok = 16 * tk + tl;
#pragma unroll
                    for (int ks = 0; ks < 4; ++ks) { const bf16x8 hf = *(const LAS bf16x8*)(hbr + tk * (16 * 272) + ks * 64);
                        y = __builtin_amdgcn_mfma_f32_16x16x32_bf16(cm[ks], hf, y, 0, 0, 0); }
                    const u32x2 uw = *(const u32x2*)(Z + (row0 + tok) * EVEN_IN + g * 16 + 4 * kq);
                    const float y0 = y[0] + dsk[0] * bflo(uw.x), y1 = y[1] + dsk[1] * bfhi(uw.x), y2 = y[2] + dsk[2] * bflo(uw.y), y3 = y[3] + dsk[3] * bfhi(uw.y);
                    u32x2 o; o.x = pk2(gelu_tanh(y0), gelu_tanh(y1)); o.y = pk2(gelu_tanh(y2), gelu_tanh(y3));
                    *(u32x2*)(ZS + (row0 + tok) * S5W + g * 16 + 4 * kq) = o;
                }
            }
        }
        if (!FULL) SR[(size_t)wu * 64 + r + 32 * hi] = hi ? (f32x2){cBr, cBi} : (f32x2){cAr, cAi};
    }
}

template <int S> __device__ __forceinline__ void conv_tap(float (&out)[64], const float (&w)[CONVK], const bf16* zrow0, int t0) {
    float v = 0.f;
    if (S >= 0 || t0 + S >= 0) { const bf16* zp = zrow0 + (long)S * EVEN_IN; v = bf2f(zp[1024]) * bf2f(zp[1536]); }
#pragma unroll
    for (int k = 0; k < CONVK; ++k) { const int t = S + 30 - k; if (t >= 0 && t < 64) out[t] += w[k] * v; }
}
template <int... I> __device__ __forceinline__ void conv_taps(std::integer_sequence<int, I...>, float (&out)[64], const float (&w)[CONVK], const bf16* zrow0, int t0) {
    (conv_tap<I - 30>(out, w, zrow0, t0), ...);
}
__device__ __forceinline__ void conv_phase(Frame& F, const Args& a) {
    const int lane = lane_id_v(), wave = F.wave, c = wave * 64 + lane;
    const bf16* Z = (const bf16*)(F.ws + WS_Z); bf16* Y = (bf16*)(F.ws + WS_Y);
    LAS f32x2* red = (LAS f32x2*)F.lds;
    LAS f32x2* stats = (LAS f32x2*)(F.lds + 4096);
    float w[CONVK];
#pragma unroll
    for (int k = 0; k < CONVK; ++k) w[k] = a.in[15][k * 512 + c];
    const float cb = a.in[16][c], lng = a.in[17][c], lnb = a.in[18][c];
    for (int tile = F.vcu; tile < BATCH * NCHUNK; tile += F.G) {
        const int b = tile >> 7, t0 = (tile & 127) * 64; const size_t row0 = (size_t)b * SEQ + t0;
        float out[64];
#pragma unroll
        for (int t = 0; t < 64; ++t) out[t] = cb;
        conv_taps(std::make_integer_sequence<int, 94>{}, out, w, Z + row0 * EVEN_IN + c, t0);
        float r1[64];
#pragma unroll
        for (int t = 0; t < 64; ++t) r1[t] = out[t];
#pragma unroll
        for (int half = 32; half >= 1; half >>= 1) { const bool up_ = (lane & half) != 0;
#pragma unroll
            for (int i = 0; i < half; ++i) { const float keep = up_ ? r1[i + half] : r1[i], send = up_ ? r1[i] : r1[i + half]; r1[i] = keep + __shfl_xor(send, half); } }
        const float s1 = r1[0];
#pragma unroll
        for (int t = 0; t < 64; ++t) r1[t] = out[t] * out[t];
#pragma unroll
        for (int half = 32; half >= 1; half >>= 1) { const bool up_ = (lane & half) != 0;
#pragma unroll
            for (int i = 0; i < half; ++i) { const float keep = up_ ? r1[i + half] : r1[i], send = up_ ? r1[i] : r1[i + half]; r1[i] = keep + __shfl_xor(send, half); } }
        const float s2 = r1[0];
        __syncthreads();
        red[wave * 64 + lane] = (f32x2){s1, s2};
        __syncthreads();
        if (wave == 0) { float q1 = 0.f, q2 = 0.f;
#pragma unroll
            for (int i = 0; i < 8; ++i) { const f32x2 p = red[i * 64 + lane]; q1 += p.x; q2 += p.y; }
            const float mu = q1 * (1.f / 512.f); const float var = fmaxf(q2 * (1.f / 512.f) - mu * mu, 0.f);
            stats[lane] = (f32x2){mu, 1.0f / sqrtf(var + EPS)}; }
        __syncthreads();
#pragma unroll
        for (int t = 0; t < 64; ++t) { const f32x2 st = stats[t]; const float cn = (out[t] - st.x) * st.y * lng + lnb;
            const float gt = bf2f(Z[(row0 + t) * EVEN_IN + 2048 + c]);
            Y[(row0 + t) * DM + 512 + c] = (bf16)f2bf(fast_silu(cn) * gt); }
    }
}

__device__ __forceinline__ s16x4 tr_read(const LAS unsigned char* p) { return __builtin_bit_cast(s16x4, __builtin_amdgcn_ds_read_tr16_b64_v4i16((LAS s16x4*)p)); }
__device__ __forceinline__ void chunk_attn_mfma(Frame& F, const Args& a) {
    const int w = F.wave;
    const int hh = w >> 2, cc = (w >> 1) & 1, half = w & 1;
    LAS unsigned char* const lds = F.lds; const unsigned lds0 = (unsigned)(uintptr_t)F.lds; LAS float* const btab = (LAS float*)(lds + 131072);
    const bf16* ZQ = (const bf16*)(F.ws + WS_Z); const bf16* ZK = ZQ + (size_t)MTOK * 1024; const bf16* ZV = ZK + (size_t)MTOK * 1024; const bf16* ZG = ZV + (size_t)MTOK * 1024;
    bf16* Y = (bf16*)(F.ws + WS_Y);
#define CA_DMA_TILE(trel) do { const int T_ = tbase + (trel); if (T_ >= 0) { _Pragma("unroll") for (int i_ = 0; i_ < 4; ++i_) { const int piece_ = 4 * w + i_, sub_ = piece_ >> 3; \
        const bf16* src_ = ((sub_ < 2) ? ZK : ZV) + (size_t)((b * 16 + 2 * hp + (sub_ & 1)) * 128 + T_) * 4096 + (piece_ & 7) * 512 + lane * 8; \
        glds16_asm(src_, (unsigned)__builtin_amdgcn_readfirstlane((int)(lds0 + ((trel) & 3) * 32768 + piece_ * 1024))); } } } while (0)
#define CA_WAITBAR(n) asm volatile("s_waitcnt vmcnt(" #n ") lgkmcnt(0)\n\ts_barrier" ::: "memory")
    for (int u = F.vcu; u < BATCH * 8 * 64; u += F.G) {
        const int cp = u & 63, hp = (u >> 6) & 7, b = u >> 9;
        const int c = 2 * cp + cc, h = 2 * hp + hh, tbase = 2 * cp - 8;
        const int lane = lane_id_v(), r = lane & 31, hi = lane >> 5;
        const int q4 = (lane & 15) >> 2, p4 = lane & 3, dsel = (lane >> 4) & 1, sw = (q4 >> 1) & 1;
        const int vlane = (4 * hi + q4) * 128 + (2 * dsel + (p4 >> 1)) * 16 + (p4 & 1) * 8;
        __syncthreads();
        for (int i = w * 64 + lane; i < 2 * 320; i += NWAVES * 64) { const int hs = i / 320, ix = i - hs * 320; btab[i] = a.in[22][(2 * hp + hs) * 257 + (ix > 256 ? 256 : ix)] * LOG2E; }
        const size_t qrow = (size_t)b * SEQ + c * 64 + half * 32 + r;
        bf16x8 qf0 = *(const bf16x8*)(ZQ + qrow * 1024 + h * 64 + 8 * hi), qf1 = *(const bf16x8*)(ZQ + qrow * 1024 + h * 64 + 16 + 8 * hi);
        bf16x8 qf2 = *(const bf16x8*)(ZQ + qrow * 1024 + h * 64 + 32 + 8 * hi), qf3 = *(const bf16x8*)(ZQ + qrow * 1024 + h * 64 + 48 + 8 * hi);
        CA_DMA_TILE(0); CA_DMA_TILE(1); CA_DMA_TILE(2);
        if (tbase + 2 >= 0) CA_WAITBAR(4); else CA_WAITBAR(0);
        asm volatile("" : "+v"(qf0), "+v"(qf1), "+v"(qf2), "+v"(qf3));
        const float cfar = btab[hh * 320 + 256];
        float m = 0.f, l = 0.f; bool first = true;
        f32x16 o0, o1, negm;
#pragma unroll
        for (int e = 0; e < 16; ++e) { o0[e] = 0.f; o1[e] = 0.f; negm[e] = cfar; }
#pragma unroll
        for (int s = 0; s < 9; ++s) {
            const bool issue = (s + 3 <= 9) && (tbase + s + 3 >= 0);
            if (s + 3 <= 9) CA_DMA_TILE(s + 3);
            const int T = tbase + s + cc;
            if (T >= 0) {
                const int bsel = (s + cc) & 3;
                const LAS unsigned char* kb = lds + bsel * 32768 + hh * 8192 + (hi * 64 + r) * 16;
                const LAS unsigned char* vb = lds + bsel * 32768 + 16384 + hh * 8192 + vlane;
                f32x16 p0, p1;
                if (s >= 6) {
                    const LAS float* bp = btab + hh * 320 + (64 * (8 - s) + half * 32 + r - 4 * hi + 128 - 27 - 32);
#pragma unroll
                    for (int e = 0; e < 16; ++e) { const int ko = (e & 3) + 8 * (e >> 2); p0[e] = bp[27 + 32 - ko] - m; p1[e] = bp[27 - ko] - m; }
                } else { p0 = negm; p1 = negm; }
#pragma unroll
                for (int s4 = 0; s4 < 4; ++s4) {
                    const bf16x8 qf = s4 == 0 ? qf0 : (s4 == 1 ? qf1 : (s4 == 2 ? qf2 : qf3));
                    const bf16x8 k0 = *(const LAS bf16x8*)(kb + (2 * s4) * 1024), k1 = *(const LAS bf16x8*)(kb + (2 * s4) * 1024 + 512);
                    p0 = __builtin_amdgcn_mfma_f32_32x32x16_bf16(k0, qf, p0, 0, 0, 0);
                    p1 = __builtin_amdgcn_mfma_f32_32x32x16_bf16(k1, qf, p1, 0, 0, 0);
                }
                asm volatile("s_nop 15\n\ts_nop 7" : "+v"(p0), "+v"(p1));
                float rm = max3_asm(p0[0], p0[1], p1[0]), rm2 = max3_asm(p0[2], p0[3], p1[1]); rm = max3_asm(rm, p1[2], p1[3]);
#pragma unroll
                for (int e = 4; e < 16; e += 4) { rm = max3_asm(rm, p0[e], p0[e + 1]); rm2 = max3_asm(rm2, p0[e + 2], p0[e + 3]); rm = max3_asm(rm, p1[e], p1[e + 1]); rm2 = max3_asm(rm2, p1[e + 2], p1[e + 3]); }
                rm = max2_asm(rm, rm2);
                { const auto rr = __builtin_amdgcn_permlane32_swap(__float_as_uint(rm), __float_as_uint(rm), false, false); rm = max2_asm(__uint_as_float(rr[0]), __uint_as_float(rr[1])); }
                if (first) {
                    m = rm;
#pragma unroll
                    for (int e = 0; e < 16; ++e) { p0[e] -= rm; p1[e] -= rm; negm[e] = cfar - m; }
                    first = false;
                } else if (__any(rm > 0.f)) {
                    const float dl = fmaxf(rm, 0.f), al = __builtin_amdgcn_exp2f(-dl);
                    m += dl; l *= al;
#pragma unroll
                    for (int e = 0; e < 16; ++e) { p0[e] -= dl; p1[e] -= dl; o0[e] *= al; o1[e] *= al; negm[e] = cfar - m; }
                }
                float ps = 0.f;
#pragma unroll
                for (int e = 0; e < 16; ++e) { p0[e] = __builtin_amdgcn_exp2f(p0[e]); p1[e] = __builtin_amdgcn_exp2f(p1[e]); ps += p0[e] + p1[e]; }
                l += ps;
                u32x4 pf[2][2];
#pragma unroll
                for (int s2 = 0; s2 < 2; ++s2) {
                    u32x4 t; t.x = pk2(p0[8 * s2 + 0], p0[8 * s2 + 1]); t.y = pk2(p0[8 * s2 + 2], p0[8 * s2 + 3]); t.z = pk2(p0[8 * s2 + 4], p0[8 * s2 + 5]); t.w = pk2(p0[8 * s2 + 6], p0[8 * s2 + 7]); pf[0][s2] = t;
                    u32x4 v; v.x = pk2(p1[8 * s2 + 0], p1[8 * s2 + 1]); v.y = pk2(p1[8 * s2 + 2], p1[8 * s2 + 3]); v.z = pk2(p1[8 * s2 + 4], p1[8 * s2 + 5]); v.w = pk2(p1[8 * s2 + 6], p1[8 * s2 + 7]); pf[1][s2] = v;
                }
#pragma unroll
                for (int kh = 0; kh < 2; ++kh)
#pragma unroll
                    for (int s2 = 0; s2 < 2; ++s2) {
                        const LAS unsigned char* vk = vb + (32 * kh + 16 * s2) * 128;
                        const s16x4 a0 = tr_read(vk + sw * 64), a1 = tr_read(vk + 8 * 128 + sw * 64);
                        const s16x4 c0 = tr_read(vk + (1 - sw) * 64), c1 = tr_read(vk + 8 * 128 + (1 - sw) * 64);
                        const bf16x8 vf0 = (bf16x8){a0[0], a0[1], a0[2], a0[3], a1[0], a1[1], a1[2], a1[3]};
                        const bf16x8 vf1 = (bf16x8){c0[0], c0[1], c0[2], c0[3], c1[0], c1[1], c1[2], c1[3]};
                        o0 = __builtin_amdgcn_mfma_f32_32x32x16_bf16(vf0, __builtin_bit_cast(bf16x8, pf[kh][s2]), o0, 0, 0, 0);
                        o1 = __builtin_amdgcn_mfma_f32_32x32x16_bf16(vf1, __builtin_bit_cast(bf16x8, pf[kh][s2]), o1, 0, 0, 0);
                    }
            }
            __builtin_amdgcn_sched_barrier(0);
            if (s < 8) { if (issue) CA_WAITBAR(4); else CA_WAITBAR(0); }
        }
        { const auto rr = __builtin_amdgcn_permlane32_swap(__float_as_uint(l), __float_as_uint(l), false, false); l = __uint_as_float(rr[0]) + __uint_as_float(rr[1]); }
        const float rl = 1.0f / l;
        const bf16* gp = ZG + qrow * 1024 + h * 64 + 4 * hi; bf16* yp = Y + qrow * DM + h * 64 + 4 * hi;
#pragma unroll
        for (int i = 0; i < 4; ++i) {
            const u32x2 g0 = *(const u32x2*)(gp + 8 * i), g1 = *(const u32x2*)(gp + 32 + 8 * i);
            u32x2 y0, y1;
            y0.x = pk2(o0[4 * i] * rl * bflo(g0.x), o0[4 * i + 1] * rl * bfhi(g0.x)); y0.y = pk2(o0[4 * i + 2] * rl * bflo(g0.y), o0[4 * i + 3] * rl * bfhi(g0.y));
            y1.x = pk2(o1[4 * i] * rl * bflo(g1.x), o1[4 * i + 1] * rl * bfhi(g1.x)); y1.y = pk2(o1[4 * i + 2] * rl * bflo(g1.y), o1[4 * i + 3] * rl * bfhi(g1.y));
            *(u32x2*)(yp + 8 * i) = y0; *(u32x2*)(yp + 32 + 8 * i) = y1;
        }
    }
#undef CA_DMA_TILE
#undef CA_WAITBAR
}

__device__ __forceinline__ void xattn_mfma(Frame& F, int layer) {
    const int w = F.wave;
    const bf16* QG = (const bf16*)(F.ws + WS_Z); bf16* Y = (bf16*)(F.ws + WS_Y);
    LAS unsigned char* const lds = F.lds;
#define XA_DMA_K(ds, bufoff) do { _Pragma("unroll") for (int i_ = 0; i_ < 4; ++i_) { const int piece_ = w * 4 + i_; \
        __builtin_amdgcn_global_load_lds((const unsigned*)(kbase + (size_t)(ds) * 16384 + piece_ * 512 + lane * 8), (LAS unsigned*)(lds + (bufoff) + piece_ * 1024), 16, 0, 0); } } while (0)
#define XA_DMA_V(ds, bufoff) do { _Pragma("unroll") for (int i_ = 0; i_ < 4; ++i_) { const int piece_ = w * 4 + i_, p_ = piece_ * 64 + lane, kg_ = p_ >> 5, dp_ = p_ & 31; \
        __builtin_amdgcn_global_load_lds((const unsigned*)(vbase + ((size_t)kg_ * 256 + 64 * (ds) + 2 * dp_) * 4), (LAS unsigned*)(lds + (bufoff) + piece_ * 1024), 16, 0, 0); } } while (0)
    for (int u = F.vcu; u < BATCH * 4 * (SEQ / 256); u += F.G) {
        const int qb = u & 31, hx = (u >> 5) & 3, b = u >> 7;
        const int lane = lane_id_v(), r = lane & 31, hi = lane >> 5;
        const size_t qrow = (size_t)b * SEQ + qb * 256 + w * 32 + r;
        const bf16* qptr = QG + qrow * 2048 + hx * 256 + 8 * hi;
        const bf16* kbase = (const bf16*)(F.ws + WS_KP) + (size_t)((layer * 4 + b) * 4 + hx) * (32 * 256 * 8);
        const bf16* vbase = (const bf16*)(F.ws + WS_VP) + (size_t)((layer * 4 + b) * 4 + hx) * (64 * 256 * 4);
        f32x16 sacc[8];
#pragma unroll
        for (int kt = 0; kt < 8; ++kt)
#pragma unroll
            for (int e = 0; e < 16; ++e) sacc[kt][e] = 0.f;
        bf16x8 qn[4];
#pragma unroll
        for (int s = 0; s < 4; ++s) qn[s] = *(const bf16x8*)(qptr + 16 * s);
        XA_DMA_K(0, 0);
#pragma unroll
        for (int ds = 0; ds < 4; ++ds) {
            __syncthreads();
            bf16x8 qf[4];
#pragma unroll
            for (int s = 0; s < 4; ++s) qf[s] = qn[s];
            if (ds < 3) {
#pragma unroll
                for (int s = 0; s < 4; ++s) qn[s] = *(const bf16x8*)(qptr + 64 * (ds + 1) + 16 * s);
                XA_DMA_K(ds + 1, ((ds + 1) & 1) * 32768);
            } else { XA_DMA_V(0, 0); }
            const LAS unsigned char* kb = lds + (ds & 1) * 32768 + (hi * 256 + r) * 16;
#pragma unroll
            for (int kt = 0; kt < 8; ++kt)
#pragma unroll
                for (int s = 0; s < 4; ++s) {
                    const bf16x8 kf = *(const LAS bf16x8*)(kb + (2 * s * 256 + 32 * kt) * 16);
                    sacc[kt] = __builtin_amdgcn_mfma_f32_32x32x16_bf16(kf, qf[s], sacc[kt], 0, 0, 0);
                }
        }
        float m = sacc[0][0];
#pragma unroll
        for (int kt = 0; kt < 8; ++kt)
#pragma unroll
            for (int e = 0; e < 16; ++e) m = fmaxf(m, sacc[kt][e]);
        m = fmaxf(m, __shfl_xor(m, 32));
        float l = 0.f;
        u32x4 pf[8][2];
#pragma unroll
        for (int kt = 0; kt < 8; ++kt) {
#pragma unroll
            for (int e = 0; e < 16; ++e) { const float p = __builtin_amdgcn_exp2f(sacc[kt][e] - m); sacc[kt][e] = p; l += p; }
#pragma unroll
            for (int s2 = 0; s2 < 2; ++s2) { u32x4 t; t.x = pk2(sacc[kt][8 * s2 + 0], sacc[kt][8 * s2 + 1]); t.y = pk2(sacc[kt][8 * s2 + 2], sacc[kt][8 * s2 + 3]);
                t.z = pk2(sacc[kt][8 * s2 + 4], sacc[kt][8 * s2 + 5]); t.w = pk2(sacc[kt][8 * s2 + 6], sacc[kt][8 * s2 + 7]); pf[kt][s2] = t; }
        }
        l += __shfl_xor(l, 32);
        const float rl = 1.0f / l;
        __builtin_amdgcn_sched_barrier(0);
        const bf16* gp = QG + qrow * 2048 + 1024 + hx * 256 + 4 * hi; bf16* yp = Y + qrow * DM + hx * 256 + 4 * hi;
        u32x2 gq[8][4];
#pragma unroll
        for (int t = 0; t < 8; ++t)
#pragma unroll
            for (int i = 0; i < 4; ++i) gq[t][i] = *(const u32x2*)(gp + 32 * t + 8 * i);
        __builtin_amdgcn_sched_barrier(0);
#pragma unroll
        for (int ds = 0; ds < 4; ++ds) {
            __syncthreads();
            if (ds < 3) XA_DMA_V(ds + 1, ((ds + 1) & 1) * 32768);
            const LAS unsigned char* vb = lds + (ds & 1) * 32768 + (hi * 64 + r) * 8;
#pragma unroll
            for (int dt = 0; dt < 2; ++dt) {
                f32x16 oacc;
#pragma unroll
                for (int e = 0; e < 16; ++e) oacc[e] = 0.f;
#pragma unroll
                for (int kt = 0; kt < 8; ++kt)
#pragma unroll
                    for (int s2 = 0; s2 < 2; ++s2) {
                        const int kg = 8 * kt + 4 * s2;
                        const s16x4 v0 = *(const LAS s16x4*)(vb + (kg * 64 + 32 * dt) * 8), v1 = *(const LAS s16x4*)(vb + ((kg + 2) * 64 + 32 * dt) * 8);
                        const bf16x8 vf = (bf16x8){v0[0], v0[1], v0[2], v0[3], v1[0], v1[1], v1[2], v1[3]};
                        oacc = __builtin_amdgcn_mfma_f32_32x32x16_bf16(vf, __builtin_bit_cast(bf16x8, pf[kt][s2]), oacc, 0, 0, 0);
                    }
                const int t = 2 * ds + dt;
#pragma unroll
                for (int i = 0; i < 4; ++i) {
                    const u32x2 gw = gq[t][i];
                    const float g0 = bflo(gw.x), g1 = bfhi(gw.x), g2 = bflo(gw.y), g3 = bfhi(gw.y);
                    u32x2 o; o.x = pk2(oacc[4 * i] * rl * g0, oacc[4 * i + 1] * rl * g1); o.y = pk2(oacc[4 * i + 2] * rl * g2, oacc[4 * i + 3] * rl * g3);
                    *(u32x2*)(yp + 32 * t + 8 * i) = o;
                }
                __builtin_amdgcn_sched_barrier(0);
            }
        }
    }
#undef XA_DMA_K
#undef XA_DMA_V
}

__device__ __forceinline__ void final_norm(Frame& F, const Args& a) {
    const int gw = F.vcu * NWAVES + F.wave, NGW = F.G * NWAVES, lane = lane_id_v();
    const f32x4* gr = (const f32x4*)a.in[28] + lane;
    for (int m = gw; m < MTOK; m += NGW) {
        f32x4* xr = (f32x4*)(F.out + (size_t)m * DM) + lane;
        f32x4 v[4]; float s = 0.f;
#pragma unroll
        for (int j = 0; j < 4; ++j) { v[j] = xr[64 * j]; s += (v[j].x * v[j].x + v[j].y * v[j].y) + (v[j].z * v[j].z + v[j].w * v[j].w); }
        const float rstd = 1.0f / sqrtf(wave_sum(s) * (1.f / DM) + EPS);
#pragma unroll
        for (int j = 0; j < 4; ++j) { const f32x4 g = gr[64 * j]; xr[64 * j] = (f32x4){v[j].x * rstd * g.x, v[j].y * rstd * g.y, v[j].z * rstd * g.z, v[j].w * rstd * g.w}; }
    }
}

constexpr int NPH = 15;
__global__ void __launch_bounds__(NWAVES * 64, 2) trunk_fwd(Args args) {
    extern __shared__ __attribute__((aligned(16))) unsigned char lds[];
    Frame F;
    F.lds = (LAS unsigned char*)lds;
    F.MISC = (volatile LAS unsigned*)(F.lds + MISC_OFF);
    F.wave = __builtin_amdgcn_readfirstlane(threadIdx.x >> 6);
    F.G = gridDim.x; { const int bx = blockIdx.x; F.vcu = (F.G % 8 == 0) ? (bx % 8) * (F.G / 8) + bx / 8 : bx; }
    F.ws = args.ws; F.out = args.out; F.ctl = (unsigned*)(args.ws + WS_CTL);
    for (int u = threadIdx.x; u < (LDS_BYTES - LDSCTL_OFF) / 4; u += NWAVES * 64) ((LAS unsigned*)(F.lds + LDSCTL_OFF))[u] = 0u;
    __syncthreads();
    const int lo = args.ph_lo, hi = args.ph_hi;
    const bool multi = (hi - lo) > 1;
    XcdBarrier bar; bar.bar = F.ctl + CW_BAR; bar.x = 0; bar.st = nullptr;
    if (multi) bar = xcd_barrier_post(F.ctl + CW_BAR, F.MISC + 8);
#define IN(k) (lo <= (k) && (k) < hi)
#define DUP(k) for (int rep_ = 0; rep_ < (((DUP_MASK >> (k)) & 1u) ? 2 : 1); ++rep_)
#define SEAM(k) do { if (IN(k) && IN((k) + 1)) xcd_barrier(bar); } while (0)
    unsigned char* ws = args.ws;
    bf16* const XB = (bf16*)(ws + WS_XB); bf16* const Y = (bf16*)(ws + WS_Y); bf16* const Z = (bf16*)(ws + WS_Z); bf16* const ZS = (bf16*)(ws + WS_ZS);
    float* const RS = (float*)(ws + WS_RS);
    pg8::Epi E0{}; E0.mode = 0; E0.perm = true;
    pg8::Epi E1{}; E1.mode = 1; E1.perm = false; E1.xout = args.out; E1.xb = XB; E1.rsout = RS; E1.xold = args.out;

    if (IN(0)) DUP(0) { p0_prologue(F, args); __syncthreads(); } SEAM(0);
    if (IN(1)) DUP(1) {
        { pg8::Gemm g{XB, (const bf16*)(ws + WS_W_IN0), MTOK, EVEN_IN, DM}; pg8::StaticOrder S; S.init(MTOK, EVEN_IN, F.G, (int)blockIdx.x);
          pg8::Epi E = E0; E.O = Z; E.ldc = EVEN_IN; E.rs = RS; E.act_silu = 0x30Cu; E.act_sig = 0xC0u; pg8::gemm_phase(F.lds, g, S, E); }
        { pg8::Gemm g{(const bf16*)(ws + WS_MEMN), (const bf16*)(ws + WS_W_KV), BATCH * MEMLEN, 2048, DM}; pg8::StaticOrder S; S.init(BATCH * MEMLEN, 2048, F.G, (int)blockIdx.x);
          pg8::Epi E = E0; E.mode = 3; E.O = (bf16*)(ws + WS_KP); pg8::gemm_phase(F.lds, g, S, E); }
        { pg8::Gemm g{(const bf16*)(ws + WS_W_KV) + (size_t)2048 * DM, (const bf16*)(ws + WS_MEMN), 2048, BATCH * MEMLEN, DM}; pg8::StaticOrder S; S.init(2048, BATCH * MEMLEN, F.G, (int)((blockIdx.x + F.G - 32) % F.G));
          pg8::Epi E = E0; E.mode = 4; E.O = (bf16*)(ws + WS_VP); pg8::gemm_phase(F.lds, g, S, E); }
    } SEAM(1);
    if (IN(2)) DUP(2) { s5_phase<false>(F, args); conv_phase(F, args); __syncthreads(); } SEAM(2);
    if (IN(3)) DUP(3) { s5_phase<true>(F, args); __syncthreads(); } SEAM(3);
    if (IN(4)) DUP(4) { pg8::Gemm g{ZS, (const bf16*)(ws + WS_W_GLU), MTOK, S5W, S5W}; pg8::StaticOrder S; S.init(MTOK, S5W, F.G, (int)blockIdx.x);
        pg8::Epi E{}; E.mode = 2; E.perm = true; E.O = Y; E.ldc = DM; E.zs = ZS; E.gatep = Z + 512; E.gate_ld = EVEN_IN; E.gb = args.in[14];
        pg8::gemm_phase(F.lds, g, S, E); } SEAM(4);
    if (IN(5)) DUP(5) { pg8::Gemm g{Y, (const bf16*)(ws + WS_W_OUT0), MTOK, DM, DM}; pg8::StaticOrder S; S.init(MTOK, DM, F.G, (int)blockIdx.x);
        pg8::Epi E = E1; E.xold = args.in[0]; pg8::gemm_phase(F.lds, g, S, E); } SEAM(5);
    if (IN(6)) DUP(6) { pg8::Gemm g{XB, (const bf16*)(ws + WS_W_QG), MTOK, 2048, DM}; pg8::StaticOrder S; S.init(MTOK, 2048, F.G, (int)blockIdx.x);
        pg8::Epi E = E0; E.O = Z; E.ldc = 2048; E.rs = RS; E.act_silu = 0xF0u; pg8::gemm_phase(F.lds, g, S, E); } SEAM(6);
    if (IN(7)) DUP(7) { xattn_mfma(F, 0); __syncthreads(); } SEAM(7);
    if (IN(8)) { pg8::Gemm g{Y, (const bf16*)(ws + WS_W_O), MTOK, DM, DM}; pg8::StaticOrder S; S.init(MTOK, DM, F.G, (int)blockIdx.x);
        pg8::gemm_phase(F.lds, g, S, E1); } SEAM(8);
    if (IN(9)) DUP(9) { pg8::Gemm g{XB, (const bf16*)(ws + WS_W_IN1), MTOK, ODD_IN, DM}; pg8::StaticOrder S; S.init(MTOK, ODD_IN, F.G, (int)blockIdx.x);
        pg8::Epi E = E0; E.mode = 5; E.O = Z; E.rs = RS; pg8::gemm_phase(F.lds, g, S, E); } SEAM(9);
    if (IN(10)) DUP(10) { chunk_attn_mfma(F, args); __syncthreads(); } SEAM(10);
    if (IN(11)) { pg8::Gemm g{Y, (const bf16*)(ws + WS_W_OUT1), MTOK, DM, DM}; pg8::StaticOrder S; S.init(MTOK, DM, F.G, (int)blockIdx.x);
        pg8::gemm_phase(F.lds, g, S, E1); } SEAM(11);
    if (IN(12)) { pg8::Gemm g{XB, (const bf16*)(ws + WS_W_QG) + (size_t)2048 * DM, MTOK, 2048, DM}; pg8::StaticOrder S; S.init(MTOK, 2048, F.G, (int)blockIdx.x);
        pg8::Epi E = E0; E.O = Z; E.ldc = 2048; E.rs = RS; E.act_silu = 0xF0u; pg8::gemm_phase(F.lds, g, S, E); } SEAM(12);
    if (IN(13)) { xattn_mfma(F, 1); } SEAM(13);
    if (IN(14)) { pg8::Gemm g{Y, (const bf16*)(ws + WS_W_O) + (size_t)DM * DM, MTOK, DM, DM}; pg8::StaticOrder S; S.init(MTOK, DM, F.G, (int)blockIdx.x);
        pg8::Epi E = E1; E.mode = 6; E.fin_g = args.in[28]; E.fin_cnt = F.ctl + CW_FIN; E.fin_out = args.out; pg8::gemm_phase(F.lds, g, S, E); }
#undef IN
#undef SEAM
}

extern "C" void kernel_launch(void* const* d_in, const int* in_sizes, int n_in, void* d_out, int out_size, void* d_ws, size_t ws_size, hipStream_t stream) {
    static int grid = 0;
    if (grid == 0) {
        if (n_in != 29 || out_size != MTOK * DM || ws_size < WS_END) { fprintf(stderr, "kernel_launch: unexpected shapes: n_in %d out %d ws %zu\n", n_in, out_size, ws_size); grid = -1; return; }
        int dev = 0, cus = 0, per_cu = 0;
        if (hipGetDevice(&dev) != hipSuccess || hipDeviceGetAttribute(&cus, hipDeviceAttributeMultiprocessorCount, dev) != hipSuccess) { grid = -1; return; }
        if (hipFuncSetAttribute((const void*)trunk_fwd, hipFuncAttributeMaxDynamicSharedMemorySize, LDS_BYTES) != hipSuccess) { fprintf(stderr, "kernel_launch: hipFuncSetAttribute failed\n"); grid = -1; return; }
        if (hipOccupancyMaxActiveBlocksPerMultiprocessor(&per_cu, (const void*)trunk_fwd, NWAVES * 64, LDS_BYTES) != hipSuccess || per_cu < 1) { fprintf(stderr, "kernel_launch: occupancy query reports %d\n", per_cu); per_cu = 1; }
        (void)hipGetLastError();
        grid = cus;
        if (grid > cus * per_cu) grid = cus * per_cu;
    }
    if (grid < 0) return;
    (void)hipMemsetAsync((char*)d_ws + WS_CTL, 0, CTL_ZERO_BYTES, stream);
    Args a{};
    for (int i = 0; i < 29; ++i) a.in[i] = (const float*)d_in[i];
    a.out = (float*)d_out; a.ws = (unsigned char*)d_ws;
    if (MK_N_LAUNCHES == 1) { a.ph_lo = 0; a.ph_hi = NPH; hipLaunchKernelGGL(trunk_fwd, dim3(grid), dim3(NWAVES * 64), LDS_BYTES, stream, a); }
    else { for (int p = 0; p < NPH; ++p) { a.ph_lo = p; a.ph_hi = p + 1; hipLaunchKernelGGL(trunk_fwd, dim3(grid), dim3(NWAVES * 64), LDS_BYTES, stream, a); } }
}
```

```cpp
#include <hip/hip_runtime.h>
#include <cstdio>
#include <cstdint>
#include <utility>

#ifndef MK_N_LAUNCHES
#define MK_N_LAUNCHES 1
#endif
#ifndef STAGGER_US
#define STAGGER_US 0
#endif
#ifndef CA_PROBE
#define CA_PROBE 0
#endif
#ifndef DUP_MASK
#define DUP_MASK 0u
#endif

#define GAS __attribute__((address_space(1)))
#define LAS __attribute__((address_space(3)))
typedef unsigned short bf16;
typedef short bf16x8 __attribute__((ext_vector_type(8)));
typedef float f32x4 __attribute__((ext_vector_type(4)));
typedef float f32x2 __attribute__((ext_vector_type(2)));
typedef unsigned u32x4 __attribute__((ext_vector_type(4)));
typedef unsigned u32x2 __attribute__((ext_vector_type(2)));
typedef float f32x16 __attribute__((ext_vector_type(16)));
typedef short s16x4 __attribute__((ext_vector_type(4)));
__host__ __device__ __forceinline__ int crow16(int reg, int hi) { return (reg & 3) + 8 * (reg >> 2) + 4 * hi; }

constexpr int BATCH = 4, SEQ = 8192, DM = 1024, MTOK = BATCH * SEQ;
constexpr int EVEN_IN = 2560, ODD_IN = 4096, S5W = 512, NGRP = 32, NST = 64, CONVK = 31;
constexpr int MEMLEN = 256, NCHUNK = SEQ / 64;
constexpr float EPS = 1e-6f, LOG2E = 1.4426950408889634f;
constexpr float QSCALE_ATT = 0.125f * LOG2E;
constexpr float QSCALE_XA = 0.0625f * LOG2E;
constexpr int NWAVES = 8;

constexpr size_t MiB = 1u << 20;
constexpr size_t WS_CTL = 0, CTL_ZERO_BYTES = 1 * MiB;
constexpr size_t WS_W_IN0 = 2 * MiB, WS_W_OUT0 = 7 * MiB, WS_W_GLU = 9 * MiB, WS_W_IN1 = 10 * MiB, WS_W_OUT1 = 18 * MiB;
constexpr size_t WS_W_QG = 20 * MiB, WS_W_KV = 28 * MiB, WS_W_O = 36 * MiB, WS_MEMN = 40 * MiB, WS_KP = 42 * MiB, WS_VP = 46 * MiB;
constexpr size_t WS_PAR = 50 * MiB, WS_RS = 51 * MiB, WS_SC = 53 * MiB;
constexpr size_t WS_XB = 64 * MiB, WS_Y = 128 * MiB, WS_ZS = 192 * MiB, WS_Z = 224 * MiB, WS_END = 480 * MiB;
constexpr int CW_BAR = 4096, CW_FIN = 8192;

constexpr int RING_BYTES = 143360, LDSCTL_OFF = RING_BYTES, MISC_OFF = LDSCTL_OFF + 320, RSTD_OFF = 147456, LDS_BYTES = 163840;

#define RLX_AGENT __ATOMIC_RELAXED, __HIP_MEMORY_SCOPE_AGENT
__device__ __forceinline__ unsigned f2bf(float f) { unsigned u = __builtin_bit_cast(unsigned, f); return (u + 0x7fffu + ((u >> 16) & 1u)) >> 16; }
typedef __bf16 bf16x2_t __attribute__((ext_vector_type(2)));
__device__ __forceinline__ unsigned pk2(float lo, float hi) { const f32x2 v = {lo, hi}; const bf16x2_t b = __builtin_convertvector(v, bf16x2_t); return __builtin_bit_cast(unsigned, b); }
__device__ __forceinline__ float bflo(unsigned w) { return __uint_as_float(w << 16); }
__device__ __forceinline__ float bfhi(unsigned w) { return __uint_as_float(w & 0xffff0000u); }
__device__ __forceinline__ float bf2f(unsigned short b) { return __uint_as_float((unsigned)b << 16); }
__device__ __forceinline__ int lane_id_v() { int l; asm volatile("v_mbcnt_lo_u32_b32 %0, -1, 0\n\tv_mbcnt_hi_u32_b32 %0, -1, %0" : "=v"(l)); return l; }
__device__ __forceinline__ bf16x8 gload16_asm(const void* p) { bf16x8 v; asm volatile("global_load_dwordx4 %0, %1, off" : "=v"(v) : "v"(p) : "memory"); return v; }
__device__ __forceinline__ void glds16_asm(const void* gsrc, unsigned lds_dst) { unsigned keep;
    asm volatile("s_mov_b32 %0, m0\n\ts_mov_b32 m0, %2\n\ts_nop 0\n\tglobal_load_lds_dwordx4 %1, off\n\ts_mov_b32 m0, %0" : "=&s"(keep) : "v"(gsrc), "s"(lds_dst) : "memory"); }
__device__ __forceinline__ float max3_asm(float a, float b, float c) { float r; asm("v_max3_f32 %0, %1, %2, %3" : "=v"(r) : "v"(a), "v"(b), "v"(c)); return r; }
__device__ __forceinline__ float max2_asm(float a, float b) { float r; asm("v_max_f32_e32 %0, %1, %2" : "=v"(r) : "v"(a), "v"(b)); return r; }
__device__ __forceinline__ int opaque0() { int z; asm volatile("v_mov_b32 %0, 0" : "=v"(z)); return z; }
__device__ __forceinline__ float fast_sigmoid(float x) { return __builtin_amdgcn_rcpf(1.0f + __builtin_amdgcn_exp2f(-x * LOG2E)); }
__device__ __forceinline__ float fast_silu(float x) { return x * fast_sigmoid(x); }
__device__ __forceinline__ float gelu_tanh(float y) { const float x = 0.7978845608028654f * (y + 0.044715f * y * y * y); return y * fast_sigmoid(2.0f * x); }
__device__ __forceinline__ float wave_sum(float v) {
    v += __builtin_bit_cast(float, __builtin_amdgcn_update_dpp(0, __builtin_bit_cast(int, v), 0xB1, 0xF, 0xF, true));
    v += __builtin_bit_cast(float, __builtin_amdgcn_update_dpp(0, __builtin_bit_cast(int, v), 0x4E, 0xF, 0xF, true));
    v += __builtin_bit_cast(float, __builtin_amdgcn_update_dpp(0, __builtin_bit_cast(int, v), 0x141, 0xF, 0xF, true));
    v += __builtin_bit_cast(float, __builtin_amdgcn_update_dpp(0, __builtin_bit_cast(int, v), 0x140, 0xF, 0xF, true));
    const int b = __builtin_bit_cast(int, v);
    const float r0 = __builtin_bit_cast(float, __builtin_amdgcn_readlane(b, 0)), r1 = __builtin_bit_cast(float, __builtin_amdgcn_readlane(b, 16));
    const float r2 = __builtin_bit_cast(float, __builtin_amdgcn_readlane(b, 32)), r3 = __builtin_bit_cast(float, __builtin_amdgcn_readlane(b, 48));
    return (r0 + r1) + (r2 + r3);
}
__device__ __forceinline__ void unpack8(const u32x4 w, float* f) {
    f[0] = bflo(w.x); f[1] = bfhi(w.x); f[2] = bflo(w.y); f[3] = bfhi(w.y); f[4] = bflo(w.z); f[5] = bfhi(w.z); f[6] = bflo(w.w); f[7] = bfhi(w.w);
}

namespace pg8 {
constexpr int BM = 256, BK = 64, HALF = 128, HTB = HALF * BK * 2, STAGE_BYTES = 8 * HTB, NXCD = 8, WGM = 8;
__host__ __device__ __forceinline__ int lds_byte(int r, int c) { const int st = (r >> 4) * 2 + (c >> 5), rr = r & 15, cc = c & 31, ob = rr * 64 + cc * 2; return st * 1024 + (ob ^ (((ob >> 9) & 1) << 5)); }
__host__ __device__ __forceinline__ void stage_rc(int b, int& R, int& C) { const int st = b / 1024, sb = b % 1024, swz = sb ^ (((sb >> 9) & 1) << 5); R = (st >> 1) * 16 + swz / 64; C = (st & 1) * 32 + (swz % 64) / 2; }
__host__ __device__ __forceinline__ int perm32(int rho) { const int n = rho >> 4, i = rho & 15; return 8 * (i >> 2) + 4 * n + (i & 3); }

struct Unit { int pm, pn; };
struct Gemm { const bf16* A; const bf16* Bt; int M, N, K; };

struct StaticOrder {
    int nM, nN, nwg, G, c;
    __host__ __device__ void init(int M, int N, int G_, int c_) { nM = M / BM; nN = N / BM; nwg = nM * nN; G = G_; c = c_; }
    __host__ __device__ bool next(int i, Unit& u) const {
        const long L = (long)i * G + c; if (L >= nwg) return false;
        int wgid = (int)L; { const int q = nwg / NXCD, r = nwg % NXCD, xcd = wgid % NXCD, off = wgid / NXCD; wgid = (xcd < r ? xcd * (q + 1) : r * (q + 1) + (xcd - r) * q) + off; }
        const int nig = WGM * nN, gid = wgid / nig, fm = gid * WGM, gsz = (nM - fm) < WGM ? (nM - fm) : WGM;
        u.pm = fm + ((wgid % nig) % gsz); u.pn = (wgid % nig) / gsz; return true;
    }
};

#define G_SILU_IN_ATTN 1
#define EPI_ST_MODE 0
#if EPI_ST_MODE == 1
__device__ __forceinline__ void st16_wt(void* p, u32x4 w) { asm volatile("global_store_dwordx4 %0, %1, off\n\ts_nop 1" :: "v"(p), "v"(w) : "memory"); }
#define EPI_ST16(ptr, w) st16_wt((void*)(ptr), (w))
#else
#define EPI_ST16(ptr, w) (*(u32x4*)(ptr) = (w))
#endif
__device__ __forceinline__ unsigned cvt_pk_bf16(float lo, float hi) { unsigned r; asm volatile("v_cvt_pk_bf16_f32 %0, %1, %2" : "=v"(r) : "v"(lo), "v"(hi)); return r; }

struct Epi {
    int mode; bool perm;
    unsigned act_silu, act_sig;
    const float* fin_g; unsigned* fin_cnt; float* fin_out;
    bf16* O; int ldc; const float* rs;
    const float* xold; float* xout; bf16* xb; bf16* xl; float* rsout;
    const bf16* zs; const bf16* gatep; int gate_ld; const float* gb;
    __device__ __forceinline__ void operator()(f32x4 (&acc)[2][2][4][2], const Unit& u, int wr, int wc, int fr, int fq, LAS float* rcache, int& cached_pm) const {
#if defined(PROBE_NULLEPI)
        if (mode == 7) {
#pragma unroll
            for (int a_ = 0; a_ < 2; ++a_)
#pragma unroll
                for (int b_ = 0; b_ < 2; ++b_)
#pragma unroll
                    for (int m_ = 0; m_ < 4; ++m_)
#pragma unroll
                        for (int n_ = 0; n_ < 2; ++n_) asm volatile("" :: "v"(acc[a_][b_][m_][n_]));
            return; }
#endif
        if (mode == 0) {
            const int row0 = u.pm * BM + wr * 64 + fr, col0 = u.pn * BM + wc * 32 + 8 * fq;
            const int act = ((act_silu >> u.pn) & 1u) ? 1 : (((act_sig >> u.pn) & 1u) ? 2 : 0);
            float scv[2][4];
            if (rs) {
                if (cached_pm == u.pm) { const f32x4 c0 = *(const LAS f32x4*)rcache, c1 = *(const LAS f32x4*)(rcache + 4);
#pragma unroll
                    for (int e = 0; e < 4; ++e) { scv[0][e] = c0[e]; scv[1][e] = c1[e]; } }
                else {
                    f32x4 rsv[2][4];
#pragma unroll
                    for (int ai = 0; ai < 2; ++ai)
#pragma unroll
                        for (int m = 0; m < 4; ++m) rsv[ai][m] = *(const f32x4*)(rs + (size_t)(row0 + ai * HALF + m * 16) * 16 + 4 * fq);
#pragma unroll
                    for (int ai = 0; ai < 2; ++ai)
#pragma unroll
                        for (int m = 0; m < 4; ++m) { const f32x4 a = rsv[ai][m]; float sq = (a[0] + a[1]) + (a[2] + a[3]); sq += __shfl_xor(sq, 16); sq += __shfl_xor(sq, 32);
                            scv[ai][m] = __builtin_amdgcn_rsqf(sq * (1.0f / 1024.0f) + EPS); }
                    *(LAS f32x4*)rcache = (f32x4){scv[0][0], scv[0][1], scv[0][2], scv[0][3]}; *(LAS f32x4*)(rcache + 4) = (f32x4){scv[1][0], scv[1][1], scv[1][2], scv[1][3]};
                    cached_pm = u.pm;
                }
            }
#pragma unroll
            for (int ai = 0; ai < 2; ++ai)
#pragma unroll
                for (int m = 0; m < 4; ++m) {
                    const int row = row0 + ai * HALF + m * 16;
                    const float sc = rs ? scv[ai][m] : 1.f;
                    bf16* rowp = O + (size_t)row * ldc + col0;
#pragma unroll
                    for (int bj = 0; bj < 2; ++bj) { f32x4 v0 = acc[ai][bj][m][0] * sc, v1 = acc[ai][bj][m][1] * sc;
                        if (act) {
#pragma unroll
                            for (int e = 0; e < 4; ++e) { const float s0 = fast_sigmoid(v0[e]), s1 = fast_sigmoid(v1[e]); v0[e] = (act == 1) ? v0[e] * s0 : s0; v1[e] = (act == 1) ? v1[e] * s1 : s1; } }
                        u32x4 w; w.x = cvt_pk_bf16(v0[0], v0[1]); w.y = cvt_pk_bf16(v0[2], v0[3]); w.z = cvt_pk_bf16(v1[0], v1[1]); w.w = cvt_pk_bf16(v1[2], v1[3]);
                        EPI_ST16(rowp + bj * HALF, w); }
                }
        } else if (mode == 1) {
            const int row0 = u.pm * BM + wr * 64 + fr, col0 = u.pn * BM + wc * 32 + 8 * fq;
            if (xold) {
#pragma unroll
                for (int aim = 0; aim < 4; ++aim) { const int ai = aim >> 1;
                    f32x4 xf[2][2][2];
#pragma unroll
                    for (int mm = 0; mm < 2; ++mm)
#pragma unroll
                        for (int bj = 0; bj < 2; ++bj) { const size_t off = (size_t)(row0 + ai * HALF + (2 * (aim & 1) + mm) * 16) * DM + col0 + bj * HALF; xf[mm][bj][0] = *(const f32x4*)(xold + off); xf[mm][bj][1] = *(const f32x4*)(xold + off + 4); }
#pragma unroll
                    for (int mm = 0; mm < 2; ++mm) { const int m = 2 * (aim & 1) + mm;
                        const int row = row0 + ai * HALF + m * 16; const size_t off = (size_t)row * DM + col0; float ss = 0.f;
#pragma unroll
                        for (int bj = 0; bj < 2; ++bj) {
                            const f32x4 x0 = xf[mm][bj][0] + acc[ai][bj][m][0], x1 = xf[mm][bj][1] + acc[ai][bj][m][1];
                            ss += ((x0[0] * x0[0] + x0[1] * x0[1]) + (x0[2] * x0[2] + x0[3] * x0[3])) + ((x1[0] * x1[0] + x1[1] * x1[1]) + (x1[2] * x1[2] + x1[3] * x1[3]));
                            u32x4 wh; wh.x = cvt_pk_bf16(x0[0], x0[1]); wh.y = cvt_pk_bf16(x0[2], x0[3]); wh.z = cvt_pk_bf16(x1[0], x1[1]); wh.w = cvt_pk_bf16(x1[2], x1[3]);
                            EPI_ST16(xb + off + bj * HALF, wh); }
                        ss += __shfl_xor(ss, 16); ss += __shfl_xor(ss, 32);
                        if (fq == 0) rsout[(size_t)row * 16 + u.pn * 4 + wc] = ss;
                    }
                }
            } else {
                u32x4 xin[2][4][2];
#pragma unroll
                for (int ai = 0; ai < 2; ++ai)
#pragma unroll
                    for (int m = 0; m < 4; ++m)
#pragma unroll
                        for (int bj = 0; bj < 2; ++bj) xin[ai][m][bj] = *(const u32x4*)(xb + (size_t)(row0 + ai * HALF + m * 16) * DM + col0 + bj * HALF);
#pragma unroll
                for (int ai = 0; ai < 2; ++ai)
#pragma unroll
                    for (int m = 0; m < 4; ++m) {
                        const int row = row0 + ai * HALF + m * 16; const size_t off = (size_t)row * DM + col0; float ss = 0.f;
#pragma unroll
                        for (int bj = 0; bj < 2; ++bj) {
                            float x[8]; unpack8(xin[ai][m][bj], x);
#pragma unroll
                            for (int e = 0; e < 4; ++e) { x[e] += acc[ai][bj][m][0][e]; x[4 + e] += acc[ai][bj][m][1][e]; }
#pragma unroll
                            for (int e = 0; e < 8; ++e) ss += x[e] * x[e];
                            u32x4 wh; wh.x = cvt_pk_bf16(x[0], x[1]); wh.y = cvt_pk_bf16(x[2], x[3]); wh.z = cvt_pk_bf16(x[4], x[5]); wh.w = cvt_pk_bf16(x[6], x[7]);
                            EPI_ST16(xb + off + bj * HALF, wh); }
                        ss += __shfl_xor(ss, 16); ss += __shfl_xor(ss, 32);
                        if (fq == 0) rsout[(size_t)row * 16 + u.pn * 4 + wc] = ss;
                    }
            }
        } else if (mode == 6) {
            const int row0 = u.pm * BM + wr * 64 + fr, col0 = u.pn * BM + wc * 32 + 8 * fq;
            u32x4 xin[2][4][2];
#pragma unroll
            for (int ai = 0; ai < 2; ++ai)
#pragma unroll
                for (int m = 0; m < 4; ++m)
#pragma unroll
                    for (int bj = 0; bj < 2; ++bj) xin[ai][m][bj] = *(const u32x4*)(xb + (size_t)(row0 + ai * HALF + m * 16) * DM + col0 + bj * HALF);
#pragma unroll
            for (int ai = 0; ai < 2; ++ai)
#pragma unroll
                for (int m = 0; m < 4; ++m) {
                    const int row = row0 + ai * HALF + m * 16; float ss = 0.f;
#pragma unroll
                    for (int bj = 0; bj < 2; ++bj)
                    { float h[8]; unpack8(xin[ai][m][bj], h);
#pragma unroll
                        for (int n = 0; n < 2; ++n) { f32x4 x = acc[ai][bj][m][n];
#pragma unroll
                            for (int e = 0; e < 4; ++e) x[e] += h[4 * n + e];
                            acc[ai][bj][m][n] = x; ss += (x[0] * x[0] + x[1] * x[1]) + (x[2] * x[2] + x[3] * x[3]); } }
                    ss += __shfl_xor(ss, 16); ss += __shfl_xor(ss, 32);
                    if (fq == 0) __hip_atomic_store(rsout + (size_t)row * 16 + u.pn * 4 + wc, ss, __ATOMIC_RELAXED, __HIP_MEMORY_SCOPE_AGENT);
                }
            asm volatile("s_waitcnt vmcnt(0)" ::: "memory");
            unsigned* cnt = fin_cnt + 64 * u.pm;
            if (fr == 0 && fq == 0) __hip_atomic_fetch_add(cnt, 1u, __ATOMIC_RELAXED, __HIP_MEMORY_SCOPE_AGENT);
            for (unsigned sp = 0; sp < (1u << 20); ++sp) {
                if ((unsigned)__builtin_amdgcn_readfirstlane((int)__hip_atomic_load(cnt, __ATOMIC_RELAXED, __HIP_MEMORY_SCOPE_AGENT)) >= 32u) break;
                __builtin_amdgcn_s_sleep(2);
            }
            float tsl[2][4]; f32x4 gv[2][2];
#pragma unroll
            for (int ai = 0; ai < 2; ++ai)
#pragma unroll
                for (int m = 0; m < 4; ++m) { const float* sl = rsout + (size_t)(row0 + ai * HALF + m * 16) * 16 + 4 * fq;
                    tsl[ai][m] = (__hip_atomic_load(sl, __ATOMIC_RELAXED, __HIP_MEMORY_SCOPE_AGENT) + __hip_atomic_load(sl + 1, __ATOMIC_RELAXED, __HIP_MEMORY_SCOPE_AGENT))
                               + (__hip_atomic_load(sl + 2, __ATOMIC_RELAXED, __HIP_MEMORY_SCOPE_AGENT) + __hip_atomic_load(sl + 3, __ATOMIC_RELAXED, __HIP_MEMORY_SCOPE_AGENT)); }
#pragma unroll
            for (int bj = 0; bj < 2; ++bj)
#pragma unroll
                for (int n = 0; n < 2; ++n) gv[bj][n] = *(const f32x4*)(fin_g + col0 + bj * HALF + n * 4);
#pragma unroll
            for (int ai = 0; ai < 2; ++ai)
#pragma unroll
                for (int m = 0; m < 4; ++m) {
                    const int row = row0 + ai * HALF + m * 16; const size_t off = (size_t)row * DM + col0;
                    float t = tsl[ai][m]; t += __shfl_xor(t, 16); t += __shfl_xor(t, 32);
                    const float rstd = __builtin_amdgcn_rsqf(t * (1.0f / 1024.0f) + EPS);
#pragma unroll
                    for (int bj = 0; bj < 2; ++bj)
#pragma unroll
                        for (int n = 0; n < 2; ++n) *(f32x4*)(fin_out + off + bj * HALF + n * 4) = acc[ai][bj][m][n] * rstd * gv[bj][n];
                }
        } else if (mode == 5 || mode == 8) {
            const int row0 = u.pm * BM + wr * 64 + fr, col0 = u.pn * BM + wc * 32 + 8 * fq;
            const int quarter = u.pn >> 2; bf16* const Oq = O + (size_t)quarter * ((size_t)MTOK * 1024);
            float scv[2][4];
            if (cached_pm == u.pm) { const f32x4 c0 = *(const LAS f32x4*)rcache, c1 = *(const LAS f32x4*)(rcache + 4);
#pragma unroll
                for (int e = 0; e < 4; ++e) { scv[0][e] = c0[e]; scv[1][e] = c1[e]; } }
            else {
                f32x4 rsv[2][4];
#pragma unroll
                for (int ai = 0; ai < 2; ++ai)
#pragma unroll
                    for (int m = 0; m < 4; ++m) rsv[ai][m] = *(const f32x4*)(rs + (size_t)(row0 + ai * HALF + m * 16) * 16 + 4 * fq);
#pragma unroll
                for (int ai = 0; ai < 2; ++ai)
#pragma unroll
                    for (int m = 0; m < 4; ++m) { const f32x4 a = rsv[ai][m]; float sq = (a[0] + a[1]) + (a[2] + a[3]); sq += __shfl_xor(sq, 16); sq += __shfl_xor(sq, 32);
                        scv[ai][m] = __builtin_amdgcn_rsqf(sq * (1.0f / 1024.0f) + EPS); }
                *(LAS f32x4*)rcache = (f32x4){scv[0][0], scv[0][1], scv[0][2], scv[0][3]}; *(LAS f32x4*)(rcache + 4) = (f32x4){scv[1][0], scv[1][1], scv[1][2], scv[1][3]};
                cached_pm = u.pm;
            }
#pragma unroll
            for (int ai = 0; ai < 2; ++ai)
#pragma unroll
                for (int m = 0; m < 4; ++m) {
                    const int row = row0 + ai * HALF + m * 16;
                    const float sc = scv[ai][m];
                    const int bb = row >> 13, tt = row & 8191, chunk = tt >> 6, key = tt & 63;
#pragma unroll
                    for (int bj = 0; bj < 2; ++bj) { const int cc = (col0 + bj * HALF) & 1023, h = cc >> 6, dc = (cc & 63) >> 3;
                        f32x4 v0 = acc[ai][bj][m][0] * sc, v1 = acc[ai][bj][m][1] * sc;
#if !G_SILU_IN_ATTN
                        if (quarter == 3) {
#pragma unroll
                            for (int e = 0; e < 4; ++e) { v0[e] *= fast_sigmoid(v0[e]); v1[e] *= fast_sigmoid(v1[e]); } }
#endif
                        u32x4 w; w.x = cvt_pk_bf16(v0[0], v0[1]); w.y = cvt_pk_bf16(v0[2], v0[3]); w.z = cvt_pk_bf16(v1[0], v1[1]); w.w = cvt_pk_bf16(v1[2], v1[3]);
                        size_t off;
                        if (quarter == 1) off = ((size_t)(((bb * 16 + h) * 128 + chunk) * 8 + dc) * 64 + key) * 8;
                        else if (quarter == 2) off = (size_t)((bb * 16 + h) * 128 + chunk) * 4096 + key * 64 + ((dc ^ (((key >> 1) & 1) << 2)) * 8);
                        else off = (size_t)row * 1024 + cc;
#if defined(PROBE_NULLEPI)
                        if (mode == 8) asm volatile("" :: "v"(w), "v"(Oq + off)); else
#endif
                        EPI_ST16(Oq + off, w); }
                }
        } else if (mode == 3) {
            const int row0 = u.pm * BM + wr * 64 + fr, col0 = u.pn * BM + wc * 32 + 8 * fq;
#pragma unroll
            for (int ai = 0; ai < 2; ++ai)
#pragma unroll
                for (int m = 0; m < 4; ++m) {
                    const int row = row0 + ai * HALF + m * 16, b = row >> 8, key = row & 255;
#pragma unroll
                    for (int bj = 0; bj < 2; ++bj) { const int col = col0 + bj * HALF, l = col >> 10, hx = (col >> 8) & 3, dc = (col & 255) >> 3;
                        const f32x4 v0 = acc[ai][bj][m][0], v1 = acc[ai][bj][m][1];
                        u32x4 w; w.x = cvt_pk_bf16(v0[0], v0[1]); w.y = cvt_pk_bf16(v0[2], v0[3]); w.z = cvt_pk_bf16(v1[0], v1[1]); w.w = cvt_pk_bf16(v1[2], v1[3]);
                        *(u32x4*)(O + ((size_t)((((l * 4 + b) * 4 + hx) * 32 + dc) * 256 + key)) * 8) = w; }
                }
        } else if (mode == 4) {
            const int row0 = u.pm * BM + wr * 64 + fr, col0 = u.pn * BM + wc * 32 + 8 * fq;
#pragma unroll
            for (int ai = 0; ai < 2; ++ai)
#pragma unroll
                for (int m = 0; m < 4; ++m) {
                    const int row = row0 + ai * HALF + m * 16, l = row >> 10, hx = (row >> 8) & 3, d = row & 255;
#pragma unroll
                    for (int bj = 0; bj < 2; ++bj) { const int col = col0 + bj * HALF, b = col >> 8, kg = (col & 255) >> 2;
                        const f32x4 v0 = acc[ai][bj][m][0], v1 = acc[ai][bj][m][1];
                        u32x2 w0, w1; w0.x = cvt_pk_bf16(v0[0], v0[1]); w0.y = cvt_pk_bf16(v0[2], v0[3]); w1.x = cvt_pk_bf16(v1[0], v1[1]); w1.y = cvt_pk_bf16(v1[2], v1[3]);
                        bf16* p = O + ((size_t)((((l * 4 + b) * 4 + hx) * 64 + kg) * 256 + d)) * 4;
                        *(u32x2*)p = w0; *(u32x2*)(p + 256 * 4) = w1; }
                }
        } else {
            const int row0 = u.pm * BM + wr * 64 + fr, col0 = u.pn * BM + wc * 32 + 8 * fq;
#pragma unroll
            for (int bj = 0; bj < 2; ++bj) {
                const int col = col0 + bj * HALF; const f32x4 b0 = *(const f32x4*)(gb + col), b1 = *(const f32x4*)(gb + col + 4);
#pragma unroll
                for (int ai = 0; ai < 2; ++ai) {
                    u32x4 zin[4], gin[4];
#pragma unroll
                    for (int m = 0; m < 4; ++m) { const int row = row0 + ai * HALF + m * 16; zin[m] = *(const u32x4*)(zs + (size_t)row * S5W + col); gin[m] = *(const u32x4*)(gatep + (size_t)row * gate_ld + col); }
#pragma unroll
                    for (int m = 0; m < 4; ++m) {
                        const int row = row0 + ai * HALF + m * 16;
                        const u32x4 zw = zin[m]; const u32x4 gw = gin[m];
                        float z[8], g[8], o[8]; unpack8(zw, z); unpack8(gw, g);
                        const f32x4 a0 = acc[ai][bj][m][0] + b0, a1 = acc[ai][bj][m][1] + b1;
#pragma unroll
                        for (int e = 0; e < 4; ++e) { o[e] = z[e] * fast_sigmoid(a0[e]) * g[e]; o[4 + e] = z[4 + e] * fast_sigmoid(a1[e]) * g[4 + e]; }
                        u32x4 w; w.x = cvt_pk_bf16(o[0], o[1]); w.y = cvt_pk_bf16(o[2], o[3]); w.z = cvt_pk_bf16(o[4], o[5]); w.w = cvt_pk_bf16(o[6], o[7]);
                        *(u32x4*)(O + (size_t)row * ldc + col) = w;
                    }
                }
            }
        }
    }
};

struct PairOrder {
    int vcu;
    __device__ __forceinline__ bool next(int i, Unit& u) const { if (i >= 4) return false;
        u.pm = (i >> 1) * 64 + (vcu >> 5) * 8 + ((vcu & 31) >> 2); u.pn = (vcu & 3) + 4 * (i & 1); return true; }
};
template <class Sched> __device__ __forceinline__ void gemm_phase(LAS unsigned char* lds, const Gemm g, const Sched& S, const Epi& E) {
    const int lane = lane_id_v(), wid = __builtin_amdgcn_readfirstlane(threadIdx.x >> 6), tid = wid * 64 + lane, wr = wid >> 2, wc = wid & 3, fr = lane & 15, fq = lane >> 4;
    const int K = g.K, nt = K / BK;
    unsigned voffA[2], voffB[2];
#pragma unroll
    for (int i = 0; i < 2; ++i) { int R, C; stage_rc(tid * 16 + i * 8192, R, C); const int Rb = E.perm ? ((R & ~31) + perm32(R & 31)) : R;
        voffA[i] = (unsigned)(R * K + C) * 2u; voffB[i] = (unsigned)(Rb * K + C) * 2u; }
    const size_t kstep = (size_t)(BK * 2);
    const size_t hstep = (size_t)HALF * K * 2;
    const size_t tstep = 2 * hstep;
    const unsigned ldsw = (unsigned)wid * 1024u;
    const int aoff = lds_byte(wr * 64 + fr, fq * 8), boff = lds_byte(wc * 32 + fr, fq * 8);
#define PG8_SA(b, h) (((b) * 2 + (h)) * HTB)
#define PG8_SB(b, h) ((4 + (b) * 2 + (h)) * HTB)
#define PG8_STAGE(bufoff, gbase, voff) do { _Pragma("unroll") for (int _i = 0; _i < 2; ++_i) \
        __builtin_amdgcn_global_load_lds((const unsigned*)((const char*)(gbase) + (voff)[_i]), (LAS unsigned*)(lds + (bufoff) + ldsw + _i * 8192), 16, 0, 0); } while (0)
#define PG8_LDA(dst, b, h) do { _Pragma("unroll") for (int m = 0; m < 4; ++m) _Pragma("unroll") for (int k = 0; k < 2; ++k) dst[m][k] = *(const LAS bf16x8*)(lds + PG8_SA(b, h) + aoff + m * 2048 + k * 1024); } while (0)
#define PG8_LDB(dst, b, h) do { _Pragma("unroll") for (int n = 0; n < 2; ++n) _Pragma("unroll") for (int k = 0; k < 2; ++k) dst[n][k] = *(const LAS bf16x8*)(lds + PG8_SB(b, h) + boff + n * 2048 + k * 1024); } while (0)
#define PG8_MMA(ai, bj, At, Bt) do { __builtin_amdgcn_s_setprio(1); _Pragma("unroll") for (int m = 0; m < 4; ++m) _Pragma("unroll") for (int n = 0; n < 2; ++n) _Pragma("unroll") for (int k = 0; k < 2; ++k) \
        acc[ai][bj][m][n] = __builtin_amdgcn_mfma_f32_16x16x32_bf16(Bt[n][k], At[m][k], acc[ai][bj][m][n], 0, 0, 0); __builtin_amdgcn_s_setprio(0); } while (0)
#define PG8_WAIT_V(n) asm volatile("s_waitcnt vmcnt(" #n ")" ::: "memory")
#define PG8_WAIT_L(n) asm volatile("s_waitcnt lgkmcnt(" #n ")" ::: "memory")
#define PG8_BAR __builtin_amdgcn_s_barrier()
#define PG8_SCHED __builtin_amdgcn_sched_barrier(0)
    Unit cur, nxt; int ui = 0;
    if (!S.next(0, cur)) return;
    int cached_pm = -1; LAS float* const rcache = (LAS float*)(lds + RSTD_OFF) + tid * 8;
    f32x4 acc[2][2][4][2];
#pragma unroll
    for (int a = 0; a < 2; ++a)
#pragma unroll
        for (int b = 0; b < 2; ++b)
#pragma unroll
            for (int m = 0; m < 4; ++m)
#pragma unroll
                for (int n = 0; n < 2; ++n) acc[a][b][m][n] = (f32x4){0.f, 0.f, 0.f, 0.f};
    bf16x8 At[4][2], B0[2][2], B1[2][2];
    const char* cA = (const char*)g.A + (size_t)cur.pm * tstep; const char* cB = (const char*)g.Bt + (size_t)cur.pn * tstep;
    PG8_STAGE(PG8_SB(0, 0), cB, voffB); PG8_STAGE(PG8_SB(0, 1), cB + hstep, voffB); PG8_STAGE(PG8_SA(0, 0), cA, voffA); PG8_STAGE(PG8_SA(0, 1), cA + hstep, voffA);
    if (wr == 1) PG8_BAR;
    PG8_WAIT_V(2); PG8_BAR;
    PG8_STAGE(PG8_SB(1, 0), cB + kstep, voffB); PG8_STAGE(PG8_SA(1, 0), cA + kstep, voffA); PG8_STAGE(PG8_SB(1, 1), cB + hstep + kstep, voffB);
    PG8_WAIT_V(6); PG8_BAR;
    for (;;) {
        const bool has_next = S.next(ui + 1, nxt);
        const char* nA = has_next ? (const char*)g.A + (size_t)nxt.pm * tstep : cA; const char* nB = has_next ? (const char*)g.Bt + (size_t)nxt.pn * tstep : cB;
        for (int t = 0; t < nt; t += 2) {
            const bool last = (t == nt - 2);
            const char* a1 = cA + (size_t)(t + 1) * kstep;
            const char* a2 = last ? nA : cA + (size_t)(t + 2) * kstep; const char* b2 = last ? nB : cB + (size_t)(t + 2) * kstep;
            const char* a3 = a2 + kstep; const char* b3 = b2 + kstep;
            PG8_LDB(B0, 0, 0); PG8_LDB(B1, 0, 1); PG8_SCHED; PG8_LDA(At, 0, 0); PG8_STAGE(PG8_SA(1, 1), a1 + hstep, voffA);
            PG8_WAIT_V(8); PG8_WAIT_L(0); PG8_BAR; PG8_MMA(0, 0, At, B0); PG8_MMA(0, 1, At, B1); PG8_BAR; PG8_SCHED;
            PG8_LDA(At, 0, 1); PG8_STAGE(PG8_SB(0, 0), b2, voffB); PG8_STAGE(PG8_SB(0, 1), b2 + hstep, voffB); PG8_STAGE(PG8_SA(0, 0), a2, voffA);
            PG8_WAIT_V(8); PG8_WAIT_L(0); PG8_BAR; PG8_MMA(1, 0, At, B0); PG8_MMA(1, 1, At, B1); PG8_BAR; PG8_SCHED;
            PG8_LDB(B0, 1, 0); PG8_LDB(B1, 1, 1); PG8_SCHED; PG8_LDA(At, 1, 0); PG8_STAGE(PG8_SA(0, 1), a2 + hstep, voffA);
            PG8_WAIT_V(8); PG8_WAIT_L(0); PG8_BAR; PG8_MMA(0, 0, At, B0); PG8_MMA(0, 1, At, B1); PG8_BAR; PG8_SCHED;
            PG8_LDA(At, 1, 1); PG8_STAGE(PG8_SB(1, 0), b3, voffB); PG8_STAGE(PG8_SB(1, 1), b3 + hstep, voffB); PG8_STAGE(PG8_SA(1, 0), a3, voffA);
            PG8_WAIT_V(8); PG8_WAIT_L(0); PG8_BAR; PG8_MMA(1, 0, At, B0); PG8_MMA(1, 1, At, B1); PG8_BAR; PG8_SCHED;
        }
        if (wr == 0) PG8_BAR;
        E(acc, cur, wr, wc, fr, fq, rcache, cached_pm);
        if (!has_next) break;
#pragma unroll
        for (int a = 0; a < 2; ++a)
#pragma unroll
            for (int b = 0; b < 2; ++b)
#pragma unroll
                for (int m = 0; m < 4; ++m)
#pragma unroll
                    for (int n = 0; n < 2; ++n) acc[a][b][m][n] = (f32x4){0.f, 0.f, 0.f, 0.f};
        cur = nxt; cA = nA; cB = nB; ++ui;
        if (wr == 1) PG8_BAR;
    }
    PG8_WAIT_V(0);
    PG8_BAR;
#undef PG8_SA
#undef PG8_SB
#undef PG8_STAGE
#undef PG8_LDA
#undef PG8_LDB
#undef PG8_MMA
#undef PG8_WAIT_V
#undef PG8_WAIT_L
#undef PG8_BAR
#undef PG8_SCHED
}
}

#define XB_TMO      128
#define XB_XCNT(j)  (256  + 64 * (j))
#define XB_XSUB(j)  (1280 + 64 * (j))
#define XB_XGEN(j)  (2304 + 64 * (j))
#define XB_TOP      3328
#define XB_TOPGEN   3392
#define XCD_BAR_WORDS 3456
#define XB_SPIN_CAP (1u << 18)
__device__ __forceinline__ unsigned xb_ld(unsigned* p)              { return __hip_atomic_load(p, __ATOMIC_RELAXED, __HIP_MEMORY_SCOPE_AGENT); }
__device__ __forceinline__ unsigned xb_add(unsigned* p, unsigned v) { return __hip_atomic_fetch_add(p, v, __ATOMIC_RELAXED, __HIP_MEMORY_SCOPE_AGENT); }
__device__ __forceinline__ unsigned xb_xcc_id() { return (unsigned)__builtin_amdgcn_s_getreg((3 << 11) | 20) & 0xFu; }
#define XB_SPIN(cond, bar) do { unsigned _sp = 0; while (cond) { __builtin_amdgcn_s_sleep(1); \
    if ((++_sp & 255u) == 0u) { if (xb_ld(&(bar)[XB_TMO])) break; if (_sp > XB_SPIN_CAP) { atomicAdd(&(bar)[XB_TMO], 1u); break; } } } } while (0)
struct XcdBarrier { unsigned* bar; unsigned x; volatile LAS unsigned* st; };
__device__ __forceinline__ XcdBarrier xcd_barrier_post(unsigned* bar, volatile LAS unsigned* st) {
    XcdBarrier b; b.bar = bar; b.x = xb_xcc_id(); b.st = st;
    if (threadIdx.x == 0) (void)xb_add(&bar[XB_XCNT(b.x)], 1u);
    return b;
}
__device__ __forceinline__ void xcd_barrier_complete(unsigned* bar, unsigned x, unsigned& nloc, unsigned& nx) {
    const unsigned G = gridDim.x * gridDim.y * gridDim.z;
    unsigned sum, cnt, mine, sp = 0u;
    for (;;) {
        sum = 0u; cnt = 0u; mine = 0u;
#pragma unroll
        for (unsigned j = 0; j < 16; ++j) { const unsigned c = xb_ld(&bar[XB_XCNT(j)]); sum += c; cnt += (c > 0u) ? 1u : 0u; mine = (j == x) ? c : mine; }
        if (sum == G) break;
        __builtin_amdgcn_s_sleep(1);
        if ((++sp & 255u) == 0u) { if (xb_ld(&bar[XB_TMO])) break; if (sp > XB_SPIN_CAP) { atomicAdd(&bar[XB_TMO], 1u); break; } }
    }
    nloc = mine > 0u ? mine : 1u; nx = cnt > 0u ? cnt : 1u;
}
__device__ __forceinline__ void xcd_barrier(const XcdBarrier& b) {
    asm volatile("s_waitcnt vmcnt(0)" ::: "memory");
    __syncthreads();
    if (threadIdx.x == 0) {
        unsigned* bar = b.bar;
        __builtin_amdgcn_s_waitcnt(0);
        unsigned nloc = b.st[0], nx = b.st[1];
        if (nloc == 0u) { xcd_barrier_complete(bar, b.x, nloc, nx); b.st[0] = nloc; b.st[1] = nx; }
        const unsigned old = xb_add(&bar[XB_XSUB(b.x)], 1u);
        const unsigned gen = old / nloc;
        if (old + 1u == (gen + 1u) * nloc) {
            __builtin_amdgcn_fence(__ATOMIC_RELEASE, "agent");
            asm volatile("s_waitcnt vmcnt(0)" ::: "memory");
            const unsigned og = xb_add(&bar[XB_TOP], 1u);
            const unsigned tg = og / nx;
            if (og + 1u == (tg + 1u) * nx) xb_add(&bar[XB_TOPGEN], 1u);
            else XB_SPIN(xb_ld(&bar[XB_TOPGEN]) == tg, bar);
            __builtin_amdgcn_fence(__ATOMIC_ACQUIRE, "agent");
            xb_add(&bar[XB_XGEN(b.x)], 1u);
            asm volatile("s_waitcnt vmcnt(0)" ::: "memory");
        } else {
            XB_SPIN(xb_ld(&bar[XB_XGEN(b.x)]) == gen, bar);
            __builtin_amdgcn_fence(__ATOMIC_ACQUIRE, "agent");
            asm volatile("s_waitcnt vmcnt(0)" ::: "memory");
        }
    }
    __syncthreads();
}

struct Args { const float* in[29]; float* out; unsigned char* ws; int ph_lo, ph_hi; };
struct Frame {
    LAS unsigned char* lds; volatile LAS unsigned* MISC; unsigned* ctl;
    int wave, vcu, G;
    unsigned char* ws; float* out;
};

__device__ __forceinline__ void p0_transpose_item(const float* W, const float* gain, int K, int N, bf16* WT, int qcols, float qscale, LAS float* scr, int item, int lane, int kvsplit = 0) {
    const int nblk = N / 32, kb = item / nblk, nb = item % nblk, k0 = 64 * kb, n0 = 32 * nb;
    const float cs = (n0 < qcols) ? qscale : 1.0f;
    float wv[32];
#pragma unroll
    for (int i = 0; i < 32; ++i) wv[i] = W[(size_t)(k0 + 2 * i + (lane >> 5)) * N + n0 + (lane & 31)];
    if (gain) {
#pragma unroll
        for (int i = 0; i < 32; ++i) wv[i] *= gain[k0 + 2 * i + (lane >> 5)];
    }
#pragma unroll
    for (int i = 0; i < 32; ++i) scr[(2 * i + (lane >> 5)) * 33 + (lane & 31)] = wv[i] * cs;
    asm volatile("s_waitcnt lgkmcnt(0)" ::: "memory");
    const int c = lane & 7;
#pragma unroll
    for (int j = 0; j < 4; ++j) { const int n = (lane >> 3) + 8 * j; const LAS float* s = scr + (8 * c) * 33 + n;
        u32x4 o; o.x = pk2(s[0 * 33], s[1 * 33]); o.y = pk2(s[2 * 33], s[3 * 33]); o.z = pk2(s[4 * 33], s[5 * 33]); o.w = pk2(s[6 * 33], s[7 * 33]);
        const int drow = kvsplit ? ((n0 < 1024) ? (n0 + n) : (n0 + n + 1024)) : (n0 + n);
        *(u32x4*)(WT + (size_t)drow * K + k0 + 8 * c) = o; }
    asm volatile("s_waitcnt lgkmcnt(0)" ::: "memory");
}

__device__ __forceinline__ void p1_late_weights(Frame& F, const Args& a, int gwl, int nwl) {
    LAS float* scr = (LAS float*)(F.lds + F.wave * 16384);
    const int lane = lane_id_v(); unsigned char* ws = F.ws;
    constexpr int I_OUT = 16 * 32, I_GLU = 8 * 16, I_IN1 = 16 * 128, I_QG = 16 * 64, I_O = 16 * 32;
    constexpr int NITEMS = I_OUT + I_GLU + I_IN1 + I_OUT + 2 * I_QG + 2 * I_O;
    for (int it = gwl; it < NITEMS; it += nwl) {
        int r = it;
        if (r < I_OUT) { p0_transpose_item(a.in[19], nullptr, DM, DM, (bf16*)(ws + WS_W_OUT0), 0, 1.f, scr, r, lane); continue; } r -= I_OUT;
        if (r < I_GLU) { p0_transpose_item(a.in[13], nullptr, S5W, S5W, (bf16*)(ws + WS_W_GLU), 0, 1.f, scr, r, lane); continue; } r -= I_GLU;
        if (r < I_IN1) { p0_transpose_item(a.in[21], a.in[20], DM, ODD_IN, (bf16*)(ws + WS_W_IN1), DM, QSCALE_ATT, scr, r, lane); continue; } r -= I_IN1;
        if (r < I_OUT) { p0_transpose_item(a.in[23], nullptr, DM, DM, (bf16*)(ws + WS_W_OUT1), 0, 1.f, scr, r, lane); continue; } r -= I_OUT;
        if (r < 2 * I_QG) { const int l = r / I_QG; p0_transpose_item(a.in[25] + (size_t)l * DM * 2048, a.in[24] + l * DM, DM, 2048, (bf16*)(ws + WS_W_QG) + (size_t)l * 2048 * DM, DM, QSCALE_XA, scr, r % I_QG, lane); continue; } r -= 2 * I_QG;
        { const int l = r / I_O; p0_transpose_item(a.in[27] + (size_t)l * DM * DM, nullptr, DM, DM, (bf16*)(ws + WS_W_O) + (size_t)l * DM * DM, 0, 1.f, scr, r % I_O, lane); }
    }
}
__device__ __forceinline__ void p0_prologue(Frame& F, const Args& a) {
    LAS float* scr = (LAS float*)(F.lds + F.wave * 16384);
    const int gw = F.vcu * NWAVES + F.wave, NGW = F.G * NWAVES, lane = lane_id_v();
    unsigned char* ws = F.ws;
    constexpr int I_IN0 = 16 * 80, I_KV = 16 * 64;
    constexpr int NITEMS = I_IN0 + 2 * I_KV;
    for (int it = gw; it < NITEMS; it += NGW) {
        int r = it;
        if (r < I_IN0) { p0_transpose_item(a.in[4], a.in[3], DM, EVEN_IN, (bf16*)(ws + WS_W_IN0), 0, 1.f, scr, r, lane); continue; } r -= I_IN0;
        { const int l = r / I_KV; p0_transpose_item(a.in[26] + (size_t)l * DM * 2048, nullptr, DM, 2048, (bf16*)(ws + WS_W_KV) + (size_t)l * 1024 * DM, 0, 1.f, scr, r % I_KV, lane, 1); }
    }
    for (int m = gw; m < BATCH * MEMLEN; m += NGW) {
        const f32x4* xr = (const f32x4*)(a.in[1] + (size_t)m * DM) + lane; const f32x4* gr = (const f32x4*)a.in[2] + lane;
        f32x4 v[4]; float s = 0.f;
#pragma unroll
        for (int j = 0; j < 4; ++j) { v[j] = xr[64 * j]; s += (v[j].x * v[j].x + v[j].y * v[j].y) + (v[j].z * v[j].z + v[j].w * v[j].w); }
        const float rstd = 1.0f / sqrtf(wave_sum(s) * (1.f / DM) + EPS);
        u32x2* o8 = (u32x2*)((bf16*)(ws + WS_MEMN) + (size_t)m * DM) + lane;
#pragma unroll
        for (int j = 0; j < 4; ++j) { const f32x4 g = gr[64 * j]; u32x2 w; w.x = pk2(v[j].x * rstd * g.x, v[j].y * rstd * g.y); w.y = pk2(v[j].z * rstd * g.z, v[j].w * rstd * g.w); o8[64 * j] = w; }
    }
    for (int m0 = gw * 4; m0 < MTOK; m0 += NGW * 4) {
        f32x4 v[4][4];
#pragma unroll
        for (int q = 0; q < 4; ++q)
#pragma unroll
            for (int j = 0; j < 4; ++j) v[q][j] = ((const f32x4*)(a.in[0] + (size_t)(m0 + q) * DM) + lane)[64 * j];
#pragma unroll
        for (int q = 0; q < 4; ++q) {
            u32x2* o8 = (u32x2*)((bf16*)(ws + WS_XB) + (size_t)(m0 + q) * DM) + lane;
            float* rs = (float*)(ws + WS_RS) + (size_t)(m0 + q) * 16;
            float sj[4];
#pragma unroll
            for (int j = 0; j < 4; ++j) { const f32x4 x = v[q][j]; sj[j] = wave_sum((x.x * x.x + x.y * x.y) + (x.z * x.z + x.w * x.w));
                u32x2 w; w.x = pk2(x.x, x.y); w.y = pk2(x.z, x.w); o8[64 * j] = w; }
            if (lane < 16) rs[lane] = (lane & 3) ? 0.f : ((lane >> 2) == 0 ? sj[0] : ((lane >> 2) == 1 ? sj[1] : ((lane >> 2) == 2 ? sj[2] : sj[3])));
        }
    }
    {
        const int gt = (F.vcu * NWAVES + F.wave) * 64 + lane;
        if (gt < NGRP * NST) {
            const int g = gt >> 6;
            const float lr = a.in[5][gt], li = a.in[6][gt], dt = expf(a.in[7][g]);
            const float mag = expf(lr * dt); float sn, cs; sincosf(li * dt, &sn, &cs);
            const float are = mag * cs, aim = mag * sn;
            const float den = lr * lr + li * li, nr = are - 1.0f;
            const float cre = (nr * lr + aim * li) / den, cim = (aim * lr - nr * li) / den;
            float pr = are, pi = aim;
#pragma unroll
            for (int i = 0; i < 6; ++i) { const float t = pr * pr - pi * pi; pi = 2.f * pr * pi; pr = t; }
            ((f32x4*)(ws + WS_PAR))[gt] = (f32x4){are, aim, pr, pi};
            const float* br = a.in[8] + (size_t)gt * 16; const float* bi = a.in[9] + (size_t)gt * 16;
            const int p = gt & 63;
            f32x4 brv[4], biv[4]; float crv[16], civ[16];
#pragma unroll
            for (int q = 0; q < 4; ++q) { brv[q] = ((const f32x4*)br)[q]; biv[q] = ((const f32x4*)bi)[q]; }
#pragma unroll
            for (int co = 0; co < 16; ++co) { crv[co] = a.in[10][(size_t)(g * 16 + co) * 64 + p]; civ[co] = a.in[11][(size_t)(g * 16 + co) * 64 + p]; }
            ((f32x4*)(ws + WS_PAR))[gt] = (f32x4){are, aim, pr, pi};
            bf16* bbt_re = (bf16*)(ws + WS_PAR + 524288) + (size_t)((g * 4 + 2 * (p >> 5)) * 32 + (p & 31)) * 16; bf16* bbt_im = bbt_re + 32 * 16;
#pragma unroll
            for (int q = 0; q < 4; ++q) { u32x2 wr_, wi_; float xr[4], xi[4];
#pragma unroll
                for (int e = 0; e < 4; ++e) { xr[e] = cre * brv[q][e] - cim * biv[q][e]; xi[e] = cre * biv[q][e] + cim * brv[q][e]; }
                wr_.x = pk2(xr[0], xr[1]); wr_.y = pk2(xr[2], xr[3]); wi_.x = pk2(xi[0], xi[1]); wi_.y = pk2(xi[2], xi[3]);
                ((u32x2*)bbt_re)[q] = wr_; ((u32x2*)bbt_im)[q] = wi_; }
            bf16* cmt = (bf16*)(ws + WS_PAR + 655360) + (size_t)g * 16 * 128 + 2 * p;
#pragma unroll
            for (int co = 0; co < 16; ++co) *(unsigned*)(cmt + co * 128) = pk2(crv[co], -civ[co]);
        }
    }
}

__device__ __forceinline__ float fma_asm(float a, float b, float c) { float d; asm("v_fma_f32 %0, %1, %2, %3" : "=v"(d) : "v"(a), "v"(b), "v"(c)); return d; }
__device__ __forceinline__ float fnma_asm(float a, float b, float c) { float d; asm("v_fma_f32 %0, -%1, %2, %3" : "=v"(d) : "v"(a), "v"(b), "v"(c)); return d; }
#define S5_CMAC(dr, di, ar, ai, xr, xi) asm("v_fma_f32 %0, %2, %4, %0\n\tv_fma_f32 %1, %2, %5, %1\n\tv_fma_f32 %0, -%3, %5, %0\n\tv_fma_f32 %1, %3, %4, %1" : "+v"(dr), "+v"(di) : "v"(ar), "v"(ai), "v"(xr), "v"(xi))
template <bool FULL> __device__ __forceinline__ void s5_scan_tile(f32x16& zr, f32x16& zi, const float (&pw)[8], float& cr, float& ci, int hi) {
#pragma unroll
    for (int i = 0; i < 4; ++i)
#pragma unroll
        for (int e = 1; e < 4; ++e) S5_CMAC(zr[4 * i + e], zi[4 * i + e], pw[0], pw[1], zr[4 * i + e - 1], zi[4 * i + e - 1]);
#pragma unroll
    for (int i = 0; i < 4; ++i) {
        float er = zr[4 * i + 3], orr = er, ei = zi[4 * i + 3], oi = ei;
        asm volatile("s_nop 1\n\tv_permlane32_swap_b32 %0, %1\n\tv_permlane32_swap_b32 %2, %3" : "+v"(er), "+v"(orr), "+v"(ei), "+v"(oi));
        float ner = er, nei = ei; S5_CMAC(ner, nei, pw[6], pw[7], cr, ci);
        const float cinr = hi ? ner : cr, cini = hi ? nei : ci;
        float nor = orr, noi = oi; S5_CMAC(nor, noi, pw[6], pw[7], ner, nei);
        cr = nor; ci = noi;
        if (FULL) {
#pragma unroll
            for (int e = 0; e < 4; ++e) S5_CMAC(zr[4 * i + e], zi[4 * i + e], pw[2 * e], pw[2 * e + 1], cinr, cini);
        }
    }
}
template <bool FULL> __device__ __forceinline__ void s5_phase(Frame& F, const Args& a) {
    const int gw = F.vcu * NWAVES + F.wave, NGW = F.G * NWAVES;
    const bf16* Z = (const bf16*)(F.ws + WS_Z); bf16* ZS = (bf16*)(F.ws + WS_ZS);
    f32x2* SR = (f32x2*)(F.ws + WS_SC);
    LAS unsigned char* const hb = F.lds + F.wave * (64 * 272);
    for (int wu = gw; wu < BATCH * NGRP * 16; wu += NGW) {
        const int lane = lane_id_v(), r = lane & 31, hi = lane >> 5;
        LAS unsigned char* const hbw = hb + (4 * hi) * 272 + r * 4; LAS unsigned char* const hbr = hb + (lane & 15) * 272 + (lane >> 4) * 16;
        const int rho = wu & 15, g = (wu >> 4) & 31, b = wu >> 9;
        const f32x4 pA = ((const f32x4*)(F.ws + WS_PAR))[g * 64 + r], pB = ((const f32x4*)(F.ws + WS_PAR))[g * 64 + 32 + r];
        float pwA[8], pwB[8];
        pwA[0] = pA.x; pwA[1] = pA.y; pwA[2] = pA.x * pA.x - pA.y * pA.y; pwA[3] = 2.f * pA.x * pA.y; pwA[4] = pwA[2] * pA.x - pwA[3] * pA.y; pwA[5] = pwA[2] * pA.y + pwA[3] * pA.x;
        pwA[6] = pwA[2] * pwA[2] - pwA[3] * pwA[3]; pwA[7] = 2.f * pwA[2] * pwA[3];
        pwB[0] = pB.x; pwB[1] = pB.y; pwB[2] = pB.x * pB.x - pB.y * pB.y; pwB[3] = 2.f * pB.x * pB.y; pwB[4] = pwB[2] * pB.x - pwB[3] * pB.y; pwB[5] = pwB[2] * pB.y + pwB[3] * pB.x;
        pwB[6] = pwB[2] * pwB[2] - pwB[3] * pwB[3]; pwB[7] = 2.f * pwB[2] * pwB[3];
        bf16x8 bbf[4];
#pragma unroll
        for (int ct = 0; ct < 4; ++ct) bbf[ct] = *(const bf16x8*)((const bf16*)(F.ws + WS_PAR + 524288) + (size_t)((g * 4 + ct) * 32 + r) * 16 + 8 * hi);
        bf16x8 cm[4]; f32x4 dsk = (f32x4){0.f, 0.f, 0.f, 0.f};
        float cAr = 0.f, cAi = 0.f, cBr = 0.f, cBi = 0.f;
        if (FULL) {
#pragma unroll
            for (int ks = 0; ks < 4; ++ks) cm[ks] = *(const bf16x8*)((const bf16*)(F.ws + WS_PAR + 655360) + (size_t)(g * 16 + (lane & 15)) * 128 + 32 * ks + 8 * (lane >> 4));
            dsk = *(const f32x4*)(a.in[12] + g * 16 + 4 * (lane >> 4));
            float qAr = pA.z, qAi = pA.w, qBr = pB.z, qBi = pB.w;
#pragma unroll
            for (int i = 0; i < 3; ++i) { float t = qAr * qAr - qAi * qAi; qAi = 2.f * qAr * qAi; qAr = t; t = qBr * qBr - qBi * qBi; qBi = 2.f * qBr * qBi; qBr = t; }
            const f32x2* sr = SR + (size_t)(wu - rho) * 64 + r;
            for (int j = 0; j < rho; ++j) { const f32x2 sA = sr[(size_t)j * 64], sB = sr[(size_t)j * 64 + 32];
                float nr = sA.x, ni = sA.y; S5_CMAC(nr, ni, qAr, qAi, cAr, cAi); cAr = nr; cAi = ni;
                nr = sB.x; ni = sB.y; S5_CMAC(nr, ni, qBr, qBi, cBr, cBi); cBr = nr; cBi = ni; }
        }
        const size_t rrow0 = (size_t)b * SEQ + (size_t)rho * 512;
        const bf16* up = Z + (rrow0 + r) * EVEN_IN + g * 16 + 8 * hi;
        bf16x8 uf_next = *(const bf16x8*)up;
        for (int c8 = 0; c8 < 8; ++c8) {
            const size_t row0 = rrow0 + (size_t)c8 * 64;
            u32x2 uw[4];
            if (FULL) {
#pragma unroll
                for (int tk = 0; tk < 4; ++tk) uw[tk] = *(const u32x2*)(Z + (row0 + 16 * tk + (lane & 15)) * EVEN_IN + g * 16 + 4 * (lane >> 4));
            }
#pragma unroll
            for (int tt = 0; tt < 2; ++tt) {
                const bf16x8 uf = uf_next;
                { const int tn = c8 * 2 + tt + 1; uf_next = *(const bf16x8*)(up + (size_t)(tn < 16 ? tn : 15) * 32 * EVEN_IN); }
                f32x16 acc[4];
#pragma unroll
                for (int ct = 0; ct < 4; ++ct) {
#pragma unroll
                    for (int e = 0; e < 16; ++e) acc[ct][e] = 0.f;
                    acc[ct] = __builtin_amdgcn_mfma_f32_32x32x16_bf16(uf, bbf[ct], acc[ct], 0, 0, 0);
                }
                asm volatile("s_nop 15\n\ts_nop 7" : "+v"(acc[0]), "+v"(acc[1]), "+v"(acc[2]), "+v"(acc[3]));
                s5_scan_tile<FULL>(acc[0], acc[1], pwA, cAr, cAi, hi);
                s5_scan_tile<FULL>(acc[2], acc[3], pwB, cBr, cBi, hi);
                if (FULL) {
#pragma unroll
                    for (int e = 0; e < 16; ++e) { LAS unsigned char* rowp = hbw + (32 * tt + (e & 3) + 8 * (e >> 2)) * 272;
                        *(LAS unsigned*)(rowp) = pk2(acc[0][e], acc[1][e]);
                        *(LAS unsigned*)(rowp + 128) = pk2(acc[2][e], acc[3][e]); }
                }
                __builtin_amdgcn_sched_barrier(0);
            }
            if (FULL) {
                const int tl = lane & 15, kq = lane >> 4;
#pragma unroll
                for (int tk = 0; tk < 4; ++tk) {
                    f32x4 y = (f32x4){0.f, 0.f, 0.f, 0.f};
                    const int tok = 16 * tk + tl;
#pragma unroll
                    for (int ks = 0; ks < 4; ++ks) { const bf16x8 hf = *(const LAS bf16x8*)(hbr + tk * (16 * 272) + ks * 64);
                        y = __builtin_amdgcn_mfma_f32_16x16x32_bf16(cm[ks], hf, y, 0, 0, 0); }
                    const float y0 = y[0] + dsk[0] * bflo(uw[tk].x), y1 = y[1] + dsk[1] * bfhi(uw[tk].x), y2 = y[2] + dsk[2] * bflo(uw[tk].y), y3 = y[3] + dsk[3] * bfhi(uw[tk].y);
                    u32x2 o; o.x = pk2(gelu_tanh(y0), gelu_tanh(y1)); o.y = pk2(gelu_tanh(y2), gelu_tanh(y3));
                    *(u32x2*)(ZS + (row0 + tok) * S5W + g * 16 + 4 * kq) = o;
                }
            }
        }
        if (!FULL) SR[(size_t)wu * 64 + r + 32 * hi] = hi ? (f32x2){cBr, cBi} : (f32x2){cAr, cAi};
    }
}

template <int S> __device__ __forceinline__ void conv_tap_v(float (&out)[64], const float (&w)[CONVK], float v) {
    if (S < 64) {
#pragma unroll
        for (int k = 0; k < CONVK; ++k) { const int t = S + 30 - k; if (t >= 0 && t < 64) out[t] += w[k] * v; }
    }
}
struct ConvBuf { unsigned short xa[8], xg[8]; };
template <int S0, int... I> __device__ __forceinline__ void conv_load(std::integer_sequence<int, I...>, ConvBuf& B, const bf16* zrow0, int t0) {
    ((B.xa[I] = (S0 + I < 64) ? zrow0[(long)((S0 + I >= 0 || t0 + S0 + I >= 0) ? (S0 + I) : 0) * EVEN_IN + 1024] : (unsigned short)0), ...);
    ((B.xg[I] = (S0 + I < 64) ? zrow0[(long)((S0 + I >= 0 || t0 + S0 + I >= 0) ? (S0 + I) : 0) * EVEN_IN + 1536] : (unsigned short)0), ...);
}
template <int S0, int... I> __device__ __forceinline__ void conv_taps8(std::integer_sequence<int, I...>, float (&out)[64], const float (&w)[CONVK], const ConvBuf& B, int t0) {
    (conv_tap_v<S0 + I>(out, w, (S0 + I >= 0 || t0 + S0 + I >= 0) ? bf2f(B.xa[I]) * bf2f(B.xg[I]) : 0.f), ...);
}
__device__ __forceinline__ void conv_phase(Frame& F, const Args& a) {
    const int lane = lane_id_v(), wave = F.wave, c = wave * 64 + lane;
    const bf16* Z = (const bf16*)(F.ws + WS_Z); bf16* Y = (bf16*)(F.ws + WS_Y);
    LAS f32x2* red = (LAS f32x2*)F.lds;
    LAS f32x2* stats = (LAS f32x2*)(F.lds + 4096);
    LAS unsigned char* const gbuf = F.lds + 8192; const unsigned gbuf0 = (unsigned)(uintptr_t)F.lds + 8192;
    float w[CONVK];
#pragma unroll
    for (int k = 0; k < CONVK; ++k) w[k] = a.in[15][k * 512 + c];
    const float cb = a.in[16][c], lng = a.in[17][c], lnb = a.in[18][c];
    for (int tile = F.vcu; tile < BATCH * NCHUNK; tile += F.G) {
        const int b = tile >> 7, t0 = (tile & 127) * 64; const size_t row0 = (size_t)b * SEQ + t0;
        __syncthreads();
        { const int lane_d = lane_id_v();
#pragma unroll 1
        for (int k = 0; k < 8; ++k) { const int t = wave * 8 + k;
            glds16_asm(Z + (row0 + t) * EVEN_IN + 2048 + lane_d * 8, (unsigned)__builtin_amdgcn_readfirstlane((int)(gbuf0 + t * 1024))); } }
        float out[64];
#pragma unroll
        for (int t = 0; t < 64; ++t) out[t] = cb;
        { const bf16* zr0 = Z + row0 * EVEN_IN + c; const auto sq = std::make_integer_sequence<int, 8>{};
          ConvBuf A, B;
          conv_load<-30>(sq, A, zr0, t0); __builtin_amdgcn_sched_barrier(0); conv_load<-22>(sq, B, zr0, t0); __builtin_amdgcn_sched_barrier(0);
          conv_taps8<-30>(sq, out, w, A, t0); conv_load<-14>(sq, A, zr0, t0); __builtin_amdgcn_sched_barrier(0);
          conv_taps8<-22>(sq, out, w, B, t0); conv_load<-6>(sq, B, zr0, t0); __builtin_amdgcn_sched_barrier(0);
          conv_taps8<-14>(sq, out, w, A, t0); conv_load<2>(sq, A, zr0, t0); __builtin_amdgcn_sched_barrier(0);
          conv_taps8<-6>(sq, out, w, B, t0);  conv_load<10>(sq, B, zr0, t0); __builtin_amdgcn_sched_barrier(0);
          conv_taps8<2>(sq, out, w, A, t0);   conv_load<18>(sq, A, zr0, t0); __builtin_amdgcn_sched_barrier(0);
          conv_taps8<10>(sq, out, w, B, t0);  conv_load<26>(sq, B, zr0, t0); __builtin_amdgcn_sched_barrier(0);
          conv_taps8<18>(sq, out, w, A, t0);  conv_load<34>(sq, A, zr0, t0); __builtin_amdgcn_sched_barrier(0);
          conv_taps8<26>(sq, out, w, B, t0);  conv_load<42>(sq, B, zr0, t0); __builtin_amdgcn_sched_barrier(0);
          conv_taps8<34>(sq, out, w, A, t0);  conv_load<50>(sq, A, zr0, t0); __builtin_amdgcn_sched_barrier(0);
          conv_taps8<42>(sq, out, w, B, t0);  conv_load<58>(sq, B, zr0, t0); __builtin_amdgcn_sched_barrier(0);
          conv_taps8<50>(sq, out, w, A, t0);
          conv_taps8<58>(sq, out, w, B, t0); }
        float r1[32];
#pragma unroll
        for (int i = 0; i < 32; ++i) { float x = out[i], y = out[i + 32];
            asm volatile("s_nop 1\n\tv_permlane32_swap_b32 %0, %1" : "+v"(x), "+v"(y)); r1[i] = x + y; }
#pragma unroll
        for (int half = 16; half >= 1; half >>= 1) { const bool up_ = (lane & half) != 0;
#pragma unroll
            for (int i = 0; i < half; ++i) { const float keep = up_ ? r1[i + half] : r1[i], send = up_ ? r1[i] : r1[i + half]; r1[i] = keep + __shfl_xor(send, half); } }
        const float s1 = r1[0];
#pragma unroll
        for (int i = 0; i < 32; ++i) { float x = out[i] * out[i], y = out[i + 32] * out[i + 32];
            asm volatile("s_nop 1\n\tv_permlane32_swap_b32 %0, %1" : "+v"(x), "+v"(y)); r1[i] = x + y; }
#pragma unroll
        for (int half = 16; half >= 1; half >>= 1) { const bool up_ = (lane & half) != 0;
#pragma unroll
            for (int i = 0; i < half; ++i) { const float keep = up_ ? r1[i + half] : r1[i], send = up_ ? r1[i] : r1[i + half]; r1[i] = keep + __shfl_xor(send, half); } }
        const float s2 = r1[0];
        __syncthreads();
        red[wave * 64 + lane] = (f32x2){s1, s2};
        __syncthreads();
        if (wave == 0) { float q1 = 0.f, q2 = 0.f;
#pragma unroll
            for (int i = 0; i < 8; ++i) { const f32x2 p = red[i * 64 + lane]; q1 += p.x; q2 += p.y; }
            const float mu = q1 * (1.f / 512.f); const float var = fmaxf(q2 * (1.f / 512.f) - mu * mu, 0.f);
            stats[lane] = (f32x2){mu, 1.0f / sqrtf(var + EPS)}; }
        asm volatile("s_waitcnt vmcnt(0)" ::: "memory");
        __syncthreads();
        {
            const int c_o = wave * 64 + lane_id_v();
            LAS unsigned short* gcol = (LAS unsigned short*)gbuf + c_o;
#pragma unroll
            for (int t = 0; t < 64; ++t) { const f32x2 st = stats[t]; const float cn = (out[t] - st.x) * st.y * lng + lnb;
                gcol[t * 512] = (unsigned short)f2bf(fast_silu(cn) * bf2f(gcol[t * 512])); }
        }
        __syncthreads();
        {
            const int tid = wave * 64 + lane_id_v();
#pragma unroll 2
            for (int k = 0; k < 8; ++k) { const int item = tid + 512 * k, t = item >> 6, ch = item & 63;
                *(u32x4*)(Y + (row0 + t) * DM + 512 + 8 * ch) = *(const LAS u32x4*)(gbuf + ((size_t)t * 512 + 8 * ch) * 2); }
        }
    }
}

__device__ __forceinline__ s16x4 tr_read(const LAS unsigned char* p) { return __builtin_bit_cast(s16x4, __builtin_amdgcn_ds_read_tr16_b64_v4i16((LAS s16x4*)p)); }
__device__ __forceinline__ void chunk_attn_mfma(Frame& F, const Args& a) {
    const int w = F.wave;
    const int hh = w >> 2, cc = (w >> 1) & 1, half = w & 1;
    LAS unsigned char* const lds = F.lds; const unsigned lds0 = (unsigned)(uintptr_t)F.lds; LAS float* const btab = (LAS float*)(lds + 131072);
    const bf16* ZQ = (const bf16*)(F.ws + WS_Z); const bf16* ZK = ZQ + (size_t)MTOK * 1024; const bf16* ZV = ZK + (size_t)MTOK * 1024; const bf16* ZG = ZV + (size_t)MTOK * 1024;
    bf16* Y = (bf16*)(F.ws + WS_Y);
#define CA_DMA_TILE_X(tb_, sb_, trel) do { const int T_ = (tb_) + (trel); if (T_ >= 0) { _Pragma("unroll") for (int i_ = 0; i_ < 4; ++i_) { const int piece_ = 4 * w + i_, sub_ = piece_ >> 3; \
        const bf16* src_ = ((sub_ < 2) ? ZK : ZV) + (size_t)((b * 16 + 2 * hp + (sub_ & 1)) * 128 + T_) * 4096 + (piece_ & 7) * 512 + lane * 8; \
        glds16_asm(src_, (unsigned)__builtin_amdgcn_readfirstlane((int)(lds0 + (((trel) + (sb_)) & 3) * 32768 + piece_ * 1024))); } } } while (0)
#define CA_DMA_TILE(trel) CA_DMA_TILE_X(tbase, sbase, trel)
#define CA_WAITBAR(n) asm volatile("s_waitcnt vmcnt(" #n ") lgkmcnt(0)\n\ts_barrier" ::: "memory")
    for (int uw_ = F.vcu; uw_ < BATCH * 8 * 8; uw_ += F.G) {
      const int hp = (uw_ >> 3) & 7, b = uw_ >> 6, cp0 = (uw_ & 7) * 8;
      const int h = 2 * hp + hh;
      int lane = lane_id_v(), r = lane & 31, hi = lane >> 5;
      __syncthreads();
      for (int i = w * 64 + lane; i < 2 * 320; i += NWAVES * 64) { const int hs = i / 320, ix = i - hs * 320; btab[i] = a.in[22][(2 * hp + hs) * 257 + (ix > 256 ? 256 : ix)] * LOG2E; }
      bf16x8 qn0, qn1, qn2, qn3;
      { const size_t qrow_ = (size_t)b * SEQ + (2 * cp0 + cc) * 64 + half * 32 + r; const bf16* qp_ = ZQ + qrow_ * 1024 + h * 64 + 8 * hi;
        qn0 = *(const bf16x8*)qp_; qn1 = *(const bf16x8*)(qp_ + 16); qn2 = *(const bf16x8*)(qp_ + 32); qn3 = *(const bf16x8*)(qp_ + 48); }
      { const int tb0 = 2 * cp0 - 8; CA_DMA_TILE_X(tb0, 0, 0); CA_DMA_TILE_X(tb0, 0, 1); }
      for (int ui = 0; ui < 8; ++ui) {
        const int cp = cp0 + ui, sbase = 2 * ui;
        const int c = 2 * cp + cc, tbase = 2 * cp - 8;
        lane = lane_id_v(); r = lane & 31; hi = lane >> 5;
        const int q4 = (lane & 15) >> 2, p4 = lane & 3, dsel = (lane >> 4) & 1, sw = (q4 >> 1) & 1;
        const int vlane = (4 * hi + q4) * 128 + (2 * dsel + (p4 >> 1)) * 16 + (p4 & 1) * 8;
        const size_t qrow = (size_t)b * SEQ + c * 64 + half * 32 + r;
        CA_WAITBAR(0);
        bf16x8 qf0 = qn0, qf1 = qn1, qf2 = qn2, qf3 = qn3;
        asm volatile("" : "+v"(qf0), "+v"(qf1), "+v"(qf2), "+v"(qf3));
        const float cfar = btab[hh * 320 + 256];
        float m = 0.f, l = 0.f; bool first = true;
        f32x16 o0, o1, negm;
#pragma unroll
        for (int e = 0; e < 16; ++e) { o0[e] = 0.f; o1[e] = 0.f; negm[e] = cfar; }
#pragma unroll
        for (int s = 0; s < 9; ++s) {
            bool issue;
            if (s == 0) { CA_DMA_TILE(2); CA_DMA_TILE(3); issue = (tbase + 3 >= 0); }
            else if (s <= 6) { CA_DMA_TILE(s + 3); issue = (tbase + s + 3 >= 0); }
            else { issue = false;
                if (ui < 7) { const int tbn = tbase + 2;
                    if (s == 7) { const size_t qrow_ = qrow + 128; const bf16* qp_ = ZQ + qrow_ * 1024 + h * 64 + 8 * hi;
                        qn0 = *(const bf16x8*)qp_; qn1 = *(const bf16x8*)(qp_ + 16); qn2 = *(const bf16x8*)(qp_ + 32); qn3 = *(const bf16x8*)(qp_ + 48); }
                    CA_DMA_TILE_X(tbn, sbase + 2, s - 7); issue = (tbn + s - 7 >= 0); } }
            const int T = tbase + s + cc;
            if (T >= 0) {
                const int bsel = (s + cc + sbase) & 3;
                const LAS unsigned char* kb = lds + bsel * 32768 + hh * 8192 + (hi * 64 + r) * 16;
                const LAS unsigned char* vb = lds + bsel * 32768 + 16384 + hh * 8192 + vlane;
                f32x16 p0, p1;
                bf16x8 kf[8];
#pragma unroll
                for (int s4 = 0; s4 < 4; ++s4) { kf[2 * s4] = *(const LAS bf16x8*)(kb + (2 * s4) * 1024); kf[2 * s4 + 1] = *(const LAS bf16x8*)(kb + (2 * s4) * 1024 + 512); }
                s16x4 va[2][2][2], vc[2][2][2];
#pragma unroll
                for (int kh = 0; kh < 2; ++kh)
#pragma unroll
                    for (int s2 = 0; s2 < 2; ++s2) { const LAS unsigned char* vk = vb + (32 * kh + 16 * s2) * 128;
                        va[kh][s2][0] = tr_read(vk + sw * 64); va[kh][s2][1] = tr_read(vk + 8 * 128 + sw * 64);
                        vc[kh][s2][0] = tr_read(vk + (1 - sw) * 64); vc[kh][s2][1] = tr_read(vk + 8 * 128 + (1 - sw) * 64); }
                if (s >= 6) {
                    const LAS float* bp = btab + hh * 320 + (64 * (8 - s) + half * 32 + r - 4 * hi + 128 - 27 - 32);
#pragma unroll
                    for (int e = 0; e < 16; ++e) { const int ko = (e & 3) + 8 * (e >> 2); p0[e] = bp[27 + 32 - ko] - m; p1[e] = bp[27 - ko] - m; }
                } else { p0 = negm; p1 = negm; }
                __builtin_amdgcn_sched_barrier(0);
#pragma unroll
                for (int s4 = 0; s4 < 4; ++s4) {
                    const bf16x8 qf = s4 == 0 ? qf0 : (s4 == 1 ? qf1 : (s4 == 2 ? qf2 : qf3));
                    p0 = __builtin_amdgcn_mfma_f32_32x32x16_bf16(kf[2 * s4], qf, p0, 0, 0, 0);
                    p1 = __builtin_amdgcn_mfma_f32_32x32x16_bf16(kf[2 * s4 + 1], qf, p1, 0, 0, 0);
                }
                if (CA_PROBE == 2) {
                    u32x4 zz = (u32x4){0u, 0u, 0u, 0u}; asm volatile("" : "+v"(zz));
#pragma unroll
                    for (int s4 = 0; s4 < 4; ++s4) { const bf16x8 k0 = *(const LAS bf16x8*)(kb + (2 * s4) * 1024), k1 = *(const LAS bf16x8*)(kb + (2 * s4) * 1024 + 512);
                        p0 = __builtin_amdgcn_mfma_f32_32x32x16_bf16(k0, __builtin_bit_cast(bf16x8, zz), p0, 0, 0, 0); p1 = __builtin_amdgcn_mfma_f32_32x32x16_bf16(k1, __builtin_bit_cast(bf16x8, zz), p1, 0, 0, 0); }
                }
                asm volatile("s_nop 15\n\ts_nop 7" : "+v"(p0), "+v"(p1));
                float rm = max3_asm(p0[0], p0[1], p0[2]), rm2 = max3_asm(p0[3], p0[4], p0[5]), rm3 = max3_asm(p1[0], p1[1], p1[2]), rm4 = max3_asm(p1[3], p1[4], p1[5]);
#pragma unroll
                for (int e = 6; e < 16; e += 2) { rm = max3_asm(rm, p0[e], p0[e + 1]); rm3 = max3_asm(rm3, p1[e], p1[e + 1]); { const float t_ = rm; rm = rm2; rm2 = t_; } { const float t_ = rm3; rm3 = rm4; rm4 = t_; } }
                rm = max3_asm(rm, rm2, rm3); rm = max2_asm(rm, rm4);
                { const auto rr = __builtin_amdgcn_permlane32_swap(__float_as_uint(rm), __float_as_uint(rm), false, false); rm = max2_asm(__uint_as_float(rr[0]), __uint_as_float(rr[1])); }
                if (first) {
                    m = rm;
#pragma unroll
                    for (int e = 0; e < 16; ++e) { p0[e] -= rm; p1[e] -= rm; negm[e] = cfar - m; }
                    first = false;
                } else if (__any(rm > 6.f)) {
                    const float dl = fmaxf(rm, 0.f), al = __builtin_amdgcn_exp2f(-dl);
                    m += dl; l *= al;
#pragma unroll
                    for (int e = 0; e < 16; ++e) { p0[e] -= dl; p1[e] -= dl; o0[e] *= al; o1[e] *= al; negm[e] = cfar - m; }
                }
                float ps0 = 0.f, ps1 = 0.f, ps2 = 0.f, ps3 = 0.f;
#pragma unroll
                for (int e = 0; e < 16; e += 2) { p0[e] = __builtin_amdgcn_exp2f(p0[e]); p1[e] = __builtin_amdgcn_exp2f(p1[e]); p0[e + 1] = __builtin_amdgcn_exp2f(p0[e + 1]); p1[e + 1] = __builtin_amdgcn_exp2f(p1[e + 1]);
                    ps0 += p0[e]; ps1 += p1[e]; ps2 += p0[e + 1]; ps3 += p1[e + 1]; }
                l += (ps0 + ps1) + (ps2 + ps3);
                if (CA_PROBE == 3) { float dz = 0.f; asm volatile("" : "+v"(dz)); float acc_ = 0.f;
#pragma unroll
                    for (int e = 0; e < 16; ++e) { acc_ += __builtin_amdgcn_exp2f(p0[e] * dz) + __builtin_amdgcn_exp2f(p1[e] * dz); }
                    l += (acc_ - 32.f) * dz; }
                u32x4 pf[2][2];
#pragma unroll
                for (int s2 = 0; s2 < 2; ++s2) {
                    u32x4 t; t.x = pk2(p0[8 * s2 + 0], p0[8 * s2 + 1]); t.y = pk2(p0[8 * s2 + 2], p0[8 * s2 + 3]); t.z = pk2(p0[8 * s2 + 4], p0[8 * s2 + 5]); t.w = pk2(p0[8 * s2 + 6], p0[8 * s2 + 7]); pf[0][s2] = t;
                    u32x4 v; v.x = pk2(p1[8 * s2 + 0], p1[8 * s2 + 1]); v.y = pk2(p1[8 * s2 + 2], p1[8 * s2 + 3]); v.z = pk2(p1[8 * s2 + 4], p1[8 * s2 + 5]); v.w = pk2(p1[8 * s2 + 6], p1[8 * s2 + 7]); pf[1][s2] = v;
                }
#pragma unroll
                for (int kh = 0; kh < 2; ++kh)
#pragma unroll
                    for (int s2 = 0; s2 < 2; ++s2) {
                        const s16x4 a0 = va[kh][s2][0], a1 = va[kh][s2][1], c0 = vc[kh][s2][0], c1 = vc[kh][s2][1];
                        const bf16x8 vf0 = (bf16x8){a0[0], a0[1], a0[2], a0[3], a1[0], a1[1], a1[2], a1[3]};
                        const bf16x8 vf1 = (bf16x8){c0[0], c0[1], c0[2], c0[3], c1[0], c1[1], c1[2], c1[3]};
                        o0 = __builtin_amdgcn_mfma_f32_32x32x16_bf16(vf0, __builtin_bit_cast(bf16x8, pf[kh][s2]), o0, 0, 0, 0);
                        o1 = __builtin_amdgcn_mfma_f32_32x32x16_bf16(vf1, __builtin_bit_cast(bf16x8, pf[kh][s2]), o1, 0, 0, 0);
                    }
                if (CA_PROBE == 1) {
                    u32x4 zz = (u32x4){0u, 0u, 0u, 0u}; asm volatile("" : "+v"(zz));
#pragma unroll
                    for (int kh = 0; kh < 2; ++kh)
#pragma unroll
                        for (int s2 = 0; s2 < 2; ++s2) { const LAS unsigned char* vk = vb + (32 * kh + 16 * s2) * 128;
                            const s16x4 a0 = tr_read(vk + sw * 64), a1 = tr_read(vk + 8 * 128 + sw * 64), c0 = tr_read(vk + (1 - sw) * 64), c1 = tr_read(vk + 8 * 128 + (1 - sw) * 64);
                            const bf16x8 vf0 = (bf16x8){a0[0], a0[1], a0[2], a0[3], a1[0], a1[1], a1[2], a1[3]}; const bf16x8 vf1 = (bf16x8){c0[0], c0[1], c0[2], c0[3], c1[0], c1[1], c1[2], c1[3]};
                            o0 = __builtin_amdgcn_mfma_f32_32x32x16_bf16(vf0, __builtin_bit_cast(bf16x8, zz), o0, 0, 0, 0);
                            o1 = __builtin_amdgcn_mfma_f32_32x32x16_bf16(vf1, __builtin_bit_cast(bf16x8, zz), o1, 0, 0, 0); }
                }
            }
            __builtin_amdgcn_sched_barrier(0);
            if (s < 8) { if (issue) CA_WAITBAR(4); else CA_WAITBAR(0); }
        }
        { const auto rr = __builtin_amdgcn_permlane32_swap(__float_as_uint(l), __float_as_uint(l), false, false); l = __uint_as_float(rr[0]) + __uint_as_float(rr[1]); }
        const float rl = 1.0f / l;
        const bf16* gp = ZG + qrow * 1024 + h * 64 + 8 * hi; bf16* yp = Y + qrow * DM + h * 64 + 8 * hi;
        u32x4 gq4[4];
#pragma unroll
        for (int q = 0; q < 4; ++q) gq4[q] = *(const u32x4*)(gp + 16 * q);
#pragma unroll
        for (int q = 0; q < 4; ++q) {
            const int dt = q >> 1, i0 = 2 * (q & 1);
            u32x4 G = gq4[q];
            { const auto r1 = __builtin_amdgcn_permlane32_swap(G.x, G.z, false, false); const auto r2 = __builtin_amdgcn_permlane32_swap(G.y, G.w, false, false); G.x = r1[0]; G.z = r1[1]; G.y = r2[0]; G.w = r2[1]; }
            float gf[8] = {bflo(G.x), bfhi(G.x), bflo(G.y), bfhi(G.y), bflo(G.z), bfhi(G.z), bflo(G.w), bfhi(G.w)};
#if G_SILU_IN_ATTN
#pragma unroll
            for (int e = 0; e < 8; ++e) gf[e] = fast_silu(gf[e]);
#endif
#pragma unroll
            for (int e = 0; e < 8; ++e) gf[e] *= rl;
            u32x2 ya, yb;
            if (dt == 0) {
                ya.x = pk2(o0[4 * i0] * gf[0], o0[4 * i0 + 1] * gf[1]); ya.y = pk2(o0[4 * i0 + 2] * gf[2], o0[4 * i0 + 3] * gf[3]);
                yb.x = pk2(o0[4 * i0 + 4] * gf[4], o0[4 * i0 + 5] * gf[5]); yb.y = pk2(o0[4 * i0 + 6] * gf[6], o0[4 * i0 + 7] * gf[7]);
            } else {
                ya.x = pk2(o1[4 * i0] * gf[0], o1[4 * i0 + 1] * gf[1]); ya.y = pk2(o1[4 * i0 + 2] * gf[2], o1[4 * i0 + 3] * gf[3]);
                yb.x = pk2(o1[4 * i0 + 4] * gf[4], o1[4 * i0 + 5] * gf[5]); yb.y = pk2(o1[4 * i0 + 6] * gf[6], o1[4 * i0 + 7] * gf[7]);
            }
            { const auto r1 = __builtin_amdgcn_permlane32_swap(ya.x, yb.x, false, false); const auto r2 = __builtin_amdgcn_permlane32_swap(ya.y, yb.y, false, false);
              *(u32x4*)(yp + 16 * q) = (u32x4){r1[0], r2[0], r1[1], r2[1]}; }
        }
      }
    }
#undef CA_DMA_TILE_X
#undef CA_DMA_TILE
#undef CA_WAITBAR
}

__device__ __forceinline__ void xattn_mfma(Frame& F, int layer, const bool pairmap) {
    const int w = F.wave;
    const bf16* QG = (const bf16*)(F.ws + WS_Z); bf16* Y = (bf16*)(F.ws + WS_Y);
    LAS unsigned char* const lds = F.lds; const unsigned lds0 = (unsigned)(uintptr_t)F.lds;
    LAS unsigned char* const qbuf = lds + 98304 + w * 4096; const unsigned qbuf0 = lds0 + 98304 + w * 4096;
    const int nu = pairmap ? 2 : (BATCH * 4 * (SEQ / 256) - F.vcu + F.G - 1) / F.G;
    const int nsteps = nu * 8;
#define XA_UNIT(g_) (pairmap ? (((((g_) >> 3) * 64 + (F.vcu >> 5) * 8 + ((F.vcu & 31) >> 2)) >> 5) << 7 | (F.vcu & 3) << 5 | ((((g_) >> 3) * 64 + (F.vcu >> 5) * 8 + ((F.vcu & 31) >> 2)) & 31)) : (F.vcu + ((g_) >> 3) * F.G))
#define XA_DMA_KV(g_) do { const int u_ = XA_UNIT(g_), j_ = (g_) & 7, hx_ = (u_ >> 5) & 3, b_ = u_ >> 7; const unsigned slot_ = lds0 + ((g_) % 3) * 32768; \
        if (j_ < 4) { const bf16* kb_ = (const bf16*)(F.ws + WS_KP) + (size_t)((layer * 4 + b_) * 4 + hx_) * (32 * 256 * 8) + (size_t)j_ * 16384 + lane * 8; \
            _Pragma("unroll") for (int i_ = 0; i_ < 4; ++i_) { const int piece_ = w * 4 + i_; glds16_asm(kb_ + piece_ * 512, (unsigned)__builtin_amdgcn_readfirstlane((int)(slot_ + piece_ * 1024))); } } \
        else { const bf16* vb_ = (const bf16*)(F.ws + WS_VP) + (size_t)((layer * 4 + b_) * 4 + hx_) * (64 * 256 * 4) + (size_t)(64 * (j_ - 4)) * 4; \
            _Pragma("unroll") for (int i_ = 0; i_ < 4; ++i_) { const int piece_ = w * 4 + i_, p_ = piece_ * 64 + lane, kg_ = p_ >> 5, dp_ = p_ & 31; \
                glds16_asm(vb_ + ((size_t)kg_ * 256 + 2 * dp_) * 4, (unsigned)__builtin_amdgcn_readfirstlane((int)(slot_ + piece_ * 1024))); } } } while (0)
#define XA_DMA_QG(g_) do { const int u_ = XA_UNIT(g_), j_ = (g_) & 7, qb_ = u_ & 31, hx_ = (u_ >> 5) & 3, b_ = u_ >> 7; \
        const bf16* src_ = QG + ((size_t)b_ * SEQ + qb_ * 256 + w * 32 + (lane & 31)) * 2048 + hx_ * 256 + (j_ < 4 ? 64 * j_ : 1024 + 64 * (j_ - 4)) + (lane >> 5) * 8; \
        _Pragma("unroll") for (int i_ = 0; i_ < 4; ++i_) glds16_asm(src_ + 16 * i_, (unsigned)__builtin_amdgcn_readfirstlane((int)(qbuf0 + i_ * 1024))); } while (0)
#define XA_WAITBAR(n) asm volatile("s_waitcnt vmcnt(" #n ") lgkmcnt(0)\n\ts_barrier" ::: "memory")
    if (nsteps > 0) {
        int lane = lane_id_v();
        __syncthreads();
        XA_DMA_QG(0); XA_DMA_KV(0); XA_DMA_KV(1);
        XA_WAITBAR(0);
        u32x4 ydef[4]; bool have_y = false; size_t ydef_row = 0; int ydef_col = 0;
#define XA_FLUSH_Y() do { if (have_y) { bf16* yp_ = Y + ydef_row * DM + ydef_col; \
            _Pragma("unroll") for (int q_ = 0; q_ < 4; ++q_) *(u32x4*)(yp_ + 16 * q_) = ydef[q_]; have_y = false; } } while (0)
        for (int ui = 0; ui < nu; ++ui) {
            lane = lane_id_v();
            const int r = lane & 31, hi = lane >> 5;
            const int u = XA_UNIT(ui * 8), qb = u & 31, hx = (u >> 5) & 3, b = u >> 7;
            const size_t qrow = (size_t)b * SEQ + qb * 256 + w * 32 + r;
            u32x4 pf[8][2]; float rl;
            {
                f32x16 sacc[8];
#pragma unroll
                for (int kt = 0; kt < 8; ++kt)
#pragma unroll
                    for (int e = 0; e < 16; ++e) sacc[kt][e] = 0.f;
#pragma unroll 1
                for (int j = 0; j < 4; ++j) {
                    const int g = ui * 8 + j;
                    XA_FLUSH_Y();
                    bf16x8 qf[4];
#pragma unroll
                    for (int s4 = 0; s4 < 4; ++s4) qf[s4] = *(const LAS bf16x8*)(qbuf + ((2 * s4 + hi) * 32 + r) * 16);
                    asm volatile("s_waitcnt lgkmcnt(0)" ::: "memory");
                    if (g + 1 < nsteps) XA_DMA_QG(g + 1);
                    if (g + 2 < nsteps) XA_DMA_KV(g + 2);
                    const LAS unsigned char* kb = lds + (g % 3) * 32768 + (hi * 256 + r) * 16;
                    bf16x8 kfa[4], kfb[4];
#pragma unroll
                    for (int s4 = 0; s4 < 4; ++s4) kfa[s4] = *(const LAS bf16x8*)(kb + (2 * s4 * 256) * 16);
#pragma unroll
                    for (int kt = 0; kt < 8; kt += 2) {
#pragma unroll
                        for (int s4 = 0; s4 < 4; ++s4) kfb[s4] = *(const LAS bf16x8*)(kb + (2 * s4 * 256 + 32 * (kt + 1)) * 16);
                        __builtin_amdgcn_sched_barrier(0);
#pragma unroll
                        for (int s4 = 0; s4 < 4; ++s4) sacc[kt] = __builtin_amdgcn_mfma_f32_32x32x16_bf16(kfa[s4], qf[s4], sacc[kt], 0, 0, 0);
                        __builtin_amdgcn_sched_barrier(0);
                        if (kt + 2 < 8) {
#pragma unroll
                            for (int s4 = 0; s4 < 4; ++s4) kfa[s4] = *(const LAS bf16x8*)(kb + (2 * s4 * 256 + 32 * (kt + 2)) * 16);
                        }
                        __builtin_amdgcn_sched_barrier(0);
#pragma unroll
                        for (int s4 = 0; s4 < 4; ++s4) sacc[kt + 1] = __builtin_amdgcn_mfma_f32_32x32x16_bf16(kfb[s4], qf[s4], sacc[kt + 1], 0, 0, 0);
                        __builtin_amdgcn_sched_barrier(0);
                    }
                    if (j < 3) { if (g + 2 < nsteps) XA_WAITBAR(4); else XA_WAITBAR(0); }
                }
                float m = sacc[0][0];
#pragma unroll
                for (int kt = 0; kt < 8; ++kt)
#pragma unroll
                    for (int e = 0; e < 16; ++e) m = fmaxf(m, sacc[kt][e]);
                m = fmaxf(m, __shfl_xor(m, 32));
                float l = 0.f;
#pragma unroll
                for (int kt = 0; kt < 8; ++kt) {
#pragma unroll
                    for (int e = 0; e < 16; ++e) { const float pp = __builtin_amdgcn_exp2f(sacc[kt][e] - m); sacc[kt][e] = pp; l += pp; }
#pragma unroll
                    for (int s2 = 0; s2 < 2; ++s2) { u32x4 t; t.x = pk2(sacc[kt][8 * s2 + 0], sacc[kt][8 * s2 + 1]); t.y = pk2(sacc[kt][8 * s2 + 2], sacc[kt][8 * s2 + 3]);
                        t.z = pk2(sacc[kt][8 * s2 + 4], sacc[kt][8 * s2 + 5]); t.w = pk2(sacc[kt][8 * s2 + 6], sacc[kt][8 * s2 + 7]); pf[kt][s2] = t; }
                }
                l += __shfl_xor(l, 32);
                rl = 1.0f / l;
                __builtin_amdgcn_sched_barrier(0);
                { const int g = ui * 8 + 3; if (g + 2 < nsteps) XA_WAITBAR(4); else XA_WAITBAR(0); }
            }
#pragma unroll 1
            for (int j = 4; j < 8; ++j) {
                const int g = ui * 8 + j;
                XA_FLUSH_Y();
                u32x2 gq[8];
#pragma unroll
                for (int t = 0; t < 2; ++t)
#pragma unroll
                    for (int i = 0; i < 4; ++i) gq[4 * t + i] = *(const LAS u32x2*)(qbuf + ((4 * t + i) * 32 + r) * 16 + 8 * hi);
                asm volatile("s_waitcnt lgkmcnt(0)" ::: "memory");
                if (g + 1 < nsteps) XA_DMA_QG(g + 1);
                if (g + 2 < nsteps) XA_DMA_KV(g + 2);
                const LAS unsigned char* vb = lds + (g % 3) * 32768 + (hi * 64 + r) * 8;
#pragma unroll
                for (int dt = 0; dt < 2; ++dt) {
                    f32x16 oacc;
#pragma unroll
                    for (int e = 0; e < 16; ++e) oacc[e] = 0.f;
                    s16x4 va[2][2][2], vn[2][2][2];
#define XA_VLD(dst, kt2) do { _Pragma("unroll") for (int q_ = 0; q_ < 2; ++q_) _Pragma("unroll") for (int s2 = 0; s2 < 2; ++s2) { const int kg = 8 * ((kt2) + q_) + 4 * s2; \
                        dst[q_][s2][0] = *(const LAS s16x4*)(vb + (kg * 64 + 32 * dt) * 8); dst[q_][s2][1] = *(const LAS s16x4*)(vb + ((kg + 2) * 64 + 32 * dt) * 8); } } while (0)
#define XA_VMM(src, kt2) do { _Pragma("unroll") for (int q_ = 0; q_ < 2; ++q_) _Pragma("unroll") for (int s2 = 0; s2 < 2; ++s2) { const s16x4 v0 = src[q_][s2][0], v1 = src[q_][s2][1]; \
                        const bf16x8 vf = (bf16x8){v0[0], v0[1], v0[2], v0[3], v1[0], v1[1], v1[2], v1[3]}; \
                        oacc = __builtin_amdgcn_mfma_f32_32x32x16_bf16(vf, __builtin_bit_cast(bf16x8, pf[(kt2) + q_][s2]), oacc, 0, 0, 0); } } while (0)
                    XA_VLD(va, 0);
                    XA_VLD(vn, 2); __builtin_amdgcn_sched_barrier(0); XA_VMM(va, 0); __builtin_amdgcn_sched_barrier(0);
                    XA_VLD(va, 4); __builtin_amdgcn_sched_barrier(0); XA_VMM(vn, 2); __builtin_amdgcn_sched_barrier(0);
                    XA_VLD(vn, 6); __builtin_amdgcn_sched_barrier(0); XA_VMM(va, 4); __builtin_amdgcn_sched_barrier(0);
                    XA_VMM(vn, 6);
#undef XA_VLD
#undef XA_VMM
                    u32x2 yo[4];
#pragma unroll
                    for (int i = 0; i < 4; ++i) { const u32x2 gw = gq[4 * dt + i];
                        yo[i].x = pk2(oacc[4 * i] * rl * bflo(gw.x), oacc[4 * i + 1] * rl * bfhi(gw.x)); yo[i].y = pk2(oacc[4 * i + 2] * rl * bflo(gw.y), oacc[4 * i + 3] * rl * bfhi(gw.y)); }
#pragma unroll
                    for (int pr = 0; pr < 2; ++pr) { const auto r1 = __builtin_amdgcn_permlane32_swap(yo[2 * pr].x, yo[2 * pr + 1].x, false, false); const auto r2 = __builtin_amdgcn_permlane32_swap(yo[2 * pr].y, yo[2 * pr + 1].y, false, false);
                        ydef[2 * dt + pr] = (u32x4){r1[0], r2[0], r1[1], r2[1]}; }
                }
                have_y = true; ydef_row = qrow; ydef_col = hx * 256 + 64 * (j - 4) + 8 * hi;
                __builtin_amdgcn_sched_barrier(0);
                if (g + 2 < nsteps) XA_WAITBAR(4); else XA_WAITBAR(0);
            }
        }
        XA_FLUSH_Y();
    }
#undef XA_FLUSH_Y
#undef XA_UNIT
#undef XA_DMA_KV
#undef XA_DMA_QG
#undef XA_WAITBAR
}

__device__ __forceinline__ void final_norm(Frame& F, const Args& a) {
    const int gw = F.vcu * NWAVES + F.wave, NGW = F.G * NWAVES, lane = lane_id_v();
    const f32x4* gr = (const f32x4*)a.in[28] + lane;
    for (int m = gw; m < MTOK; m += NGW) {
        f32x4* xr = (f32x4*)(F.out + (size_t)m * DM) + lane;
        f32x4 v[4]; float s = 0.f;
#pragma unroll
        for (int j = 0; j < 4; ++j) { v[j] = xr[64 * j]; s += (v[j].x * v[j].x + v[j].y * v[j].y) + (v[j].z * v[j].z + v[j].w * v[j].w); }
        const float rstd = 1.0f / sqrtf(wave_sum(s) * (1.f / DM) + EPS);
#pragma unroll
        for (int j = 0; j < 4; ++j) { const f32x4 g = gr[64 * j]; xr[64 * j] = (f32x4){v[j].x * rstd * g.x, v[j].y * rstd * g.y, v[j].z * rstd * g.z, v[j].w * rstd * g.w}; }
    }
}

__device__ __forceinline__ void stagger_delay() {
    if (STAGGER_US > 0 && (blockIdx.x & 1)) { const unsigned long long t0 = __builtin_amdgcn_s_memrealtime();
        while (__builtin_amdgcn_s_memrealtime() - t0 < (unsigned long long)(STAGGER_US * 100)) __builtin_amdgcn_s_sleep(32); }
}
constexpr int NPH = 15;
__global__ void __launch_bounds__(NWAVES * 64, 2) trunk_fwd(Args args) {
    extern __shared__ __attribute__((aligned(16))) unsigned char lds[];
    Frame F;
    F.lds = (LAS unsigned char*)lds;
    F.MISC = (volatile LAS unsigned*)(F.lds + MISC_OFF);
    F.wave = __builtin_amdgcn_readfirstlane(threadIdx.x >> 6);
    F.G = gridDim.x; { const int bx = blockIdx.x; F.vcu = (F.G % 8 == 0) ? (bx % 8) * (F.G / 8) + bx / 8 : bx; }
    F.ws = args.ws; F.out = args.out; F.ctl = (unsigned*)(args.ws + WS_CTL);
    for (int u = threadIdx.x; u < (RSTD_OFF - LDSCTL_OFF) / 4; u += NWAVES * 64) ((LAS unsigned*)(F.lds + LDSCTL_OFF))[u] = 0u;
    __syncthreads();
    const int lo = args.ph_lo, hi = args.ph_hi;
    const bool multi = (hi - lo) > 1;
    XcdBarrier bar; bar.bar = F.ctl + CW_BAR; bar.x = 0; bar.st = nullptr;
    if (multi) bar = xcd_barrier_post(F.ctl + CW_BAR, F.MISC + 8);
#define IN(k) (lo <= (k) && (k) < hi)
#define DUP(k) for (int rep_ = 0; rep_ < (((DUP_MASK >> (k)) & 1u) ? 2 : 1); ++rep_)
#define SEAM(k) do { if (IN(k) && IN((k) + 1)) xcd_barrier(bar); } while (0)
    unsigned char* ws = args.ws;
    bf16* const XB = (bf16*)(ws + WS_XB); bf16* const Y = (bf16*)(ws + WS_Y); bf16* const Z = (bf16*)(ws + WS_Z); bf16* const ZS = (bf16*)(ws + WS_ZS);
    float* const RS = (float*)(ws + WS_RS);
    pg8::Epi E0{}; E0.mode = 0; E0.perm = true;
    pg8::Epi E1{}; E1.mode = 1; E1.perm = true; E1.xout = args.out; E1.xb = XB; E1.xl = nullptr; E1.rsout = RS; E1.xold = nullptr;

    if (IN(0)) DUP(0) { p0_prologue(F, args); __syncthreads(); } SEAM(0);
    if (IN(1)) DUP(1) {
        { pg8::Gemm g{XB, (const bf16*)(ws + WS_W_IN0), MTOK, EVEN_IN, DM}; pg8::StaticOrder S; S.init(MTOK, EVEN_IN, F.G, (int)blockIdx.x);
          pg8::Epi E = E0; E.O = Z; E.ldc = EVEN_IN; E.rs = RS; E.act_silu = 0x30Cu; E.act_sig = 0xC0u; pg8::gemm_phase(F.lds, g, S, E); }
        { pg8::Gemm g{(const bf16*)(ws + WS_MEMN), (const bf16*)(ws + WS_W_KV), BATCH * MEMLEN, 2048, DM}; pg8::StaticOrder S; S.init(BATCH * MEMLEN, 2048, F.G, (int)blockIdx.x);
          pg8::Epi E = E0; E.mode = 3; E.O = (bf16*)(ws + WS_KP); pg8::gemm_phase(F.lds, g, S, E); }
        { pg8::Gemm g{(const bf16*)(ws + WS_W_KV) + (size_t)2048 * DM, (const bf16*)(ws + WS_MEMN), 2048, BATCH * MEMLEN, DM}; pg8::StaticOrder S; S.init(2048, BATCH * MEMLEN, F.G, (int)((blockIdx.x + F.G - 32) % F.G));
          pg8::Epi E = E0; E.mode = 4; E.O = (bf16*)(ws + WS_VP); pg8::gemm_phase(F.lds, g, S, E); }
        { const int bx = (int)blockIdx.x; const int nidle = F.G > 64 ? F.G - 64 : F.G; const int me = F.G > 64 ? bx - 64 : bx;
          if (me >= 0) p1_late_weights(F, args, me * NWAVES + F.wave, nidle * NWAVES); __syncthreads(); }
    } SEAM(1);
    if (IN(2)) { DUP(16) { s5_phase<false>(F, args); } DUP(17) { conv_phase(F, args); } } SEAM(2);
    if (IN(3)) DUP(3) { s5_phase<true>(F, args); __syncthreads(); } SEAM(3);
    if (IN(4)) DUP(4) { pg8::Gemm g{ZS, (const bf16*)(ws + WS_W_GLU), MTOK, S5W, S5W}; pg8::StaticOrder S; S.init(MTOK, S5W, F.G, (int)blockIdx.x);
        pg8::Epi E{}; E.mode = 2; E.perm = true; E.O = Y; E.ldc = DM; E.zs = ZS; E.gatep = Z + 512; E.gate_ld = EVEN_IN; E.gb = args.in[14];
        pg8::gemm_phase(F.lds, g, S, E); } SEAM(4);
    if (IN(5)) DUP(5) { stagger_delay(); pg8::Gemm g{Y, (const bf16*)(ws + WS_W_OUT0), MTOK, DM, DM}; pg8::StaticOrder S; S.init(MTOK, DM, F.G, (int)blockIdx.x);
        pg8::Epi E = E1; E.xold = args.in[0]; pg8::gemm_phase(F.lds, g, S, E); } SEAM(5);
    const bool fuse_xa = multi && (F.G == 256);
#define LOCAL_HANDOFF() do { asm volatile("s_waitcnt vmcnt(0)" ::: "memory"); __syncthreads(); \
        if (threadIdx.x == 0) { __builtin_amdgcn_fence(__ATOMIC_ACQUIRE, "agent"); asm volatile("s_waitcnt vmcnt(0)" ::: "memory"); } __syncthreads(); } while (0)
    if (IN(6)) DUP(6) { pg8::Gemm g{XB, (const bf16*)(ws + WS_W_QG), MTOK, 2048, DM};
        pg8::Epi E = E0; E.O = Z; E.ldc = 2048; E.rs = RS; E.act_silu = 0xF0u;
        if (fuse_xa) { pg8::PairOrder S{F.vcu}; pg8::gemm_phase(F.lds, g, S, E); }
        else { pg8::StaticOrder S; S.init(MTOK, 2048, F.G, (int)blockIdx.x); pg8::gemm_phase(F.lds, g, S, E); } }
    if (fuse_xa) { if (IN(6) && IN(7)) LOCAL_HANDOFF(); } else SEAM(6);
    if (IN(7)) DUP(7) { xattn_mfma(F, 0, fuse_xa); __syncthreads(); } SEAM(7);
    if (IN(8)) { stagger_delay(); pg8::Gemm g{Y, (const bf16*)(ws + WS_W_O), MTOK, DM, DM}; pg8::StaticOrder S; S.init(MTOK, DM, F.G, (int)blockIdx.x);
        pg8::gemm_phase(F.lds, g, S, E1); } SEAM(8);
    if (IN(9)) DUP(9) { pg8::Gemm g{XB, (const bf16*)(ws + WS_W_IN1), MTOK, ODD_IN, DM}; pg8::StaticOrder S; S.init(MTOK, ODD_IN, F.G, (int)blockIdx.x);
#if defined(PROBE_NULLEPI)
        { pg8::Epi En = E0; En.mode = PROBE_NULLEPI; En.O = Z; En.rs = RS; pg8::gemm_phase(F.lds, g, S, En); }
#endif
        pg8::Epi E = E0; E.mode = 5; E.O = Z; E.rs = RS; pg8::gemm_phase(F.lds, g, S, E); } SEAM(9);
    if (IN(10)) DUP(10) { chunk_attn_mfma(F, args); __syncthreads(); } SEAM(10);
    if (IN(11)) { stagger_delay(); pg8::Gemm g{Y, (const bf16*)(ws + WS_W_OUT1), MTOK, DM, DM}; pg8::StaticOrder S; S.init(MTOK, DM, F.G, (int)blockIdx.x);
        pg8::gemm_phase(F.lds, g, S, E1); } SEAM(11);
    if (IN(12)) { pg8::Gemm g{XB, (const bf16*)(ws + WS_W_QG) + (size_t)2048 * DM, MTOK, 2048, DM};
        pg8::Epi E = E0; E.O = Z; E.ldc = 2048; E.rs = RS; E.act_silu = 0xF0u;
        if (fuse_xa) { pg8::PairOrder S{F.vcu}; pg8::gemm_phase(F.lds, g, S, E); }
        else { pg8::StaticOrder S; S.init(MTOK, 2048, F.G, (int)blockIdx.x); pg8::gemm_phase(F.lds, g, S, E); } }
    if (fuse_xa) { if (IN(12) && IN(13)) LOCAL_HANDOFF(); } else SEAM(12);
    if (IN(13)) { xattn_mfma(F, 1, fuse_xa); } SEAM(13);
    if (IN(14)) { stagger_delay(); pg8::Gemm g{Y, (const bf16*)(ws + WS_W_O) + (size_t)DM * DM, MTOK, DM, DM}; pg8::StaticOrder S; S.init(MTOK, DM, F.G, (int)blockIdx.x);
        pg8::Epi E = E1; E.mode = 6; E.fin_g = args.in[28]; E.fin_cnt = F.ctl + CW_FIN; E.fin_out = args.out; pg8::gemm_phase(F.lds, g, S, E); }
#if defined(PROBE_TAIL)
    xcd_barrier(bar);
#if PROBE_TAIL == 1
    conv_phase(F, args);
#endif
#endif
#undef IN
#undef SEAM
}

extern "C" void kernel_launch(void* const* d_in, const int* in_sizes, int n_in, void* d_out, int out_size, void* d_ws, size_t ws_size, hipStream_t stream) {
    static int grid = 0;
    if (grid == 0) {
        if (n_in != 29 || out_size != MTOK * DM || ws_size < WS_END) { fprintf(stderr, "kernel_launch: unexpected shapes: n_in %d out %d ws %zu\n", n_in, out_size, ws_size); grid = -1; return; }
        int dev = 0, cus = 0, per_cu = 0;
        if (hipGetDevice(&dev) != hipSuccess || hipDeviceGetAttribute(&cus, hipDeviceAttributeMultiprocessorCount, dev) != hipSuccess) { grid = -1; return; }
        if (hipFuncSetAttribute((const void*)trunk_fwd, hipFuncAttributeMaxDynamicSharedMemorySize, LDS_BYTES) != hipSuccess) { fprintf(stderr, "kernel_launch: hipFuncSetAttribute failed\n"); grid = -1; return; }
        if (hipOccupancyMaxActiveBlocksPerMultiprocessor(&per_cu, (const void*)trunk_fwd, NWAVES * 64, LDS_BYTES) != hipSuccess || per_cu < 1) { fprintf(stderr, "kernel_launch: occupancy query reports %d\n", per_cu); per_cu = 1; }
        (void)hipGetLastError();
        grid = cus;
        if (grid > cus * per_cu) grid = cus * per_cu;
    }
    if (grid < 0) return;
    (void)hipMemsetAsync((char*)d_ws + WS_CTL, 0, CTL_ZERO_BYTES, stream);
    Args a{};
    for (int i = 0; i < 29; ++i) a.in[i] = (const float*)d_in[i];
    a.out = (float*)d_out; a.ws = (unsigned char*)d_ws;
    if (MK_N_LAUNCHES == 1) { a.ph_lo = 0; a.ph_hi = NPH; hipLaunchKernelGGL(trunk_fwd, dim3(grid), dim3(NWAVES * 64), LDS_BYTES, stream, a); }
    else { for (int p = 0; p < NPH; ++p) { a.ph_lo = p; a.ph_hi = p + 1; hipLaunchKernelGGL(trunk_fwd, dim3(grid), dim3(NWAVES * 64), LDS_BYTES, stream, a); } }
}
```

```cpp
#include <hip/hip_runtime.h>
#include <cstdio>
#include <cstdint>
#include <utility>

#ifndef MK_N_LAUNCHES
#define MK_N_LAUNCHES 1
#endif
#ifndef STAGGER_US
#define STAGGER_US 0
#endif
#ifndef CA_PROBE
#define CA_PROBE 0
#endif
#ifndef DUP_MASK
#define DUP_MASK 0u
#endif

#define GAS __attribute__((address_space(1)))
#define LAS __attribute__((address_space(3)))
typedef unsigned short bf16;
typedef short bf16x8 __attribute__((ext_vector_type(8)));
typedef float f32x4 __attribute__((ext_vector_type(4)));
typedef float f32x2 __attribute__((ext_vector_type(2)));
typedef unsigned u32x4 __attribute__((ext_vector_type(4)));
typedef unsigned u32x2 __attribute__((ext_vector_type(2)));
typedef float f32x16 __attribute__((ext_vector_type(16)));
typedef short s16x4 __attribute__((ext_vector_type(4)));
__host__ __device__ __forceinline__ int crow16(int reg, int hi) { return (reg & 3) + 8 * (reg >> 2) + 4 * hi; }

constexpr int BATCH = 4, SEQ = 8192, DM = 1024, MTOK = BATCH * SEQ;
constexpr int EVEN_IN = 2560, ODD_IN = 4096, S5W = 512, NGRP = 32, NST = 64, CONVK = 31;
constexpr int MEMLEN = 256, NCHUNK = SEQ / 64;
constexpr float EPS = 1e-6f, LOG2E = 1.4426950408889634f;
constexpr float QSCALE_ATT = 0.125f * LOG2E;
constexpr float QSCALE_XA = 0.0625f * LOG2E;
constexpr int NWAVES = 8;

constexpr size_t MiB = 1u << 20;
constexpr size_t WS_CTL = 0, CTL_ZERO_BYTES = 1 * MiB;
constexpr size_t WS_W_IN0 = 2 * MiB, WS_W_OUT0 = 7 * MiB, WS_W_GLU = 9 * MiB, WS_W_IN1 = 10 * MiB, WS_W_OUT1 = 18 * MiB;
constexpr size_t WS_W_QG = 20 * MiB, WS_W_KV = 28 * MiB, WS_W_O = 36 * MiB, WS_MEMN = 40 * MiB, WS_KP = 42 * MiB, WS_VP = 46 * MiB;
constexpr size_t WS_PAR = 50 * MiB, WS_RS = 51 * MiB, WS_SC = 53 * MiB;
constexpr size_t WS_XB = 64 * MiB, WS_Y = 128 * MiB, WS_ZS = 192 * MiB, WS_Z = 224 * MiB, WS_END = 480 * MiB;
constexpr int CW_BAR = 4096, CW_FIN = 8192;

constexpr int RING_BYTES = 143360, LDSCTL_OFF = RING_BYTES, MISC_OFF = LDSCTL_OFF + 320, RSTD_OFF = 147456, LDS_BYTES = 163840;

#define RLX_AGENT __ATOMIC_RELAXED, __HIP_MEMORY_SCOPE_AGENT
__device__ __forceinline__ unsigned f2bf(float f) { unsigned u = __builtin_bit_cast(unsigned, f); return (u + 0x7fffu + ((u >> 16) & 1u)) >> 16; }
typedef __bf16 bf16x2_t __attribute__((ext_vector_type(2)));
__device__ __forceinline__ unsigned pk2(float lo, float hi) { const f32x2 v = {lo, hi}; const bf16x2_t b = __builtin_convertvector(v, bf16x2_t); return __builtin_bit_cast(unsigned, b); }
__device__ __forceinline__ float bflo(unsigned w) { return __uint_as_float(w << 16); }
__device__ __forceinline__ float bfhi(unsigned w) { return __uint_as_float(w & 0xffff0000u); }
__device__ __forceinline__ float bf2f(unsigned short b) { return __uint_as_float((unsigned)b << 16); }
__device__ __forceinline__ int lane_id_v() { int l; asm volatile("v_mbcnt_lo_u32_b32 %0, -1, 0\n\tv_mbcnt_hi_u32_b32 %0, -1, %0" : "=v"(l)); return l; }
__device__ __forceinline__ bf16x8 gload16_asm(const void* p) { bf16x8 v; asm volatile("global_load_dwordx4 %0, %1, off" : "=v"(v) : "v"(p) : "memory"); return v; }
__device__ __forceinline__ void glds16_asm(const void* gsrc, unsigned lds_dst) { unsigned keep;
    asm volatile("s_mov_b32 %0, m0\n\ts_mov_b32 m0, %2\n\ts_nop 0\n\tglobal_load_lds_dwordx4 %1, off\n\ts_mov_b32 m0, %0" : "=&s"(keep) : "v"(gsrc), "s"(lds_dst) : "memory"); }
__device__ __forceinline__ float max3_asm(float a, float b, float c) { float r; asm("v_max3_f32 %0, %1, %2, %3" : "=v"(r) : "v"(a), "v"(b), "v"(c)); return r; }
__device__ __forceinline__ float max2_asm(float a, float b) { float r; asm("v_max_f32_e32 %0, %1, %2" : "=v"(r) : "v"(a), "v"(b)); return r; }
__device__ __forceinline__ int opaque0() { int z; asm volatile("v_mov_b32 %0, 0" : "=v"(z)); return z; }
__device__ __forceinline__ float fast_sigmoid(float x) { return __builtin_amdgcn_rcpf(1.0f + __builtin_amdgcn_exp2f(-x * LOG2E)); }
__device__ __forceinline__ float fast_silu(float x) { return x * fast_sigmoid(x); }
__device__ __forceinline__ float gelu_tanh(float y) { const float x = 0.7978845608028654f * (y + 0.044715f * y * y * y); return y * fast_sigmoid(2.0f * x); }
__device__ __forceinline__ float wave_sum(float v) {
    v += __builtin_bit_cast(float, __builtin_amdgcn_update_dpp(0, __builtin_bit_cast(int, v), 0xB1, 0xF, 0xF, true));
    v += __builtin_bit_cast(float, __builtin_amdgcn_update_dpp(0, __builtin_bit_cast(int, v), 0x4E, 0xF, 0xF, true));
    v += __builtin_bit_cast(float, __builtin_amdgcn_update_dpp(0, __builtin_bit_cast(int, v), 0x141, 0xF, 0xF, true));
    v += __builtin_bit_cast(float, __builtin_amdgcn_update_dpp(0, __builtin_bit_cast(int, v), 0x140, 0xF, 0xF, true));
    const int b = __builtin_bit_cast(int, v);
    const float r0 = __builtin_bit_cast(float, __builtin_amdgcn_readlane(b, 0)), r1 = __builtin_bit_cast(float, __builtin_amdgcn_readlane(b, 16));
    const float r2 = __builtin_bit_cast(float, __builtin_amdgcn_readlane(b, 32)), r3 = __builtin_bit_cast(float, __builtin_amdgcn_readlane(b, 48));
    return (r0 + r1) + (r2 + r3);
}
__device__ __forceinline__ void unpack8(const u32x4 w, float* f) {
    f[0] = bflo(w.x); f[1] = bfhi(w.x); f[2] = bflo(w.y); f[3] = bfhi(w.y); f[4] = bflo(w.z); f[5] = bfhi(w.z); f[6] = bflo(w.w); f[7] = bfhi(w.w);
}

namespace pg8 {
constexpr int BM = 256, BK = 64, HALF = 128, HTB = HALF * BK * 2, STAGE_BYTES = 8 * HTB, NXCD = 8, WGM = 8;
__host__ __device__ __forceinline__ int lds_byte(int r, int c) { const int st = (r >> 4) * 2 + (c >> 5), rr = r & 15, cc = c & 31, ob = rr * 64 + cc * 2; return st * 1024 + (ob ^ (((ob >> 9) & 1) << 5)); }
__host__ __device__ __forceinline__ void stage_rc(int b, int& R, int& C) { const int st = b / 1024, sb = b % 1024, swz = sb ^ (((sb >> 9) & 1) << 5); R = (st >> 1) * 16 + swz / 64; C = (st & 1) * 32 + (swz % 64) / 2; }
__host__ __device__ __forceinline__ int perm32(int rho) { const int n = rho >> 4, i = rho & 15; return 8 * (i >> 2) + 4 * n + (i & 3); }

struct Unit { int pm, pn; };
struct Gemm { const bf16* A; const bf16* Bt; int M, N, K; };

struct StaticOrder {
    int nM, nN, nwg, G, c;
    __host__ __device__ void init(int M, int N, int G_, int c_) { nM = M / BM; nN = N / BM; nwg = nM * nN; G = G_; c = c_; }
    __host__ __device__ bool next(int i, Unit& u) const {
        const long L = (long)i * G + c; if (L >= nwg) return false;
        int wgid = (int)L; { const int q = nwg / NXCD, r = nwg % NXCD, xcd = wgid % NXCD, off = wgid / NXCD; wgid = (xcd < r ? xcd * (q + 1) : r * (q + 1) + (xcd - r) * q) + off; }
        const int nig = WGM * nN, gid = wgid / nig, fm = gid * WGM, gsz = (nM - fm) < WGM ? (nM - fm) : WGM;
        u.pm = fm + ((wgid % nig) % gsz); u.pn = (wgid % nig) / gsz; return true;
    }
};

#define G_SILU_IN_ATTN 1
#define EPI_ST_MODE 0
#if EPI_ST_MODE == 1
__device__ __forceinline__ void st16_wt(void* p, u32x4 w) { asm volatile("global_store_dwordx4 %0, %1, off\n\ts_nop 1" :: "v"(p), "v"(w) : "memory"); }
#define EPI_ST16(ptr, w) st16_wt((void*)(ptr), (w))
#else
#define EPI_ST16(ptr, w) (*(u32x4*)(ptr) = (w))
#endif
__device__ __forceinline__ float fq_sum(float x) {
    unsigned a = __float_as_uint(x);
    { const auto r = __builtin_amdgcn_permlane16_swap(a, a, false, false); a = __float_as_uint(__uint_as_float(r[0]) + __uint_as_float(r[1])); }
    { const auto r = __builtin_amdgcn_permlane32_swap(a, a, false, false); a = __float_as_uint(__uint_as_float(r[0]) + __uint_as_float(r[1])); }
    return __uint_as_float(a);
}
__device__ __forceinline__ unsigned cvt_pk_bf16(float lo, float hi) { unsigned r; asm volatile("v_cvt_pk_bf16_f32 %0, %1, %2" : "=v"(r) : "v"(lo), "v"(hi)); return r; }

struct Epi {
    int mode; bool perm;
    unsigned act_silu, act_sig;
    const float* fin_g; unsigned* fin_cnt; float* fin_out;
    bf16* O; int ldc; const float* rs;
    const float* xold; float* xout; bf16* xb; bf16* xl; float* rsout;
    const bf16* zs; const bf16* gatep; int gate_ld; const float* gb;
    __device__ __forceinline__ void operator()(f32x4 (&acc)[2][2][4][2], const Unit& u, int wr, int wc, int fr, int fq, LAS float* rcache, int& cached_pm) const {
#if defined(PROBE_NULLEPI)
        if (mode == 7) {
#pragma unroll
            for (int a_ = 0; a_ < 2; ++a_)
#pragma unroll
                for (int b_ = 0; b_ < 2; ++b_)
#pragma unroll
                    for (int m_ = 0; m_ < 4; ++m_)
#pragma unroll
                        for (int n_ = 0; n_ < 2; ++n_) asm volatile("" :: "v"(acc[a_][b_][m_][n_]));
            return; }
#endif
        if (mode == 0) {
            const int row0 = u.pm * BM + wr * 64 + fr, col0 = u.pn * BM + wc * 32 + 8 * fq;
            const int act = ((act_silu >> u.pn) & 1u) ? 1 : (((act_sig >> u.pn) & 1u) ? 2 : 0);
            float scv[2][4];
            if (rs) {
                if (cached_pm == u.pm) { const f32x4 c0 = *(const LAS f32x4*)rcache, c1 = *(const LAS f32x4*)(rcache + 4);
#pragma unroll
                    for (int e = 0; e < 4; ++e) { scv[0][e] = c0[e]; scv[1][e] = c1[e]; } }
                else {
                    f32x4 rsv[2][4];
#pragma unroll
                    for (int ai = 0; ai < 2; ++ai)
#pragma unroll
                        for (int m = 0; m < 4; ++m) rsv[ai][m] = *(const f32x4*)(rs + (size_t)(row0 + ai * HALF + m * 16) * 16 + 4 * fq);
#pragma unroll
                    for (int ai = 0; ai < 2; ++ai)
#pragma unroll
                        for (int m = 0; m < 4; ++m) { const f32x4 a = rsv[ai][m]; float sq = (a[0] + a[1]) + (a[2] + a[3]); sq = fq_sum(sq);
                            scv[ai][m] = __builtin_amdgcn_rsqf(sq * (1.0f / 1024.0f) + EPS); }
                    *(LAS f32x4*)rcache = (f32x4){scv[0][0], scv[0][1], scv[0][2], scv[0][3]}; *(LAS f32x4*)(rcache + 4) = (f32x4){scv[1][0], scv[1][1], scv[1][2], scv[1][3]};
                    cached_pm = u.pm;
                }
            }
#pragma unroll
            for (int ai = 0; ai < 2; ++ai)
#pragma unroll
                for (int m = 0; m < 4; ++m) {
                    const int row = row0 + ai * HALF + m * 16;
                    const float sc = rs ? scv[ai][m] : 1.f;
                    bf16* rowp = O + (size_t)row * ldc + col0;
#pragma unroll
                    for (int bj = 0; bj < 2; ++bj) { f32x4 v0 = acc[ai][bj][m][0] * sc, v1 = acc[ai][bj][m][1] * sc;
                        if (act) {
#pragma unroll
                            for (int e = 0; e < 4; ++e) { const float s0 = fast_sigmoid(v0[e]), s1 = fast_sigmoid(v1[e]); v0[e] = (act == 1) ? v0[e] * s0 : s0; v1[e] = (act == 1) ? v1[e] * s1 : s1; } }
                        u32x4 w; w.x = cvt_pk_bf16(v0[0], v0[1]); w.y = cvt_pk_bf16(v0[2], v0[3]); w.z = cvt_pk_bf16(v1[0], v1[1]); w.w = cvt_pk_bf16(v1[2], v1[3]);
                        EPI_ST16(rowp + bj * HALF, w); }
                }
        } else if (mode == 1) {
            const int row0 = u.pm * BM + wr * 64 + fr, col0 = u.pn * BM + wc * 32 + 8 * fq;
            if (xold) {
#pragma unroll
                for (int aim = 0; aim < 4; ++aim) { const int ai = aim >> 1;
                    f32x4 xf[2][2][2];
#pragma unroll
                    for (int mm = 0; mm < 2; ++mm)
#pragma unroll
                        for (int bj = 0; bj < 2; ++bj) { const size_t off = (size_t)(row0 + ai * HALF + (2 * (aim & 1) + mm) * 16) * DM + col0 + bj * HALF; xf[mm][bj][0] = *(const f32x4*)(xold + off); xf[mm][bj][1] = *(const f32x4*)(xold + off + 4); }
#pragma unroll
                    for (int mm = 0; mm < 2; ++mm) { const int m = 2 * (aim & 1) + mm;
                        const int row = row0 + ai * HALF + m * 16; const size_t off = (size_t)row * DM + col0; float ss = 0.f;
#pragma unroll
                        for (int bj = 0; bj < 2; ++bj) {
                            const f32x4 x0 = xf[mm][bj][0] + acc[ai][bj][m][0], x1 = xf[mm][bj][1] + acc[ai][bj][m][1];
                            ss += ((x0[0] * x0[0] + x0[1] * x0[1]) + (x0[2] * x0[2] + x0[3] * x0[3])) + ((x1[0] * x1[0] + x1[1] * x1[1]) + (x1[2] * x1[2] + x1[3] * x1[3]));
                            u32x4 wh; wh.x = cvt_pk_bf16(x0[0], x0[1]); wh.y = cvt_pk_bf16(x0[2], x0[3]); wh.z = cvt_pk_bf16(x1[0], x1[1]); wh.w = cvt_pk_bf16(x1[2], x1[3]);
                            EPI_ST16(xb + off + bj * HALF, wh); }
                        ss = fq_sum(ss);
                        if (fq == 0) rsout[(size_t)row * 16 + u.pn * 4 + wc] = ss;
                    }
                }
            } else {
                u32x4 xin[2][4][2];
#pragma unroll
                for (int ai = 0; ai < 2; ++ai)
#pragma unroll
                    for (int m = 0; m < 4; ++m)
#pragma unroll
                        for (int bj = 0; bj < 2; ++bj) xin[ai][m][bj] = *(const u32x4*)(xb + (size_t)(row0 + ai * HALF + m * 16) * DM + col0 + bj * HALF);
#pragma unroll
                for (int ai = 0; ai < 2; ++ai)
#pragma unroll
                    for (int m = 0; m < 4; ++m) {
                        const int row = row0 + ai * HALF + m * 16; const size_t off = (size_t)row * DM + col0; float ss = 0.f;
#pragma unroll
                        for (int bj = 0; bj < 2; ++bj) {
                            float x[8]; unpack8(xin[ai][m][bj], x);
#pragma unroll
                            for (int e = 0; e < 4; ++e) { x[e] += acc[ai][bj][m][0][e]; x[4 + e] += acc[ai][bj][m][1][e]; }
#pragma unroll
                            for (int e = 0; e < 8; ++e) ss += x[e] * x[e];
                            u32x4 wh; wh.x = cvt_pk_bf16(x[0], x[1]); wh.y = cvt_pk_bf16(x[2], x[3]); wh.z = cvt_pk_bf16(x[4], x[5]); wh.w = cvt_pk_bf16(x[6], x[7]);
                            EPI_ST16(xb + off + bj * HALF, wh); }
                        ss = fq_sum(ss);
                        if (fq == 0) rsout[(size_t)row * 16 + u.pn * 4 + wc] = ss;
                    }
            }
        } else if (mode == 6) {
            const int row0 = u.pm * BM + wr * 64 + fr, col0 = u.pn * BM + wc * 32 + 8 * fq;
            u32x4 xin[2][4][2];
#pragma unroll
            for (int ai = 0; ai < 2; ++ai)
#pragma unroll
                for (int m = 0; m < 4; ++m)
#pragma unroll
                    for (int bj = 0; bj < 2; ++bj) xin[ai][m][bj] = *(const u32x4*)(xb + (size_t)(row0 + ai * HALF + m * 16) * DM + col0 + bj * HALF);
#pragma unroll
            for (int ai = 0; ai < 2; ++ai)
#pragma unroll
                for (int m = 0; m < 4; ++m) {
                    const int row = row0 + ai * HALF + m * 16; float ss = 0.f;
#pragma unroll
                    for (int bj = 0; bj < 2; ++bj)
                    { float h[8]; unpack8(xin[ai][m][bj], h);
#pragma unroll
                        for (int n = 0; n < 2; ++n) { f32x4 x = acc[ai][bj][m][n];
#pragma unroll
                            for (int e = 0; e < 4; ++e) x[e] += h[4 * n + e];
                            acc[ai][bj][m][n] = x; ss += (x[0] * x[0] + x[1] * x[1]) + (x[2] * x[2] + x[3] * x[3]); } }
                    ss = fq_sum(ss);
                    if (fq == 0) __hip_atomic_store(rsout + (size_t)row * 16 + u.pn * 4 + wc, ss, __ATOMIC_RELAXED, __HIP_MEMORY_SCOPE_AGENT);
                }
            asm volatile("s_waitcnt vmcnt(0)" ::: "memory");
            unsigned* cnt = fin_cnt + 64 * u.pm;
            if (fr == 0 && fq == 0) __hip_atomic_fetch_add(cnt, 1u, __ATOMIC_RELAXED, __HIP_MEMORY_SCOPE_AGENT);
            for (unsigned sp = 0; sp < (1u << 20); ++sp) {
                if ((unsigned)__builtin_amdgcn_readfirstlane((int)__hip_atomic_load(cnt, __ATOMIC_RELAXED, __HIP_MEMORY_SCOPE_AGENT)) >= 32u) break;
                __builtin_amdgcn_s_sleep(2);
            }
            float tsl[2][4]; f32x4 gv[2][2];
#pragma unroll
            for (int ai = 0; ai < 2; ++ai)
#pragma unroll
                for (int m = 0; m < 4; ++m) { const float* sl = rsout + (size_t)(row0 + ai * HALF + m * 16) * 16 + 4 * fq;
                    tsl[ai][m] = (__hip_atomic_load(sl, __ATOMIC_RELAXED, __HIP_MEMORY_SCOPE_AGENT) + __hip_atomic_load(sl + 1, __ATOMIC_RELAXED, __HIP_MEMORY_SCOPE_AGENT))
                               + (__hip_atomic_load(sl + 2, __ATOMIC_RELAXED, __HIP_MEMORY_SCOPE_AGENT) + __hip_atomic_load(sl + 3, __ATOMIC_RELAXED, __HIP_MEMORY_SCOPE_AGENT)); }
#pragma unroll
            for (int bj = 0; bj < 2; ++bj)
#pragma unroll
                for (int n = 0; n < 2; ++n) gv[bj][n] = *(const f32x4*)(fin_g + col0 + bj * HALF + n * 4);
#pragma unroll
            for (int ai = 0; ai < 2; ++ai)
#pragma unroll
                for (int m = 0; m < 4; ++m) {
                    const int row = row0 + ai * HALF + m * 16; const size_t off = (size_t)row * DM + col0;
                    float t = tsl[ai][m]; t = fq_sum(t);
                    const float rstd = __builtin_amdgcn_rsqf(t * (1.0f / 1024.0f) + EPS);
#pragma unroll
                    for (int bj = 0; bj < 2; ++bj)
#pragma unroll
                        for (int n = 0; n < 2; ++n) *(f32x4*)(fin_out + off + bj * HALF + n * 4) = acc[ai][bj][m][n] * rstd * gv[bj][n];
                }
        } else if (mode == 5 || mode == 8) {
            const int row0 = u.pm * BM + wr * 64 + fr, col0 = u.pn * BM + wc * 32 + 8 * fq;
            const int quarter = u.pn >> 2; bf16* const Oq = O + (size_t)quarter * ((size_t)MTOK * 1024);
            float scv[2][4];
            if (cached_pm == u.pm) { const f32x4 c0 = *(const LAS f32x4*)rcache, c1 = *(const LAS f32x4*)(rcache + 4);
#pragma unroll
                for (int e = 0; e < 4; ++e) { scv[0][e] = c0[e]; scv[1][e] = c1[e]; } }
            else {
                f32x4 rsv[2][4];
#pragma unroll
                for (int ai = 0; ai < 2; ++ai)
#pragma unroll
                    for (int m = 0; m < 4; ++m) rsv[ai][m] = *(const f32x4*)(rs + (size_t)(row0 + ai * HALF + m * 16) * 16 + 4 * fq);
#pragma unroll
                for (int ai = 0; ai < 2; ++ai)
#pragma unroll
                    for (int m = 0; m < 4; ++m) { const f32x4 a = rsv[ai][m]; float sq = (a[0] + a[1]) + (a[2] + a[3]); sq = fq_sum(sq);
                        scv[ai][m] = __builtin_amdgcn_rsqf(sq * (1.0f / 1024.0f) + EPS); }
                *(LAS f32x4*)rcache = (f32x4){scv[0][0], scv[0][1], scv[0][2], scv[0][3]}; *(LAS f32x4*)(rcache + 4) = (f32x4){scv[1][0], scv[1][1], scv[1][2], scv[1][3]};
                cached_pm = u.pm;
            }
#pragma unroll
            for (int ai = 0; ai < 2; ++ai)
#pragma unroll
                for (int m = 0; m < 4; ++m) {
                    const int row = row0 + ai * HALF + m * 16;
                    const float sc = scv[ai][m];
                    const int bb = row >> 13, tt = row & 8191, chunk = tt >> 6, key = tt & 63;
#pragma unroll
                    for (int bj = 0; bj < 2; ++bj) { const int cc = (col0 + bj * HALF) & 1023, h = cc >> 6, dc = (cc & 63) >> 3;
                        f32x4 v0 = acc[ai][bj][m][0] * sc, v1 = acc[ai][bj][m][1] * sc;
#if !G_SILU_IN_ATTN
                        if (quarter == 3) {
#pragma unroll
                            for (int e = 0; e < 4; ++e) { v0[e] *= fast_sigmoid(v0[e]); v1[e] *= fast_sigmoid(v1[e]); } }
#endif
                        u32x4 w; w.x = cvt_pk_bf16(v0[0], v0[1]); w.y = cvt_pk_bf16(v0[2], v0[3]); w.z = cvt_pk_bf16(v1[0], v1[1]); w.w = cvt_pk_bf16(v1[2], v1[3]);
                        size_t off;
                        if (quarter == 1) off = ((size_t)(((bb * 16 + h) * 128 + chunk) * 8 + dc) * 64 + key) * 8;
                        else if (quarter == 2) off = (size_t)((bb * 16 + h) * 128 + chunk) * 4096 + key * 64 + ((dc ^ (((key >> 1) & 1) << 2)) * 8);
                        else off = (size_t)row * 1024 + cc;
#if defined(PROBE_NULLEPI)
                        if (mode == 8) asm volatile("" :: "v"(w), "v"(Oq + off)); else
#endif
                        EPI_ST16(Oq + off, w); }
                }
        } else if (mode == 3) {
            const int row0 = u.pm * BM + wr * 64 + fr, col0 = u.pn * BM + wc * 32 + 8 * fq;
#pragma unroll
            for (int ai = 0; ai < 2; ++ai)
#pragma unroll
                for (int m = 0; m < 4; ++m) {
                    const int row = row0 + ai * HALF + m * 16, b = row >> 8, key = row & 255;
#pragma unroll
                    for (int bj = 0; bj < 2; ++bj) { const int col = col0 + bj * HALF, l = col >> 10, hx = (col >> 8) & 3, dc = (col & 255) >> 3;
                        const f32x4 v0 = acc[ai][bj][m][0], v1 = acc[ai][bj][m][1];
                        u32x4 w; w.x = cvt_pk_bf16(v0[0], v0[1]); w.y = cvt_pk_bf16(v0[2], v0[3]); w.z = cvt_pk_bf16(v1[0], v1[1]); w.w = cvt_pk_bf16(v1[2], v1[3]);
                        *(u32x4*)(O + ((size_t)((((l * 4 + b) * 4 + hx) * 32 + dc) * 256 + key)) * 8) = w; }
                }
        } else if (mode == 4) {
            const int row0 = u.pm * BM + wr * 64 + fr, col0 = u.pn * BM + wc * 32 + 8 * fq;
#pragma unroll
            for (int ai = 0; ai < 2; ++ai)
#pragma unroll
                for (int m = 0; m < 4; ++m) {
                    const int row = row0 + ai * HALF + m * 16, l = row >> 10, hx = (row >> 8) & 3, d = row & 255;
#pragma unroll
                    for (int bj = 0; bj < 2; ++bj) { const int col = col0 + bj * HALF, b = col >> 8, kg = (col & 255) >> 2;
                        const f32x4 v0 = acc[ai][bj][m][0], v1 = acc[ai][bj][m][1];
                        u32x2 w0, w1; w0.x = cvt_pk_bf16(v0[0], v0[1]); w0.y = cvt_pk_bf16(v0[2], v0[3]); w1.x = cvt_pk_bf16(v1[0], v1[1]); w1.y = cvt_pk_bf16(v1[2], v1[3]);
                        bf16* p = O + ((size_t)((((l * 4 + b) * 4 + hx) * 64 + kg) * 256 + d)) * 4;
                        *(u32x2*)p = w0; *(u32x2*)(p + 256 * 4) = w1; }
                }
        } else {
            const int row0 = u.pm * BM + wr * 64 + fr, col0 = u.pn * BM + wc * 32 + 8 * fq;
            const f32x4 bb[2][2] = {{*(const f32x4*)(gb + col0), *(const f32x4*)(gb + col0 + 4)}, {*(const f32x4*)(gb + col0 + HALF), *(const f32x4*)(gb + col0 + HALF + 4)}};
            u32x4 zin[2][2], gin[2][2];
#define GLU_LOAD(buf, q_) do { const int bj_ = (q_) >> 2, ai_ = ((q_) >> 1) & 1, mh_ = (q_) & 1; _Pragma("unroll") for (int mm = 0; mm < 2; ++mm) { const int row_ = row0 + ai_ * HALF + (2 * mh_ + mm) * 16, col_ = col0 + bj_ * HALF; \
                zin[buf][mm] = *(const u32x4*)(zs + (size_t)row_ * S5W + col_); gin[buf][mm] = *(const u32x4*)(gatep + (size_t)row_ * gate_ld + col_); } } while (0)
            GLU_LOAD(0, 0);
#pragma unroll
            for (int q = 0; q < 8; ++q) { const int bj = q >> 2, ai = (q >> 1) & 1, mh = q & 1, cbuf = q & 1;
                if (q + 1 < 8) { if (cbuf == 0) GLU_LOAD(1, q + 1); else GLU_LOAD(0, q + 1); }
                const int col = col0 + bj * HALF; const f32x4 b0 = bb[bj][0], b1 = bb[bj][1];
#pragma unroll
                for (int mm = 0; mm < 2; ++mm) { const int m = 2 * mh + mm;
                    const int row = row0 + ai * HALF + m * 16;
                    const u32x4 zw = zin[cbuf][mm]; const u32x4 gw = gin[cbuf][mm];
                    float z[8], g[8], o[8]; unpack8(zw, z); unpack8(gw, g);
                    const f32x4 a0 = acc[ai][bj][m][0] + b0, a1 = acc[ai][bj][m][1] + b1;
#pragma unroll
                    for (int e = 0; e < 4; ++e) { o[e] = z[e] * fast_sigmoid(a0[e]) * g[e]; o[4 + e] = z[4 + e] * fast_sigmoid(a1[e]) * g[4 + e]; }
                    u32x4 w; w.x = cvt_pk_bf16(o[0], o[1]); w.y = cvt_pk_bf16(o[2], o[3]); w.z = cvt_pk_bf16(o[4], o[5]); w.w = cvt_pk_bf16(o[6], o[7]);
                    *(u32x4*)(O + (size_t)row * ldc + col) = w;
                }
            }
#undef GLU_LOAD
        }
    }
};

struct PairOrder {
    int vcu;
    __device__ __forceinline__ bool next(int i, Unit& u) const { if (i >= 4) return false;
        u.pm = (i >> 1) * 64 + (vcu >> 5) * 8 + ((vcu & 31) >> 2); u.pn = (vcu & 3) + 4 * (i & 1); return true; }
};
template <class Sched> __device__ __forceinline__ void gemm_phase(const int wid, LAS unsigned char* lds, const Gemm g, const Sched& S, const Epi& E) {
    const int lane = lane_id_v(), tid = wid * 64 + lane, wr = wid >> 2, wc = wid & 3, fr = lane & 15, fq = lane >> 4;
    const int K = g.K, nt = K / BK;
    unsigned voffA[2], voffB[2];
#pragma unroll
    for (int i = 0; i < 2; ++i) { int R, C; stage_rc(tid * 16 + i * 8192, R, C); const int Rb = E.perm ? ((R & ~31) + perm32(R & 31)) : R;
        voffA[i] = (unsigned)(R * K + C) * 2u; voffB[i] = (unsigned)(Rb * K + C) * 2u; }
    const size_t kstep = (size_t)(BK * 2);
    const size_t hstep = (size_t)HALF * K * 2;
    const size_t tstep = 2 * hstep;
    const unsigned ldsw = (unsigned)wid * 1024u;
    const int aoff = lds_byte(wr * 64 + fr, fq * 8), boff = lds_byte(wc * 32 + fr, fq * 8);
#define PG8_SA(b, h) (((b) * 2 + (h)) * HTB)
#define PG8_SB(b, h) ((4 + (b) * 2 + (h)) * HTB)
#define PG8_STAGE(bufoff, gbase, voff) do { _Pragma("unroll") for (int _i = 0; _i < 2; ++_i) \
        __builtin_amdgcn_global_load_lds((const unsigned*)((const char*)(gbase) + (voff)[_i]), (LAS unsigned*)(lds + (bufoff) + ldsw + _i * 8192), 16, 0, 0); } while (0)
#define PG8_LDA(dst, b, h) do { _Pragma("unroll") for (int m = 0; m < 4; ++m) _Pragma("unroll") for (int k = 0; k < 2; ++k) dst[m][k] = *(const LAS bf16x8*)(lds + PG8_SA(b, h) + aoff + m * 2048 + k * 1024); } while (0)
#define PG8_LDB(dst, b, h) do { _Pragma("unroll") for (int n = 0; n < 2; ++n) _Pragma("unroll") for (int k = 0; k < 2; ++k) dst[n][k] = *(const LAS bf16x8*)(lds + PG8_SB(b, h) + boff + n * 2048 + k * 1024); } while (0)
#define PG8_MMA(ai, bj, At, Bt) do { __builtin_amdgcn_s_setprio(1); _Pragma("unroll") for (int m = 0; m < 4; ++m) _Pragma("unroll") for (int n = 0; n < 2; ++n) _Pragma("unroll") for (int k = 0; k < 2; ++k) \
        acc[ai][bj][m][n] = __builtin_amdgcn_mfma_f32_16x16x32_bf16(Bt[n][k], At[m][k], acc[ai][bj][m][n], 0, 0, 0); __builtin_amdgcn_s_setprio(0); } while (0)
#define PG8_WAIT_V(n) asm volatile("s_waitcnt vmcnt(" #n ")" ::: "memory")
#define PG8_WAIT_L(n) asm volatile("s_waitcnt lgkmcnt(" #n ")" ::: "memory")
#define PG8_BAR __builtin_amdgcn_s_barrier()
#define PG8_SCHED __builtin_amdgcn_sched_barrier(0)
    Unit cur, nxt; int ui = 0;
    if (!S.next(0, cur)) return;
    int cached_pm = -1; LAS float* const rcache = (LAS float*)(lds + RSTD_OFF) + tid * 8;
    f32x4 acc[2][2][4][2];
#pragma unroll
    for (int a = 0; a < 2; ++a)
#pragma unroll
        for (int b = 0; b < 2; ++b)
#pragma unroll
            for (int m = 0; m < 4; ++m)
#pragma unroll
                for (int n = 0; n < 2; ++n) acc[a][b][m][n] = (f32x4){0.f, 0.f, 0.f, 0.f};
    bf16x8 At[4][2], B0[2][2], B1[2][2];
    const char* cA = (const char*)g.A + (size_t)cur.pm * tstep; const char* cB = (const char*)g.Bt + (size_t)cur.pn * tstep;
    PG8_STAGE(PG8_SB(0, 0), cB, voffB); PG8_STAGE(PG8_SB(0, 1), cB + hstep, voffB); PG8_STAGE(PG8_SA(0, 0), cA, voffA); PG8_STAGE(PG8_SA(0, 1), cA + hstep, voffA);
    if (wr == 1) PG8_BAR;
    PG8_WAIT_V(2); PG8_BAR;
    PG8_STAGE(PG8_SB(1, 0), cB + kstep, voffB); PG8_STAGE(PG8_SA(1, 0), cA + kstep, voffA); PG8_STAGE(PG8_SB(1, 1), cB + hstep + kstep, voffB);
    PG8_WAIT_V(6); PG8_BAR;
    for (;;) {
        const bool has_next = S.next(ui + 1, nxt);
        const char* nA = has_next ? (const char*)g.A + (size_t)nxt.pm * tstep : cA; const char* nB = has_next ? (const char*)g.Bt + (size_t)nxt.pn * tstep : cB;
        for (int t = 0; t < nt; t += 2) {
            const bool last = (t == nt - 2);
            const char* a1 = cA + (size_t)(t + 1) * kstep;
            const char* a2 = last ? nA : cA + (size_t)(t + 2) * kstep; const char* b2 = last ? nB : cB + (size_t)(t + 2) * kstep;
            const char* a3 = a2 + kstep; const char* b3 = b2 + kstep;
            PG8_LDB(B0, 0, 0); PG8_LDB(B1, 0, 1); PG8_SCHED; PG8_LDA(At, 0, 0); PG8_STAGE(PG8_SA(1, 1), a1 + hstep, voffA);
            PG8_WAIT_V(8); PG8_WAIT_L(0); PG8_BAR; PG8_MMA(0, 0, At, B0); PG8_MMA(0, 1, At, B1); PG8_BAR; PG8_SCHED;
            PG8_LDA(At, 0, 1); PG8_STAGE(PG8_SB(0, 0), b2, voffB); PG8_STAGE(PG8_SB(0, 1), b2 + hstep, voffB); PG8_STAGE(PG8_SA(0, 0), a2, voffA);
            PG8_WAIT_V(8); PG8_WAIT_L(0); PG8_BAR; PG8_MMA(1, 0, At, B0); PG8_MMA(1, 1, At, B1); PG8_BAR; PG8_SCHED;
            PG8_LDB(B0, 1, 0); PG8_LDB(B1, 1, 1); PG8_SCHED; PG8_LDA(At, 1, 0); PG8_STAGE(PG8_SA(0, 1), a2 + hstep, voffA);
            PG8_WAIT_V(8); PG8_WAIT_L(0); PG8_BAR; PG8_MMA(0, 0, At, B0); PG8_MMA(0, 1, At, B1); PG8_BAR; PG8_SCHED;
            PG8_LDA(At, 1, 1); PG8_STAGE(PG8_SB(1, 0), b3, voffB); PG8_STAGE(PG8_SB(1, 1), b3 + hstep, voffB); PG8_STAGE(PG8_SA(1, 0), a3, voffA);
            PG8_WAIT_V(8); PG8_WAIT_L(0); PG8_BAR; PG8_MMA(1, 0, At, B0); PG8_MMA(1, 1, At, B1); PG8_BAR; PG8_SCHED;
        }
        if (wr == 0) PG8_BAR;
        E(acc, cur, wr, wc, fr, fq, rcache, cached_pm);
        if (!has_next) break;
#pragma unroll
        for (int a = 0; a < 2; ++a)
#pragma unroll
            for (int b = 0; b < 2; ++b)
#pragma unroll
                for (int m = 0; m < 4; ++m)
#pragma unroll
                    for (int n = 0; n < 2; ++n) acc[a][b][m][n] = (f32x4){0.f, 0.f, 0.f, 0.f};
        cur = nxt; cA = nA; cB = nB; ++ui;
        if (wr == 1) PG8_BAR;
    }
    PG8_WAIT_V(0);
    PG8_BAR;
#undef PG8_SA
#undef PG8_SB
#undef PG8_STAGE
#undef PG8_LDA
#undef PG8_LDB
#undef PG8_MMA
#undef PG8_WAIT_V
#undef PG8_WAIT_L
#undef PG8_BAR
#undef PG8_SCHED
}
}

#define XB_TMO      128
#define XB_XCNT(j)  (256  + 64 * (j))
#define XB_XSUB(j)  (1280 + 64 * (j))
#define XB_XGEN(j)  (2304 + 64 * (j))
#define XB_TOP      3328
#define XB_TOPGEN   3392
#define XCD_BAR_WORDS 3456
#define XB_SPIN_CAP (1u << 18)
__device__ __forceinline__ unsigned xb_ld(unsigned* p)              { return __hip_atomic_load(p, __ATOMIC_RELAXED, __HIP_MEMORY_SCOPE_AGENT); }
__device__ __forceinline__ unsigned xb_add(unsigned* p, unsigned v) { return __hip_atomic_fetch_add(p, v, __ATOMIC_RELAXED, __HIP_MEMORY_SCOPE_AGENT); }
__device__ __forceinline__ unsigned xb_xcc_id() { return (unsigned)__builtin_amdgcn_s_getreg((3 << 11) | 20) & 0xFu; }
#define XB_SPIN(cond, bar) do { unsigned _sp = 0; while (cond) { __builtin_amdgcn_s_sleep(1); \
    if ((++_sp & 255u) == 0u) { if (xb_ld(&(bar)[XB_TMO])) break; if (_sp > XB_SPIN_CAP) { atomicAdd(&(bar)[XB_TMO], 1u); break; } } } } while (0)
struct XcdBarrier { unsigned* bar; unsigned x; volatile LAS unsigned* st; int wave; };
__device__ __forceinline__ XcdBarrier xcd_barrier_post(unsigned* bar, volatile LAS unsigned* st, int wave) {
    XcdBarrier b; b.bar = bar; b.x = xb_xcc_id(); b.st = st; b.wave = wave;
    if (wave == 0 && lane_id_v() == 0) (void)xb_add(&bar[XB_XCNT(b.x)], 1u);
    return b;
}
__device__ __forceinline__ void xcd_barrier_complete(unsigned* bar, unsigned x, unsigned& nloc, unsigned& nx) {
    const unsigned G = gridDim.x * gridDim.y * gridDim.z;
    unsigned sum, cnt, mine, sp = 0u;
    for (;;) {
        sum = 0u; cnt = 0u; mine = 0u;
#pragma unroll
        for (unsigned j = 0; j < 16; ++j) { const unsigned c = xb_ld(&bar[XB_XCNT(j)]); sum += c; cnt += (c > 0u) ? 1u : 0u; mine = (j == x) ? c : mine; }
        if (sum == G) break;
        __builtin_amdgcn_s_sleep(1);
        if ((++sp & 255u) == 0u) { if (xb_ld(&bar[XB_TMO])) break; if (sp > XB_SPIN_CAP) { atomicAdd(&bar[XB_TMO], 1u); break; } }
    }
    nloc = mine > 0u ? mine : 1u; nx = cnt > 0u ? cnt : 1u;
}
__device__ __forceinline__ void xcd_barrier(const XcdBarrier& b) {
    asm volatile("s_waitcnt vmcnt(0)" ::: "memory");
    __syncthreads();
    if (b.wave == 0 && lane_id_v() == 0) {
        unsigned* bar = b.bar;
        __builtin_amdgcn_s_waitcnt(0);
        unsigned nloc = b.st[0], nx = b.st[1];
        if (nloc == 0u) { xcd_barrier_complete(bar, b.x, nloc, nx); b.st[0] = nloc; b.st[1] = nx; }
        const unsigned old = xb_add(&bar[XB_XSUB(b.x)], 1u);
        const unsigned gen = old / nloc;
        if (old + 1u == (gen + 1u) * nloc) {
            __builtin_amdgcn_fence(__ATOMIC_RELEASE, "agent");
            asm volatile("s_waitcnt vmcnt(0)" ::: "memory");
            const unsigned og = xb_add(&bar[XB_TOP], 1u);
            const unsigned tg = og / nx;
            if (og + 1u == (tg + 1u) * nx) xb_add(&bar[XB_TOPGEN], 1u);
            else XB_SPIN(xb_ld(&bar[XB_TOPGEN]) == tg, bar);
            __builtin_amdgcn_fence(__ATOMIC_ACQUIRE, "agent");
            xb_add(&bar[XB_XGEN(b.x)], 1u);
            asm volatile("s_waitcnt vmcnt(0)" ::: "memory");
        } else {
            XB_SPIN(xb_ld(&bar[XB_XGEN(b.x)]) == gen, bar);
            __builtin_amdgcn_fence(__ATOMIC_ACQUIRE, "agent");
            asm volatile("s_waitcnt vmcnt(0)" ::: "memory");
        }
    }
    __syncthreads();
}

struct Args { const float* in[29]; float* out; unsigned char* ws; int ph_lo, ph_hi; };
struct Frame {
    LAS unsigned char* lds; volatile LAS unsigned* MISC; unsigned* ctl;
    int wave, vcu, G;
    unsigned char* ws; float* out;
};

__device__ __forceinline__ void p0_transpose_item(const float* W, const float* gain, int K, int N, bf16* WT, int qcols, float qscale, LAS float* scr, int item, int lane, int kvsplit = 0) {
    const int nblk = N / 32, kb = item / nblk, nb = item % nblk, k0 = 64 * kb, n0 = 32 * nb;
    const float cs = (n0 < qcols) ? qscale : 1.0f;
    float wv[32];
#pragma unroll
    for (int i = 0; i < 32; ++i) wv[i] = W[(size_t)(k0 + 2 * i + (lane >> 5)) * N + n0 + (lane & 31)];
    if (gain) {
#pragma unroll
        for (int i = 0; i < 32; ++i) wv[i] *= gain[k0 + 2 * i + (lane >> 5)];
    }
#pragma unroll
    for (int i = 0; i < 32; ++i) scr[(2 * i + (lane >> 5)) * 33 + (lane & 31)] = wv[i] * cs;
    asm volatile("s_waitcnt lgkmcnt(0)" ::: "memory");
    const int c = lane & 7;
#pragma unroll
    for (int j = 0; j < 4; ++j) { const int n = (lane >> 3) + 8 * j; const LAS float* s = scr + (8 * c) * 33 + n;
        u32x4 o; o.x = pk2(s[0 * 33], s[1 * 33]); o.y = pk2(s[2 * 33], s[3 * 33]); o.z = pk2(s[4 * 33], s[5 * 33]); o.w = pk2(s[6 * 33], s[7 * 33]);
        const int drow = kvsplit ? ((n0 < 1024) ? (n0 + n) : (n0 + n + 1024)) : (n0 + n);
        *(u32x4*)(WT + (size_t)drow * K + k0 + 8 * c) = o; }
    asm volatile("s_waitcnt lgkmcnt(0)" ::: "memory");
}

__device__ __forceinline__ void p1_late_weights(Frame& F, const Args& a, int gwl, int nwl) {
    LAS float* scr = (LAS float*)(F.lds + F.wave * 16384);
    const int lane = lane_id_v(); unsigned char* ws = F.ws;
    constexpr int I_OUT = 16 * 32, I_GLU = 8 * 16, I_IN1 = 16 * 128, I_QG = 16 * 64, I_O = 16 * 32;
    constexpr int NITEMS = I_OUT + I_GLU + I_IN1 + I_OUT + 2 * I_QG + 2 * I_O;
    for (int it = gwl; it < NITEMS; it += nwl) {
        int r = it;
        if (r < I_OUT) { p0_transpose_item(a.in[19], nullptr, DM, DM, (bf16*)(ws + WS_W_OUT0), 0, 1.f, scr, r, lane); continue; } r -= I_OUT;
        if (r < I_GLU) { p0_transpose_item(a.in[13], nullptr, S5W, S5W, (bf16*)(ws + WS_W_GLU), 0, 1.f, scr, r, lane); continue; } r -= I_GLU;
        if (r < I_IN1) { p0_transpose_item(a.in[21], a.in[20], DM, ODD_IN, (bf16*)(ws + WS_W_IN1), DM, QSCALE_ATT, scr, r, lane); continue; } r -= I_IN1;
        if (r < I_OUT) { p0_transpose_item(a.in[23], nullptr, DM, DM, (bf16*)(ws + WS_W_OUT1), 0, 1.f, scr, r, lane); continue; } r -= I_OUT;
        if (r < 2 * I_QG) { const int l = r / I_QG; p0_transpose_item(a.in[25] + (size_t)l * DM * 2048, a.in[24] + l * DM, DM, 2048, (bf16*)(ws + WS_W_QG) + (size_t)l * 2048 * DM, DM, QSCALE_XA, scr, r % I_QG, lane); continue; } r -= 2 * I_QG;
        { const int l = r / I_O; p0_transpose_item(a.in[27] + (size_t)l * DM * DM, nullptr, DM, DM, (bf16*)(ws + WS_W_O) + (size_t)l * DM * DM, 0, 1.f, scr, r % I_O, lane); }
    }
}
__device__ __forceinline__ void p0_prologue(Frame& F, const Args& a) {
    LAS float* scr = (LAS float*)(F.lds + F.wave * 16384);
    const int gw = F.vcu * NWAVES + F.wave, NGW = F.G * NWAVES, lane = lane_id_v();
    unsigned char* ws = F.ws;
    constexpr int I_IN0 = 16 * 80, I_KV = 16 * 64;
    constexpr int NITEMS = I_IN0 + 2 * I_KV;
    for (int it = gw; it < NITEMS; it += NGW) {
        int r = it;
        if (r < I_IN0) { p0_transpose_item(a.in[4], a.in[3], DM, EVEN_IN, (bf16*)(ws + WS_W_IN0), 0, 1.f, scr, r, lane); continue; } r -= I_IN0;
        { const int l = r / I_KV; p0_transpose_item(a.in[26] + (size_t)l * DM * 2048, nullptr, DM, 2048, (bf16*)(ws + WS_W_KV) + (size_t)l * 1024 * DM, 0, 1.f, scr, r % I_KV, lane, 1); }
    }
    for (int m = gw; m < BATCH * MEMLEN; m += NGW) {
        const f32x4* xr = (const f32x4*)(a.in[1] + (size_t)m * DM) + lane; const f32x4* gr = (const f32x4*)a.in[2] + lane;
        f32x4 v[4]; float s = 0.f;
#pragma unroll
        for (int j = 0; j < 4; ++j) { v[j] = xr[64 * j]; s += (v[j].x * v[j].x + v[j].y * v[j].y) + (v[j].z * v[j].z + v[j].w * v[j].w); }
        const float rstd = 1.0f / sqrtf(wave_sum(s) * (1.f / DM) + EPS);
        u32x2* o8 = (u32x2*)((bf16*)(ws + WS_MEMN) + (size_t)m * DM) + lane;
#pragma unroll
        for (int j = 0; j < 4; ++j) { const f32x4 g = gr[64 * j]; u32x2 w; w.x = pk2(v[j].x * rstd * g.x, v[j].y * rstd * g.y); w.y = pk2(v[j].z * rstd * g.z, v[j].w * rstd * g.w); o8[64 * j] = w; }
    }
    for (int m0 = gw * 4; m0 < MTOK; m0 += NGW * 4) {
        f32x4 v[4][4];
#pragma unroll
        for (int q = 0; q < 4; ++q)
#pragma unroll
            for (int j = 0; j < 4; ++j) v[q][j] = ((const f32x4*)(a.in[0] + (size_t)(m0 + q) * DM) + lane)[64 * j];
#pragma unroll
        for (int q = 0; q < 4; ++q) {
            u32x2* o8 = (u32x2*)((bf16*)(ws + WS_XB) + (size_t)(m0 + q) * DM) + lane;
            float* rs = (float*)(ws + WS_RS) + (size_t)(m0 + q) * 16;
            float sj[4];
#pragma unroll
            for (int j = 0; j < 4; ++j) { const f32x4 x = v[q][j]; sj[j] = wave_sum((x.x * x.x + x.y * x.y) + (x.z * x.z + x.w * x.w));
                u32x2 w; w.x = pk2(x.x, x.y); w.y = pk2(x.z, x.w); o8[64 * j] = w; }
            if (lane < 16) rs[lane] = (lane & 3) ? 0.f : ((lane >> 2) == 0 ? sj[0] : ((lane >> 2) == 1 ? sj[1] : ((lane >> 2) == 2 ? sj[2] : sj[3])));
        }
    }
    {
        const int gt = (F.vcu * NWAVES + F.wave) * 64 + lane;
        if (gt < NGRP * NST) {
            const int g = gt >> 6;
            const float lr = a.in[5][gt], li = a.in[6][gt], dt = expf(a.in[7][g]);
            const float mag = expf(lr * dt); float sn, cs; sincosf(li * dt, &sn, &cs);
            const float are = mag * cs, aim = mag * sn;
            const float den = lr * lr + li * li, nr = are - 1.0f;
            const float cre = (nr * lr + aim * li) / den, cim = (aim * lr - nr * li) / den;
            float pr = are, pi = aim;
#pragma unroll
            for (int i = 0; i < 6; ++i) { const float t = pr * pr - pi * pi; pi = 2.f * pr * pi; pr = t; }
            ((f32x4*)(ws + WS_PAR))[gt] = (f32x4){are, aim, pr, pi};
            const float* br = a.in[8] + (size_t)gt * 16; const float* bi = a.in[9] + (size_t)gt * 16;
            const int p = gt & 63;
            f32x4 brv[4], biv[4]; float crv[16], civ[16];
#pragma unroll
            for (int q = 0; q < 4; ++q) { brv[q] = ((const f32x4*)br)[q]; biv[q] = ((const f32x4*)bi)[q]; }
#pragma unroll
            for (int co = 0; co < 16; ++co) { crv[co] = a.in[10][(size_t)(g * 16 + co) * 64 + p]; civ[co] = a.in[11][(size_t)(g * 16 + co) * 64 + p]; }
            ((f32x4*)(ws + WS_PAR))[gt] = (f32x4){are, aim, pr, pi};
            bf16* bbt_re = (bf16*)(ws + WS_PAR + 524288) + (size_t)((g * 4 + 2 * (p >> 5)) * 32 + (p & 31)) * 16; bf16* bbt_im = bbt_re + 32 * 16;
#pragma unroll
            for (int q = 0; q < 4; ++q) { u32x2 wr_, wi_; float xr[4], xi[4];
#pragma unroll
                for (int e = 0; e < 4; ++e) { xr[e] = cre * brv[q][e] - cim * biv[q][e]; xi[e] = cre * biv[q][e] + cim * brv[q][e]; }
                wr_.x = pk2(xr[0], xr[1]); wr_.y = pk2(xr[2], xr[3]); wi_.x = pk2(xi[0], xi[1]); wi_.y = pk2(xi[2], xi[3]);
                ((u32x2*)bbt_re)[q] = wr_; ((u32x2*)bbt_im)[q] = wi_; }
            bf16* cmt = (bf16*)(ws + WS_PAR + 655360) + (size_t)g * 16 * 128 + 2 * p;
#pragma unroll
            for (int co = 0; co < 16; ++co) *(unsigned*)(cmt + co * 128) = pk2(crv[co], -civ[co]);
        }
    }
}

__device__ __forceinline__ float fma_asm(float a, float b, float c) { float d; asm("v_fma_f32 %0, %1, %2, %3" : "=v"(d) : "v"(a), "v"(b), "v"(c)); return d; }
__device__ __forceinline__ float fnma_asm(float a, float b, float c) { float d; asm("v_fma_f32 %0, -%1, %2, %3" : "=v"(d) : "v"(a), "v"(b), "v"(c)); return d; }
#define S5_CMAC(dr, di, ar, ai, xr, xi) asm("v_fma_f32 %0, %2, %4, %0\n\tv_fma_f32 %1, %2, %5, %1\n\tv_fma_f32 %0, -%3, %5, %0\n\tv_fma_f32 %1, %3, %4, %1" : "+v"(dr), "+v"(di) : "v"(ar), "v"(ai), "v"(xr), "v"(xi))
template <bool FULL> __device__ __forceinline__ void s5_scan_tile(f32x16& zr, f32x16& zi, const float (&pw)[8], float& cr, float& ci, int hi) {
#pragma unroll
    for (int i = 0; i < 4; ++i)
#pragma unroll
        for (int e = 1; e < 4; ++e) S5_CMAC(zr[4 * i + e], zi[4 * i + e], pw[0], pw[1], zr[4 * i + e - 1], zi[4 * i + e - 1]);
#pragma unroll
    for (int i = 0; i < 4; ++i) {
        float er = zr[4 * i + 3], orr = er, ei = zi[4 * i + 3], oi = ei;
        asm volatile("s_nop 1\n\tv_permlane32_swap_b32 %0, %1\n\tv_permlane32_swap_b32 %2, %3" : "+v"(er), "+v"(orr), "+v"(ei), "+v"(oi));
        float ner = er, nei = ei; S5_CMAC(ner, nei, pw[6], pw[7], cr, ci);
        const float cinr = hi ? ner : cr, cini = hi ? nei : ci;
        float nor = orr, noi = oi; S5_CMAC(nor, noi, pw[6], pw[7], ner, nei);
        cr = nor; ci = noi;
        if (FULL) {
#pragma unroll
            for (int e = 0; e < 4; ++e) S5_CMAC(zr[4 * i + e], zi[4 * i + e], pw[2 * e], pw[2 * e + 1], cinr, cini);
        }
    }
}
template <bool FULL> __device__ __forceinline__ void s5_phase(Frame& F, const Args& a) {
    const int gw = F.vcu * NWAVES + F.wave, NGW = F.G * NWAVES;
    const bf16* Z = (const bf16*)(F.ws + WS_Z); bf16* ZS = (bf16*)(F.ws + WS_ZS);
    f32x2* SR = (f32x2*)(F.ws + WS_SC);
    LAS unsigned char* const hb = F.lds + F.wave * (64 * 272);
    for (int wu = gw; wu < BATCH * NGRP * 16; wu += NGW) {
        const int lane = lane_id_v(), r = lane & 31, hi = lane >> 5;
        LAS unsigned char* const hbw = hb + (4 * hi) * 272 + r * 4; LAS unsigned char* const hbr = hb + (lane & 15) * 272 + (lane >> 4) * 16;
        const int rho = wu & 15, g = (wu >> 4) & 31, b = wu >> 9;
        const f32x4 pA = ((const f32x4*)(F.ws + WS_PAR))[g * 64 + r], pB = ((const f32x4*)(F.ws + WS_PAR))[g * 64 + 32 + r];
        float pwA[8], pwB[8];
        pwA[0] = pA.x; pwA[1] = pA.y; pwA[2] = pA.x * pA.x - pA.y * pA.y; pwA[3] = 2.f * pA.x * pA.y; pwA[4] = pwA[2] * pA.x - pwA[3] * pA.y; pwA[5] = pwA[2] * pA.y + pwA[3] * pA.x;
        pwA[6] = pwA[2] * pwA[2] - pwA[3] * pwA[3]; pwA[7] = 2.f * pwA[2] * pwA[3];
        pwB[0] = pB.x; pwB[1] = pB.y; pwB[2] = pB.x * pB.x - pB.y * pB.y; pwB[3] = 2.f * pB.x * pB.y; pwB[4] = pwB[2] * pB.x - pwB[3] * pB.y; pwB[5] = pwB[2] * pB.y + pwB[3] * pB.x;
        pwB[6] = pwB[2] * pwB[2] - pwB[3] * pwB[3]; pwB[7] = 2.f * pwB[2] * pwB[3];
        bf16x8 bbf[4];
#pragma unroll
        for (int ct = 0; ct < 4; ++ct) bbf[ct] = *(const bf16x8*)((const bf16*)(F.ws + WS_PAR + 524288) + (size_t)((g * 4 + ct) * 32 + r) * 16 + 8 * hi);
        bf16x8 cm[4]; f32x4 dsk = (f32x4){0.f, 0.f, 0.f, 0.f};
        float cAr = 0.f, cAi = 0.f, cBr = 0.f, cBi = 0.f;
        if (FULL) {
#pragma unroll
            for (int ks = 0; ks < 4; ++ks) cm[ks] = *(const bf16x8*)((const bf16*)(F.ws + WS_PAR + 655360) + (size_t)(g * 16 + (lane & 15)) * 128 + 32 * ks + 8 * (lane >> 4));
            dsk = *(const f32x4*)(a.in[12] + g * 16 + 4 * (lane >> 4));
            float qAr = pA.z, qAi = pA.w, qBr = pB.z, qBi = pB.w;
#pragma unroll
            for (int i = 0; i < 3; ++i) { float t = qAr * qAr - qAi * qAi; qAi = 2.f * qAr * qAi; qAr = t; t = qBr * qBr - qBi * qBi; qBi = 2.f * qBr * qBi; qBr = t; }
            const f32x2* sr = SR + (size_t)(wu - rho) * 64 + r;
            for (int j = 0; j < rho; ++j) { const f32x2 sA = sr[(size_t)j * 64], sB = sr[(size_t)j * 64 + 32];
                float nr = sA.x, ni = sA.y; S5_CMAC(nr, ni, qAr, qAi, cAr, cAi); cAr = nr; cAi = ni;
                nr = sB.x; ni = sB.y; S5_CMAC(nr, ni, qBr, qBi, cBr, cBi); cBr = nr; cBi = ni; }
        }
        const size_t rrow0 = (size_t)b * SEQ + (size_t)rho * 512;
        const bf16* up = Z + (rrow0 + r) * EVEN_IN + g * 16 + 8 * hi;
        bf16x8 uf_next = *(const bf16x8*)up;
        for (int c8 = 0; c8 < 8; ++c8) {
            const size_t row0 = rrow0 + (size_t)c8 * 64;
            u32x2 uw[4];
            if (FULL) {
#pragma unroll
                for (int tk = 0; tk < 4; ++tk) uw[tk] = *(const u32x2*)(Z + (row0 + 16 * tk + (lane & 15)) * EVEN_IN + g * 16 + 4 * (lane >> 4));
            }
#pragma unroll
            for (int tt = 0; tt < 2; ++tt) {
                const bf16x8 uf = uf_next;
                { const int tn = c8 * 2 + tt + 1; uf_next = *(const bf16x8*)(up + (size_t)(tn < 16 ? tn : 15) * 32 * EVEN_IN); }
                f32x16 acc[4];
#pragma unroll
                for (int ct = 0; ct < 4; ++ct) {
#pragma unroll
                    for (int e = 0; e < 16; ++e) acc[ct][e] = 0.f;
                    acc[ct] = __builtin_amdgcn_mfma_f32_32x32x16_bf16(uf, bbf[ct], acc[ct], 0, 0, 0);
                }
                asm volatile("s_nop 15\n\ts_nop 7" : "+v"(acc[0]), "+v"(acc[1]), "+v"(acc[2]), "+v"(acc[3]));
                s5_scan_tile<FULL>(acc[0], acc[1], pwA, cAr, cAi, hi);
                s5_scan_tile<FULL>(acc[2], acc[3], pwB, cBr, cBi, hi);
                if (FULL) {
#pragma unroll
                    for (int e = 0; e < 16; ++e) { LAS unsigned char* rowp = hbw + (32 * tt + (e & 3) + 8 * (e >> 2)) * 272;
                        *(LAS unsigned*)(rowp) = pk2(acc[0][e], acc[1][e]);
                        *(LAS unsigned*)(rowp + 128) = pk2(acc[2][e], acc[3][e]); }
                }
                __builtin_amdgcn_sched_barrier(0);
            }
            if (FULL) {
                const int tl = lane & 15, kq = lane >> 4;
#pragma unroll
                for (int tk = 0; tk < 4; ++tk) {
                    f32x4 y = (f32x4){0.f, 0.f, 0.f, 0.f};
                    const int tok = 16 * tk + tl;
#pragma unroll
                    for (int ks = 0; ks < 4; ++ks) { const bf16x8 hf = *(const LAS bf16x8*)(hbr + tk * (16 * 272) + ks * 64);
                        y = __builtin_amdgcn_mfma_f32_16x16x32_bf16(cm[ks], hf, y, 0, 0, 0); }
                    const float y0 = y[0] + dsk[0] * bflo(uw[tk].x), y1 = y[1] + dsk[1] * bfhi(uw[tk].x), y2 = y[2] + dsk[2] * bflo(uw[tk].y), y3 = y[3] + dsk[3] * bfhi(uw[tk].y);
                    u32x2 o; o.x = pk2(gelu_tanh(y0), gelu_tanh(y1)); o.y = pk2(gelu_tanh(y2), gelu_tanh(y3));
                    *(u32x2*)(ZS + (row0 + tok) * S5W + g * 16 + 4 * kq) = o;
                }
            }
        }
        if (!FULL) SR[(size_t)wu * 64 + r + 32 * hi] = hi ? (f32x2){cBr, cBi} : (f32x2){cAr, cAi};
    }
}

template <int S> __device__ __forceinline__ void conv_tap_v(f32x2 (&out2)[32], const f32x2 (&wA)[16], const f32x2 (&wB)[16], float v) {
    if (S < 64) {
        const f32x2 vv = {v, v};
        constexpr int i0 = (S >= 0 ? S : S - 1) / 2;
#pragma unroll
        for (int m = 0; m < 16; ++m) { const int i = i0 + m; if (i >= 0 && i < 32) out2[i] = __builtin_elementwise_fma((S & 1) ? wB[m] : wA[m], vv, out2[i]); }
    }
}
struct ConvBuf { unsigned short xa[8], xg[8]; };
template <int S0, int... I> __device__ __forceinline__ void conv_load(std::integer_sequence<int, I...>, ConvBuf& B, const bf16* zrow0, int t0) {
    ((B.xa[I] = (S0 + I < 64) ? zrow0[(long)((S0 + I >= 0 || t0 + S0 + I >= 0) ? (S0 + I) : 0) * EVEN_IN + 1024] : (unsigned short)0), ...);
    ((B.xg[I] = (S0 + I < 64) ? zrow0[(long)((S0 + I >= 0 || t0 + S0 + I >= 0) ? (S0 + I) : 0) * EVEN_IN + 1536] : (unsigned short)0), ...);
}
template <int S0, int... I> __device__ __forceinline__ void conv_taps8(std::integer_sequence<int, I...>, f32x2 (&out)[32], const f32x2 (&wA)[16], const f32x2 (&wB)[16], const ConvBuf& B, int t0) {
    (conv_tap_v<S0 + I>(out, wA, wB, (S0 + I >= 0 || t0 + S0 + I >= 0) ? bf2f(B.xa[I]) * bf2f(B.xg[I]) : 0.f), ...);
}
__device__ __forceinline__ void conv_phase(Frame& F, const Args& a) {
    const int lane = lane_id_v(), wave = F.wave, c = wave * 64 + lane;
    const bf16* Z = (const bf16*)(F.ws + WS_Z); bf16* Y = (bf16*)(F.ws + WS_Y);
    LAS f32x2* red = (LAS f32x2*)F.lds;
    LAS f32x2* stats = (LAS f32x2*)(F.lds + 4096);
    LAS unsigned char* const gbuf = F.lds + 8192; const unsigned gbuf0 = (unsigned)(uintptr_t)F.lds + 8192;
    const float cb = a.in[16][c], lng = a.in[17][c], lnb = a.in[18][c];
    for (int tile = F.vcu; tile < BATCH * NCHUNK; tile += F.G) {
        const int b = tile >> 7, t0 = (tile & 127) * 64; const size_t row0 = (size_t)b * SEQ + t0;
        __syncthreads();
        { const int lane_d = lane_id_v();
#pragma unroll 1
        for (int k = 0; k < 8; ++k) { const int t = wave * 8 + k;
            glds16_asm(Z + (row0 + t) * EVEN_IN + 2048 + lane_d * 8, (unsigned)__builtin_amdgcn_readfirstlane((int)(gbuf0 + t * 1024))); } }
        f32x2 out2[32];
#pragma unroll
        for (int t = 0; t < 32; ++t) out2[t] = (f32x2){cb, cb};
        const __attribute__((address_space(1))) float* wp0 = (const __attribute__((address_space(1))) float*)a.in[15]; asm volatile("" : "+s"(wp0)); const __attribute__((address_space(1))) float* wp = wp0 + (wave * 64 + lane_id_v());
    f32x2 wA[16], wB[16];
#pragma unroll
    for (int m = 0; m < 16; ++m) {
        const float e0 = wp[(30 - 2 * m) * 512], e1 = (2 * m + 1 <= 30) ? wp[(29 - 2 * m) * 512] : 0.f, em = (m >= 1) ? wp[(31 - 2 * m) * 512] : 0.f;
        wA[m] = (f32x2){e0, e1}; wB[m] = (f32x2){em, e0}; }

        { const bf16* zr0 = Z + row0 * EVEN_IN + (wave * 64 + lane_id_v()); const auto sq = std::make_integer_sequence<int, 8>{};
          ConvBuf A, B;
          conv_load<-30>(sq, A, zr0, t0); __builtin_amdgcn_sched_barrier(0); conv_load<-22>(sq, B, zr0, t0); __builtin_amdgcn_sched_barrier(0);
          conv_taps8<-30>(sq, out2, wA, wB, A, t0); conv_load<-14>(sq, A, zr0, t0); __builtin_amdgcn_sched_barrier(0);
          conv_taps8<-22>(sq, out2, wA, wB, B, t0); conv_load<-6>(sq, B, zr0, t0); __builtin_amdgcn_sched_barrier(0);
          conv_taps8<-14>(sq, out2, wA, wB, A, t0); conv_load<2>(sq, A, zr0, t0); __builtin_amdgcn_sched_barrier(0);
          conv_taps8<-6>(sq, out2, wA, wB, B, t0);  conv_load<10>(sq, B, zr0, t0); __builtin_amdgcn_sched_barrier(0);
          conv_taps8<2>(sq, out2, wA, wB, A, t0);   conv_load<18>(sq, A, zr0, t0); __builtin_amdgcn_sched_barrier(0);
          conv_taps8<10>(sq, out2, wA, wB, B, t0);  conv_load<26>(sq, B, zr0, t0); __builtin_amdgcn_sched_barrier(0);
          conv_taps8<18>(sq, out2, wA, wB, A, t0);  conv_load<34>(sq, A, zr0, t0); __builtin_amdgcn_sched_barrier(0);
          conv_taps8<26>(sq, out2, wA, wB, B, t0);  conv_load<42>(sq, B, zr0, t0); __builtin_amdgcn_sched_barrier(0);
          conv_taps8<34>(sq, out2, wA, wB, A, t0);  conv_load<50>(sq, A, zr0, t0); __builtin_amdgcn_sched_barrier(0);
          conv_taps8<42>(sq, out2, wA, wB, B, t0);  conv_load<58>(sq, B, zr0, t0); __builtin_amdgcn_sched_barrier(0);
          conv_taps8<50>(sq, out2, wA, wB, A, t0);
          conv_taps8<58>(sq, out2, wA, wB, B, t0); }
        float out[64];
#pragma unroll
        for (int t = 0; t < 32; ++t) { out[2 * t] = out2[t].x; out[2 * t + 1] = out2[t].y; }
        float r1[32];
#pragma unroll
        for (int i = 0; i < 32; ++i) { float x = out[i], y = out[i + 32];
            asm volatile("s_nop 1\n\tv_permlane32_swap_b32 %0, %1" : "+v"(x), "+v"(y)); r1[i] = x + y; }
#pragma unroll
        for (int half = 16; half >= 1; half >>= 1) { const bool up_ = (lane & half) != 0;
#pragma unroll
            for (int i = 0; i < half; ++i) { const float keep = up_ ? r1[i + half] : r1[i], send = up_ ? r1[i] : r1[i + half]; r1[i] = keep + __shfl_xor(send, half); } }
        const float s1 = r1[0];
#pragma unroll
        for (int i = 0; i < 32; ++i) { float x = out[i] * out[i], y = out[i + 32] * out[i + 32];
            asm volatile("s_nop 1\n\tv_permlane32_swap_b32 %0, %1" : "+v"(x), "+v"(y)); r1[i] = x + y; }
#pragma unroll
        for (int half = 16; half >= 1; half >>= 1) { const bool up_ = (lane & half) != 0;
#pragma unroll
            for (int i = 0; i < half; ++i) { const float keep = up_ ? r1[i + half] : r1[i], send = up_ ? r1[i] : r1[i + half]; r1[i] = keep + __shfl_xor(send, half); } }
        const float s2 = r1[0];
        __syncthreads();
        red[wave * 64 + lane] = (f32x2){s1, s2};
        __syncthreads();
        if (wave == 0) { float q1 = 0.f, q2 = 0.f;
#pragma unroll
            for (int i = 0; i < 8; ++i) { const f32x2 p = red[i * 64 + lane]; q1 += p.x; q2 += p.y; }
            const float mu = q1 * (1.f / 512.f); const float var = fmaxf(q2 * (1.f / 512.f) - mu * mu, 0.f);
            stats[lane] = (f32x2){mu, 1.0f / sqrtf(var + EPS)}; }
        asm volatile("s_waitcnt vmcnt(0)" ::: "memory");
        __syncthreads();
        {
            const int c_o = wave * 64 + lane_id_v();
            LAS unsigned short* gcol = (LAS unsigned short*)gbuf + c_o;
#pragma unroll
            for (int t = 0; t < 64; ++t) { const f32x2 st = stats[t]; const float cn = (out[t] - st.x) * st.y * lng + lnb;
                gcol[t * 512] = (unsigned short)f2bf(fast_silu(cn) * bf2f(gcol[t * 512])); }
        }
        __syncthreads();
        {
            const int tid = wave * 64 + lane_id_v();
#pragma unroll 2
            for (int k = 0; k < 8; ++k) { const int item = tid + 512 * k, t = item >> 6, ch = item & 63;
                *(u32x4*)(Y + (row0 + t) * DM + 512 + 8 * ch) = *(const LAS u32x4*)(gbuf + ((size_t)t * 512 + 8 * ch) * 2); }
        }
    }
}

__device__ __forceinline__ s16x4 tr_read(const LAS unsigned char* p) { return __builtin_bit_cast(s16x4, __builtin_amdgcn_ds_read_tr16_b64_v4i16((LAS s16x4*)p)); }
__device__ __forceinline__ void chunk_attn_mfma(Frame& F, const Args& a) {
    const int w = F.wave;
    const int hh = w >> 2, cc = (w >> 1) & 1, half = w & 1;
    LAS unsigned char* const lds = F.lds; const unsigned lds0 = (unsigned)(uintptr_t)F.lds; LAS float* const btab = (LAS float*)(lds + 131072);
    const bf16* ZQ = (const bf16*)(F.ws + WS_Z); const bf16* ZK = ZQ + (size_t)MTOK * 1024; const bf16* ZV = ZK + (size_t)MTOK * 1024; const bf16* ZG = ZV + (size_t)MTOK * 1024;
    bf16* Y = (bf16*)(F.ws + WS_Y);
#define CA_DMA_TILE_X(tb_, sb_, trel) do { const int T_ = (tb_) + (trel); if (T_ >= 0) { _Pragma("unroll") for (int i_ = 0; i_ < 4; ++i_) { const int piece_ = 4 * w + i_, sub_ = piece_ >> 3; \
        const bf16* src_ = ((sub_ < 2) ? ZK : ZV) + (size_t)((b * 16 + 2 * hp + (sub_ & 1)) * 128 + T_) * 4096 + (piece_ & 7) * 512 + lane * 8; \
        glds16_asm(src_, (unsigned)__builtin_amdgcn_readfirstlane((int)(lds0 + (((trel) + (sb_)) & 3) * 32768 + piece_ * 1024))); } } } while (0)
#define CA_DMA_TILE(trel) CA_DMA_TILE_X(tbase, sbase, trel)
#define CA_WAITBAR(n) asm volatile("s_waitcnt vmcnt(" #n ") lgkmcnt(0)\n\ts_barrier" ::: "memory")
    for (int uw_ = F.vcu; uw_ < BATCH * 8 * 8; uw_ += F.G) {
      const int hp = (uw_ >> 3) & 7, b = uw_ >> 6, cp0 = (uw_ & 7) * 8;
      const int h = 2 * hp + hh;
      int lane = lane_id_v(), r = lane & 31, hi = lane >> 5;
      __syncthreads();
      for (int i = w * 64 + lane; i < 2 * 320; i += NWAVES * 64) { const int hs = i / 320, ix = i - hs * 320; btab[i] = a.in[22][(2 * hp + hs) * 257 + (ix > 256 ? 256 : ix)] * LOG2E; }
      bf16x8 qn0, qn1, qn2, qn3;
      { const size_t qrow_ = (size_t)b * SEQ + (2 * cp0 + cc) * 64 + half * 32 + r; const bf16* qp_ = ZQ + qrow_ * 1024 + h * 64 + 8 * hi;
        qn0 = *(const bf16x8*)qp_; qn1 = *(const bf16x8*)(qp_ + 16); qn2 = *(const bf16x8*)(qp_ + 32); qn3 = *(const bf16x8*)(qp_ + 48); }
      { const int tb0 = 2 * cp0 - 8; CA_DMA_TILE_X(tb0, 0, 0); CA_DMA_TILE_X(tb0, 0, 1); }
      for (int ui = 0; ui < 8; ++ui) {
        const int cp = cp0 + ui, sbase = 2 * ui;
        const int c = 2 * cp + cc, tbase = 2 * cp - 8;
        lane = lane_id_v(); r = lane & 31; hi = lane >> 5;
        const int q4 = (lane & 15) >> 2, p4 = lane & 3, dsel = (lane >> 4) & 1, sw = (q4 >> 1) & 1;
        const int vlane = (4 * hi + q4) * 128 + (2 * dsel + (p4 >> 1)) * 16 + (p4 & 1) * 8;
        const size_t qrow = (size_t)b * SEQ + c * 64 + half * 32 + r;
        CA_WAITBAR(0);
        bf16x8 qf0 = qn0, qf1 = qn1, qf2 = qn2, qf3 = qn3;
        asm volatile("" : "+v"(qf0), "+v"(qf1), "+v"(qf2), "+v"(qf3));
        const float cfar = btab[hh * 320 + 256];
        float m = 0.f, l = 0.f; bool first = true;
        f32x16 o0, o1, negm;
#pragma unroll
        for (int e = 0; e < 16; ++e) { o0[e] = 0.f; o1[e] = 0.f; negm[e] = cfar; }
#pragma unroll
        for (int s = 0; s < 9; ++s) {
            bool issue;
            if (s == 0) { CA_DMA_TILE(2); CA_DMA_TILE(3); issue = (tbase + 3 >= 0); }
            else if (s <= 6) { CA_DMA_TILE(s + 3); issue = (tbase + s + 3 >= 0); }
            else { issue = false;
                if (ui < 7) { const int tbn = tbase + 2;
                    if (s == 7) { const size_t qrow_ = qrow + 128; const bf16* qp_ = ZQ + qrow_ * 1024 + h * 64 + 8 * hi;
                        qn0 = *(const bf16x8*)qp_; qn1 = *(const bf16x8*)(qp_ + 16); qn2 = *(const bf16x8*)(qp_ + 32); qn3 = *(const bf16x8*)(qp_ + 48); }
                    CA_DMA_TILE_X(tbn, sbase + 2, s - 7); issue = (tbn + s - 7 >= 0); } }
            const int T = tbase + s + cc;
            if (T >= 0) {
                const int bsel = (s + cc + sbase) & 3;
                const LAS unsigned char* kb = lds + bsel * 32768 + hh * 8192 + (hi * 64 + r) * 16;
                const LAS unsigned char* vb = lds + bsel * 32768 + 16384 + hh * 8192 + vlane;
                f32x16 p0, p1;
                bf16x8 kf[8];
#pragma unroll
                for (int s4 = 0; s4 < 4; ++s4) { kf[2 * s4] = *(const LAS bf16x8*)(kb + (2 * s4) * 1024); kf[2 * s4 + 1] = *(const LAS bf16x8*)(kb + (2 * s4) * 1024 + 512); }
                s16x4 va[2][2][2], vc[2][2][2];
#pragma unroll
                for (int kh = 0; kh < 2; ++kh)
#pragma unroll
                    for (int s2 = 0; s2 < 2; ++s2) { const LAS unsigned char* vk = vb + (32 * kh + 16 * s2) * 128;
                        va[kh][s2][0] = tr_read(vk + sw * 64); va[kh][s2][1] = tr_read(vk + 8 * 128 + sw * 64);
                        vc[kh][s2][0] = tr_read(vk + (1 - sw) * 64); vc[kh][s2][1] = tr_read(vk + 8 * 128 + (1 - sw) * 64); }
                if (s >= 6) {
                    const LAS float* bp = btab + hh * 320 + (64 * (8 - s) + half * 32 + r - 4 * hi + 128 - 27 - 32);
#pragma unroll
                    for (int e = 0; e < 16; ++e) { const int ko = (e & 3) + 8 * (e >> 2); p0[e] = bp[27 + 32 - ko] - m; p1[e] = bp[27 - ko] - m; }
                } else { p0 = negm; p1 = negm; }
                __builtin_amdgcn_sched_barrier(0);
#pragma unroll
                for (int s4 = 0; s4 < 4; ++s4) {
                    const bf16x8 qf = s4 == 0 ? qf0 : (s4 == 1 ? qf1 : (s4 == 2 ? qf2 : qf3));
                    p0 = __builtin_amdgcn_mfma_f32_32x32x16_bf16(kf[2 * s4], qf, p0, 0, 0, 0);
                    p1 = __builtin_amdgcn_mfma_f32_32x32x16_bf16(kf[2 * s4 + 1], qf, p1, 0, 0, 0);
                }
                if (CA_PROBE == 2) {
                    u32x4 zz = (u32x4){0u, 0u, 0u, 0u}; asm volatile("" : "+v"(zz));
#pragma unroll
                    for (int s4 = 0; s4 < 4; ++s4) { const bf16x8 k0 = *(const LAS bf16x8*)(kb + (2 * s4) * 1024), k1 = *(const LAS bf16x8*)(kb + (2 * s4) * 1024 + 512);
                        p0 = __builtin_amdgcn_mfma_f32_32x32x16_bf16(k0, __builtin_bit_cast(bf16x8, zz), p0, 0, 0, 0); p1 = __builtin_amdgcn_mfma_f32_32x32x16_bf16(k1, __builtin_bit_cast(bf16x8, zz), p1, 0, 0, 0); }
                }
                asm volatile("s_nop 15\n\ts_nop 7" : "+v"(p0), "+v"(p1));
                float rm = max3_asm(p0[0], p0[1], p0[2]), rm2 = max3_asm(p0[3], p0[4], p0[5]), rm3 = max3_asm(p1[0], p1[1], p1[2]), rm4 = max3_asm(p1[3], p1[4], p1[5]);
#pragma unroll
                for (int e = 6; e < 16; e += 2) { rm = max3_asm(rm, p0[e], p0[e + 1]); rm3 = max3_asm(rm3, p1[e], p1[e + 1]); { const float t_ = rm; rm = rm2; rm2 = t_; } { const float t_ = rm3; rm3 = rm4; rm4 = t_; } }
                rm = max3_asm(rm, rm2, rm3); rm = max2_asm(rm, rm4);
                { const auto rr = __builtin_amdgcn_permlane32_swap(__float_as_uint(rm), __float_as_uint(rm), false, false); rm = max2_asm(__uint_as_float(rr[0]), __uint_as_float(rr[1])); }
                if (first) {
                    m = rm;
#pragma unroll
                    for (int e = 0; e < 16; ++e) { p0[e] -= rm; p1[e] -= rm; negm[e] = cfar - m; }
                    first = false;
                } else if (__any(rm > 6.f)) {
                    const float dl = fmaxf(rm, 0.f), al = __builtin_amdgcn_exp2f(-dl);
                    m += dl; l *= al;
#pragma unroll
                    for (int e = 0; e < 16; ++e) { p0[e] -= dl; p1[e] -= dl; o0[e] *= al; o1[e] *= al; negm[e] = cfar - m; }
                }
                float ps0 = 0.f, ps1 = 0.f, ps2 = 0.f, ps3 = 0.f;
#pragma unroll
                for (int e = 0; e < 16; e += 2) { p0[e] = __builtin_amdgcn_exp2f(p0[e]); p1[e] = __builtin_amdgcn_exp2f(p1[e]); p0[e + 1] = __builtin_amdgcn_exp2f(p0[e + 1]); p1[e + 1] = __builtin_amdgcn_exp2f(p1[e + 1]);
                    ps0 += p0[e]; ps1 += p1[e]; ps2 += p0[e + 1]; ps3 += p1[e + 1]; }
                l += (ps0 + ps1) + (ps2 + ps3);
                if (CA_PROBE == 3) { float dz = 0.f; asm volatile("" : "+v"(dz)); float acc_ = 0.f;
#pragma unroll
                    for (int e = 0; e < 16; ++e) { acc_ += __builtin_amdgcn_exp2f(p0[e] * dz) + __builtin_amdgcn_exp2f(p1[e] * dz); }
                    l += (acc_ - 32.f) * dz; }
                u32x4 pf[2][2];
#pragma unroll
                for (int s2 = 0; s2 < 2; ++s2) {
                    u32x4 t; t.x = pk2(p0[8 * s2 + 0], p0[8 * s2 + 1]); t.y = pk2(p0[8 * s2 + 2], p0[8 * s2 + 3]); t.z = pk2(p0[8 * s2 + 4], p0[8 * s2 + 5]); t.w = pk2(p0[8 * s2 + 6], p0[8 * s2 + 7]); pf[0][s2] = t;
                    u32x4 v; v.x = pk2(p1[8 * s2 + 0], p1[8 * s2 + 1]); v.y = pk2(p1[8 * s2 + 2], p1[8 * s2 + 3]); v.z = pk2(p1[8 * s2 + 4], p1[8 * s2 + 5]); v.w = pk2(p1[8 * s2 + 6], p1[8 * s2 + 7]); pf[1][s2] = v;
                }
#pragma unroll
                for (int kh = 0; kh < 2; ++kh)
#pragma unroll
                    for (int s2 = 0; s2 < 2; ++s2) {
                        const s16x4 a0 = va[kh][s2][0], a1 = va[kh][s2][1], c0 = vc[kh][s2][0], c1 = vc[kh][s2][1];
                        const bf16x8 vf0 = (bf16x8){a0[0], a0[1], a0[2], a0[3], a1[0], a1[1], a1[2], a1[3]};
                        const bf16x8 vf1 = (bf16x8){c0[0], c0[1], c0[2], c0[3], c1[0], c1[1], c1[2], c1[3]};
                        o0 = __builtin_amdgcn_mfma_f32_32x32x16_bf16(vf0, __builtin_bit_cast(bf16x8, pf[kh][s2]), o0, 0, 0, 0);
                        o1 = __builtin_amdgcn_mfma_f32_32x32x16_bf16(vf1, __builtin_bit_cast(bf16x8, pf[kh][s2]), o1, 0, 0, 0);
                    }
                if (CA_PROBE == 1) {
                    u32x4 zz = (u32x4){0u, 0u, 0u, 0u}; asm volatile("" : "+v"(zz));
#pragma unroll
                    for (int kh = 0; kh < 2; ++kh)
#pragma unroll
                        for (int s2 = 0; s2 < 2; ++s2) { const LAS unsigned char* vk = vb + (32 * kh + 16 * s2) * 128;
                            const s16x4 a0 = tr_read(vk + sw * 64), a1 = tr_read(vk + 8 * 128 + sw * 64), c0 = tr_read(vk + (1 - sw) * 64), c1 = tr_read(vk + 8 * 128 + (1 - sw) * 64);
                            const bf16x8 vf0 = (bf16x8){a0[0], a0[1], a0[2], a0[3], a1[0], a1[1], a1[2], a1[3]}; const bf16x8 vf1 = (bf16x8){c0[0], c0[1], c0[2], c0[3], c1[0], c1[1], c1[2], c1[3]};
                            o0 = __builtin_amdgcn_mfma_f32_32x32x16_bf16(vf0, __builtin_bit_cast(bf16x8, zz), o0, 0, 0, 0);
                            o1 = __builtin_amdgcn_mfma_f32_32x32x16_bf16(vf1, __builtin_bit_cast(bf16x8, zz), o1, 0, 0, 0); }
                }
            }
            __builtin_amdgcn_sched_barrier(0);
            if (s < 8) { if (issue) CA_WAITBAR(4); else CA_WAITBAR(0); }
        }
        { const auto rr = __builtin_amdgcn_permlane32_swap(__float_as_uint(l), __float_as_uint(l), false, false); l = __uint_as_float(rr[0]) + __uint_as_float(rr[1]); }
        const float rl = 1.0f / l;
        const bf16* gp = ZG + qrow * 1024 + h * 64 + 8 * hi; bf16* yp = Y + qrow * DM + h * 64 + 8 * hi;
        u32x4 gq4[4];
#pragma unroll
        for (int q = 0; q < 4; ++q) gq4[q] = *(const u32x4*)(gp + 16 * q);
#pragma unroll
        for (int q = 0; q < 4; ++q) {
            const int dt = q >> 1, i0 = 2 * (q & 1);
            u32x4 G = gq4[q];
            { const auto r1 = __builtin_amdgcn_permlane32_swap(G.x, G.z, false, false); const auto r2 = __builtin_amdgcn_permlane32_swap(G.y, G.w, false, false); G.x = r1[0]; G.z = r1[1]; G.y = r2[0]; G.w = r2[1]; }
            float gf[8] = {bflo(G.x), bfhi(G.x), bflo(G.y), bfhi(G.y), bflo(G.z), bfhi(G.z), bflo(G.w), bfhi(G.w)};
#if G_SILU_IN_ATTN
#pragma unroll
            for (int e = 0; e < 8; ++e) gf[e] = fast_silu(gf[e]);
#endif
#pragma unroll
            for (int e = 0; e < 8; ++e) gf[e] *= rl;
            u32x2 ya, yb;
            if (dt == 0) {
                ya.x = pk2(o0[4 * i0] * gf[0], o0[4 * i0 + 1] * gf[1]); ya.y = pk2(o0[4 * i0 + 2] * gf[2], o0[4 * i0 + 3] * gf[3]);
                yb.x = pk2(o0[4 * i0 + 4] * gf[4], o0[4 * i0 + 5] * gf[5]); yb.y = pk2(o0[4 * i0 + 6] * gf[6], o0[4 * i0 + 7] * gf[7]);
            } else {
                ya.x = pk2(o1[4 * i0] * gf[0], o1[4 * i0 + 1] * gf[1]); ya.y = pk2(o1[4 * i0 + 2] * gf[2], o1[4 * i0 + 3] * gf[3]);
                yb.x = pk2(o1[4 * i0 + 4] * gf[4], o1[4 * i0 + 5] * gf[5]); yb.y = pk2(o1[4 * i0 + 6] * gf[6], o1[4 * i0 + 7] * gf[7]);
            }
            { const auto r1 = __builtin_amdgcn_permlane32_swap(ya.x, yb.x, false, false); const auto r2 = __builtin_amdgcn_permlane32_swap(ya.y, yb.y, false, false);
              *(u32x4*)(yp + 16 * q) = (u32x4){r1[0], r2[0], r1[1], r2[1]}; }
        }
      }
    }
#undef CA_DMA_TILE_X
#undef CA_DMA_TILE
#undef CA_WAITBAR
}

__device__ __forceinline__ void xattn_mfma(Frame& F, int layer, const bool pairmap) {
    const int w = F.wave;
    const bf16* QG = (const bf16*)(F.ws + WS_Z); bf16* Y = (bf16*)(F.ws + WS_Y);
    LAS unsigned char* const lds = F.lds; const unsigned lds0 = (unsigned)(uintptr_t)F.lds;
    LAS unsigned char* const qbuf = lds + 98304 + w * 4096; const unsigned qbuf0 = lds0 + 98304 + w * 4096;
    const int nu = pairmap ? 2 : (BATCH * 4 * (SEQ / 256) - F.vcu + F.G - 1) / F.G;
    const int nsteps = nu * 8;
#define XA_UNIT(g_) (pairmap ? (((((g_) >> 3) * 64 + (F.vcu >> 5) * 8 + ((F.vcu & 31) >> 2)) >> 5) << 7 | (F.vcu & 3) << 5 | ((((g_) >> 3) * 64 + (F.vcu >> 5) * 8 + ((F.vcu & 31) >> 2)) & 31)) : (F.vcu + ((g_) >> 3) * F.G))
#define XA_DMA_KV(g_) do { const int u_ = XA_UNIT(g_), j_ = (g_) & 7, hx_ = (u_ >> 5) & 3, b_ = u_ >> 7; const unsigned slot_ = lds0 + ((g_) % 3) * 32768; \
        if (j_ < 4) { const bf16* kb_ = (const bf16*)(F.ws + WS_KP) + (size_t)((layer * 4 + b_) * 4 + hx_) * (32 * 256 * 8) + (size_t)j_ * 16384 + lane * 8; \
            _Pragma("unroll") for (int i_ = 0; i_ < 4; ++i_) { const int piece_ = w * 4 + i_; glds16_asm(kb_ + piece_ * 512, (unsigned)__builtin_amdgcn_readfirstlane((int)(slot_ + piece_ * 1024))); } } \
        else { const bf16* vb_ = (const bf16*)(F.ws + WS_VP) + (size_t)((layer * 4 + b_) * 4 + hx_) * (64 * 256 * 4) + (size_t)(64 * (j_ - 4)) * 4; \
            _Pragma("unroll") for (int i_ = 0; i_ < 4; ++i_) { const int piece_ = w * 4 + i_, p_ = piece_ * 64 + lane, kg_ = p_ >> 5, dp_ = p_ & 31; \
                glds16_asm(vb_ + ((size_t)kg_ * 256 + 2 * dp_) * 4, (unsigned)__builtin_amdgcn_readfirstlane((int)(slot_ + piece_ * 1024))); } } } while (0)
#define XA_DMA_QG(g_) do { const int u_ = XA_UNIT(g_), j_ = (g_) & 7, qb_ = u_ & 31, hx_ = (u_ >> 5) & 3, b_ = u_ >> 7; \
        const bf16* src_ = QG + ((size_t)b_ * SEQ + qb_ * 256 + w * 32 + (lane & 31)) * 2048 + hx_ * 256 + (j_ < 4 ? 64 * j_ : 1024 + 64 * (j_ - 4)) + (lane >> 5) * 8; \
        _Pragma("unroll") for (int i_ = 0; i_ < 4; ++i_) glds16_asm(src_ + 16 * i_, (unsigned)__builtin_amdgcn_readfirstlane((int)(qbuf0 + i_ * 1024))); } while (0)
#define XA_WAITBAR(n) asm volatile("s_waitcnt vmcnt(" #n ") lgkmcnt(0)\n\ts_barrier" ::: "memory")
    if (nsteps > 0) {
        int lane = lane_id_v();
        __syncthreads();
        XA_DMA_QG(0); XA_DMA_KV(0); XA_DMA_KV(1);
        XA_WAITBAR(0);
        u32x4 ydef[4]; bool have_y = false; size_t ydef_row = 0; int ydef_col = 0;
#define XA_FLUSH_Y() do { if (have_y) { bf16* yp_ = Y + ydef_row * DM + ydef_col; \
            _Pragma("unroll") for (int q_ = 0; q_ < 4; ++q_) *(u32x4*)(yp_ + 16 * q_) = ydef[q_]; have_y = false; } } while (0)
        for (int ui = 0; ui < nu; ++ui) {
            lane = lane_id_v();
            const int r = lane & 31, hi = lane >> 5;
            const int u = XA_UNIT(ui * 8), qb = u & 31, hx = (u >> 5) & 3, b = u >> 7;
            const size_t qrow = (size_t)b * SEQ + qb * 256 + w * 32 + r;
            u32x4 pf[8][2]; float rl;
            {
                f32x16 sacc[8];
#pragma unroll
                for (int kt = 0; kt < 8; ++kt)
#pragma unroll
                    for (int e = 0; e < 16; ++e) sacc[kt][e] = 0.f;
#pragma unroll 1
                for (int j = 0; j < 4; ++j) {
                    const int g = ui * 8 + j;
                    XA_FLUSH_Y();
                    bf16x8 qf[4];
#pragma unroll
                    for (int s4 = 0; s4 < 4; ++s4) qf[s4] = *(const LAS bf16x8*)(qbuf + ((2 * s4 + hi) * 32 + r) * 16);
                    asm volatile("s_waitcnt lgkmcnt(0)" ::: "memory");
                    if (g + 1 < nsteps) XA_DMA_QG(g + 1);
                    if (g + 2 < nsteps) XA_DMA_KV(g + 2);
                    const LAS unsigned char* kb = lds + (g % 3) * 32768 + (hi * 256 + r) * 16;
                    bf16x8 kfa[4], kfb[4];
#pragma unroll
                    for (int s4 = 0; s4 < 4; ++s4) kfa[s4] = *(const LAS bf16x8*)(kb + (2 * s4 * 256) * 16);
#pragma unroll
                    for (int kt = 0; kt < 8; kt += 2) {
#pragma unroll
                        for (int s4 = 0; s4 < 4; ++s4) kfb[s4] = *(const LAS bf16x8*)(kb + (2 * s4 * 256 + 32 * (kt + 1)) * 16);
                        __builtin_amdgcn_sched_barrier(0);
#pragma unroll
                        for (int s4 = 0; s4 < 4; ++s4) sacc[kt] = __builtin_amdgcn_mfma_f32_32x32x16_bf16(kfa[s4], qf[s4], sacc[kt], 0, 0, 0);
                        __builtin_amdgcn_sched_barrier(0);
                        if (kt + 2 < 8) {
#pragma unroll
                            for (int s4 = 0; s4 < 4; ++s4) kfa[s4] = *(const LAS bf16x8*)(kb + (2 * s4 * 256 + 32 * (kt + 2)) * 16);
                        }
                        __builtin_amdgcn_sched_barrier(0);
#pragma unroll
                        for (int s4 = 0; s4 < 4; ++s4) sacc[kt + 1] = __builtin_amdgcn_mfma_f32_32x32x16_bf16(kfb[s4], qf[s4], sacc[kt + 1], 0, 0, 0);
                        __builtin_amdgcn_sched_barrier(0);
                    }
                    if (j < 3) { if (g + 2 < nsteps) XA_WAITBAR(4); else XA_WAITBAR(0); }
                }
                float m = sacc[0][0];
#pragma unroll
                for (int kt = 0; kt < 8; ++kt)
#pragma unroll
                    for (int e = 0; e < 16; ++e) m = fmaxf(m, sacc[kt][e]);
                m = fmaxf(m, __shfl_xor(m, 32));
                float l = 0.f;
#pragma unroll
                for (int kt = 0; kt < 8; ++kt) {
#pragma unroll
                    for (int e = 0; e < 16; ++e) { const float pp = __builtin_amdgcn_exp2f(sacc[kt][e] - m); sacc[kt][e] = pp; l += pp; }
#pragma unroll
                    for (int s2 = 0; s2 < 2; ++s2) { u32x4 t; t.x = pk2(sacc[kt][8 * s2 + 0], sacc[kt][8 * s2 + 1]); t.y = pk2(sacc[kt][8 * s2 + 2], sacc[kt][8 * s2 + 3]);
                        t.z = pk2(sacc[kt][8 * s2 + 4], sacc[kt][8 * s2 + 5]); t.w = pk2(sacc[kt][8 * s2 + 6], sacc[kt][8 * s2 + 7]); pf[kt][s2] = t; }
                }
                l += __shfl_xor(l, 32);
                rl = 1.0f / l;
                __builtin_amdgcn_sched_barrier(0);
                { const int g = ui * 8 + 3; if (g + 2 < nsteps) XA_WAITBAR(4); else XA_WAITBAR(0); }
            }
#pragma unroll 1
            for (int j = 4; j < 8; ++j) {
                const int g = ui * 8 + j;
                XA_FLUSH_Y();
                u32x2 gq[8];
#pragma unroll
                for (int t = 0; t < 2; ++t)
#pragma unroll
                    for (int i = 0; i < 4; ++i) gq[4 * t + i] = *(const LAS u32x2*)(qbuf + ((4 * t + i) * 32 + r) * 16 + 8 * hi);
                asm volatile("s_waitcnt lgkmcnt(0)" ::: "memory");
                if (g + 1 < nsteps) XA_DMA_QG(g + 1);
                if (g + 2 < nsteps) XA_DMA_KV(g + 2);
                const LAS unsigned char* vb = lds + (g % 3) * 32768 + (hi * 64 + r) * 8;
#pragma unroll
                for (int dt = 0; dt < 2; ++dt) {
                    f32x16 oacc;
#pragma unroll
                    for (int e = 0; e < 16; ++e) oacc[e] = 0.f;
                    s16x4 va[2][2][2], vn[2][2][2];
#define XA_VLD(dst, kt2) do { _Pragma("unroll") for (int q_ = 0; q_ < 2; ++q_) _Pragma("unroll") for (int s2 = 0; s2 < 2; ++s2) { const int kg = 8 * ((kt2) + q_) + 4 * s2; \
                        dst[q_][s2][0] = *(const LAS s16x4*)(vb + (kg * 64 + 32 * dt) * 8); dst[q_][s2][1] = *(const LAS s16x4*)(vb + ((kg + 2) * 64 + 32 * dt) * 8); } } while (0)
#define XA_VMM(src, kt2) do { _Pragma("unroll") for (int q_ = 0; q_ < 2; ++q_) _Pragma("unroll") for (int s2 = 0; s2 < 2; ++s2) { const s16x4 v0 = src[q_][s2][0], v1 = src[q_][s2][1]; \
                        const bf16x8 vf = (bf16x8){v0[0], v0[1], v0[2], v0[3], v1[0], v1[1], v1[2], v1[3]}; \
                        oacc = __builtin_amdgcn_mfma_f32_32x32x16_bf16(vf, __builtin_bit_cast(bf16x8, pf[(kt2) + q_][s2]), oacc, 0, 0, 0); } } while (0)
                    XA_VLD(va, 0);
                    XA_VLD(vn, 2); __builtin_amdgcn_sched_barrier(0); XA_VMM(va, 0); __builtin_amdgcn_sched_barrier(0);
                    XA_VLD(va, 4); __builtin_amdgcn_sched_barrier(0); XA_VMM(vn, 2); __builtin_amdgcn_sched_barrier(0);
                    XA_VLD(vn, 6); __builtin_amdgcn_sched_barrier(0); XA_VMM(va, 4); __builtin_amdgcn_sched_barrier(0);
                    XA_VMM(vn, 6);
#undef XA_VLD
#undef XA_VMM
                    u32x2 yo[4];
#pragma unroll
                    for (int i = 0; i < 4; ++i) { const u32x2 gw = gq[4 * dt + i];
                        yo[i].x = pk2(oacc[4 * i] * rl * bflo(gw.x), oacc[4 * i + 1] * rl * bfhi(gw.x)); yo[i].y = pk2(oacc[4 * i + 2] * rl * bflo(gw.y), oacc[4 * i + 3] * rl * bfhi(gw.y)); }
#pragma unroll
                    for (int pr = 0; pr < 2; ++pr) { const auto r1 = __builtin_amdgcn_permlane32_swap(yo[2 * pr].x, yo[2 * pr + 1].x, false, false); const auto r2 = __builtin_amdgcn_permlane32_swap(yo[2 * pr].y, yo[2 * pr + 1].y, false, false);
                        ydef[2 * dt + pr] = (u32x4){r1[0], r2[0], r1[1], r2[1]}; }
                }
                have_y = true; ydef_row = qrow; ydef_col = hx * 256 + 64 * (j - 4) + 8 * hi;
                __builtin_amdgcn_sched_barrier(0);
                if (g + 2 < nsteps) XA_WAITBAR(4); else XA_WAITBAR(0);
            }
        }
        XA_FLUSH_Y();
    }
#undef XA_FLUSH_Y
#undef XA_UNIT
#undef XA_DMA_KV
#undef XA_DMA_QG
#undef XA_WAITBAR
}

__device__ __forceinline__ void final_norm(Frame& F, const Args& a) {
    const int gw = F.vcu * NWAVES + F.wave, NGW = F.G * NWAVES, lane = lane_id_v();
    const f32x4* gr = (const f32x4*)a.in[28] + lane;
    for (int m = gw; m < MTOK; m += NGW) {
        f32x4* xr = (f32x4*)(F.out + (size_t)m * DM) + lane;
        f32x4 v[4]; float s = 0.f;
#pragma unroll
        for (int j = 0; j < 4; ++j) { v[j] = xr[64 * j]; s += (v[j].x * v[j].x + v[j].y * v[j].y) + (v[j].z * v[j].z + v[j].w * v[j].w); }
        const float rstd = 1.0f / sqrtf(wave_sum(s) * (1.f / DM) + EPS);
#pragma unroll
        for (int j = 0; j < 4; ++j) { const f32x4 g = gr[64 * j]; xr[64 * j] = (f32x4){v[j].x * rstd * g.x, v[j].y * rstd * g.y, v[j].z * rstd * g.z, v[j].w * rstd * g.w}; }
    }
}

__device__ __forceinline__ void stagger_delay() {
    if (STAGGER_US > 0 && (blockIdx.x & 1)) { const unsigned long long t0 = __builtin_amdgcn_s_memrealtime();
        while (__builtin_amdgcn_s_memrealtime() - t0 < (unsigned long long)(STAGGER_US * 100)) __builtin_amdgcn_s_sleep(32); }
}
constexpr int NPH = 15;
__global__ void __launch_bounds__(NWAVES * 64, 2) trunk_fwd(Args args) {
    extern __shared__ __attribute__((aligned(16))) unsigned char lds[];
    Frame F;
    F.lds = (LAS unsigned char*)lds;
    F.MISC = (volatile LAS unsigned*)(F.lds + MISC_OFF);
    F.wave = __builtin_amdgcn_readfirstlane(threadIdx.x >> 6);
    F.G = gridDim.x; { const int bx = blockIdx.x; F.vcu = (F.G % 8 == 0) ? (bx % 8) * (F.G / 8) + bx / 8 : bx; }
    F.ws = args.ws; F.out = args.out; F.ctl = (unsigned*)(args.ws + WS_CTL);
    for (int u = threadIdx.x; u < (RSTD_OFF - LDSCTL_OFF) / 4; u += NWAVES * 64) ((LAS unsigned*)(F.lds + LDSCTL_OFF))[u] = 0u;
    __syncthreads();
    const int lo = args.ph_lo, hi = args.ph_hi;
    const bool multi = (hi - lo) > 1;
    XcdBarrier bar; bar.bar = F.ctl + CW_BAR; bar.x = 0; bar.st = nullptr;
    if (multi) bar = xcd_barrier_post(F.ctl + CW_BAR, F.MISC + 8, F.wave);
#define IN(k) (lo <= (k) && (k) < hi)
#define DUP(k) for (int rep_ = 0; rep_ < (((DUP_MASK >> (k)) & 1u) ? 2 : 1); ++rep_)
#define SEAM(k) do { if (IN(k) && IN((k) + 1)) xcd_barrier(bar); } while (0)
    unsigned char* ws = args.ws;
    bf16* const XB = (bf16*)(ws + WS_XB); bf16* const Y = (bf16*)(ws + WS_Y); bf16* const Z = (bf16*)(ws + WS_Z); bf16* const ZS = (bf16*)(ws + WS_ZS);
    float* const RS = (float*)(ws + WS_RS);
    pg8::Epi E0{}; E0.mode = 0; E0.perm = true;
    pg8::Epi E1{}; E1.mode = 1; E1.perm = true; E1.xout = args.out; E1.xb = XB; E1.xl = nullptr; E1.rsout = RS; E1.xold = nullptr;

    if (IN(0)) DUP(0) { p0_prologue(F, args); __syncthreads(); } SEAM(0);
    if (IN(1)) DUP(1) {
        { pg8::Gemm g{XB, (const bf16*)(ws + WS_W_IN0), MTOK, EVEN_IN, DM}; pg8::StaticOrder S; S.init(MTOK, EVEN_IN, F.G, (int)blockIdx.x);
          pg8::Epi E = E0; E.O = Z; E.ldc = EVEN_IN; E.rs = RS; E.act_silu = 0x30Cu; E.act_sig = 0xC0u; pg8::gemm_phase(F.wave, F.lds, g, S, E); }
        { pg8::Gemm g{(const bf16*)(ws + WS_MEMN), (const bf16*)(ws + WS_W_KV), BATCH * MEMLEN, 2048, DM}; pg8::StaticOrder S; S.init(BATCH * MEMLEN, 2048, F.G, (int)blockIdx.x);
          pg8::Epi E = E0; E.mode = 3; E.O = (bf16*)(ws + WS_KP); pg8::gemm_phase(F.wave, F.lds, g, S, E); }
        { pg8::Gemm g{(const bf16*)(ws + WS_W_KV) + (size_t)2048 * DM, (const bf16*)(ws + WS_MEMN), 2048, BATCH * MEMLEN, DM}; pg8::StaticOrder S; S.init(2048, BATCH * MEMLEN, F.G, (int)((blockIdx.x + F.G - 32) % F.G));
          pg8::Epi E = E0; E.mode = 4; E.O = (bf16*)(ws + WS_VP); pg8::gemm_phase(F.wave, F.lds, g, S, E); }
        { const int bx = (int)blockIdx.x; const int nidle = F.G > 64 ? F.G - 64 : F.G; const int me = F.G > 64 ? bx - 64 : bx;
          if (me >= 0) p1_late_weights(F, args, me * NWAVES + F.wave, nidle * NWAVES); __syncthreads(); }
    } SEAM(1);
    if (IN(2)) { DUP(16) { s5_phase<false>(F, args); } DUP(17) { conv_phase(F, args); } } SEAM(2);
    if (IN(3)) DUP(3) { s5_phase<true>(F, args); __syncthreads(); } SEAM(3);
    if (IN(4)) DUP(4) { pg8::Gemm g{ZS, (const bf16*)(ws + WS_W_GLU), MTOK, S5W, S5W}; pg8::StaticOrder S; S.init(MTOK, S5W, F.G, (int)blockIdx.x);
        pg8::Epi E{}; E.mode = 2; E.perm = true; E.O = Y; E.ldc = DM; E.zs = ZS; E.gatep = Z + 512; E.gate_ld = EVEN_IN; E.gb = args.in[14];
        pg8::gemm_phase(F.wave, F.lds, g, S, E); } SEAM(4);
    if (IN(5)) DUP(5) { stagger_delay(); pg8::Gemm g{Y, (const bf16*)(ws + WS_W_OUT0), MTOK, DM, DM}; pg8::StaticOrder S; S.init(MTOK, DM, F.G, (int)blockIdx.x);
        pg8::Epi E = E1; E.xold = args.in[0]; pg8::gemm_phase(F.wave, F.lds, g, S, E); } SEAM(5);
    const bool fuse_xa = multi && (F.G == 256);
#define LOCAL_HANDOFF() do { asm volatile("s_waitcnt vmcnt(0)" ::: "memory"); __syncthreads(); \
        if (F.wave == 0 && lane_id_v() == 0) { __builtin_amdgcn_fence(__ATOMIC_ACQUIRE, "agent"); asm volatile("s_waitcnt vmcnt(0)" ::: "memory"); } __syncthreads(); } while (0)
    if (IN(6)) DUP(6) { pg8::Gemm g{XB, (const bf16*)(ws + WS_W_QG), MTOK, 2048, DM};
        pg8::Epi E = E0; E.O = Z; E.ldc = 2048; E.rs = RS; E.act_silu = 0xF0u;
        if (fuse_xa) { pg8::PairOrder S{F.vcu}; pg8::gemm_phase(F.wave, F.lds, g, S, E); }
        else { pg8::StaticOrder S; S.init(MTOK, 2048, F.G, (int)blockIdx.x); pg8::gemm_phase(F.wave, F.lds, g, S, E); } }
    if (fuse_xa) { if (IN(6) && IN(7)) LOCAL_HANDOFF(); } else SEAM(6);
    if (IN(7)) DUP(7) { xattn_mfma(F, 0, fuse_xa); __syncthreads(); } SEAM(7);
    if (IN(8)) { stagger_delay(); pg8::Gemm g{Y, (const bf16*)(ws + WS_W_O), MTOK, DM, DM}; pg8::StaticOrder S; S.init(MTOK, DM, F.G, (int)blockIdx.x);
        pg8::gemm_phase(F.wave, F.lds, g, S, E1); } SEAM(8);
    if (IN(9)) DUP(9) { pg8::Gemm g{XB, (const bf16*)(ws + WS_W_IN1), MTOK, ODD_IN, DM}; pg8::StaticOrder S; S.init(MTOK, ODD_IN, F.G, (int)blockIdx.x);
#if defined(PROBE_NULLEPI)
        { pg8::Epi En = E0; En.mode = PROBE_NULLEPI; En.O = Z; En.rs = RS; pg8::gemm_phase(F.wave, F.lds, g, S, En); }
#endif
        pg8::Epi E = E0; E.mode = 5; E.O = Z; E.rs = RS; pg8::gemm_phase(F.wave, F.lds, g, S, E); } SEAM(9);
    if (IN(10)) DUP(10) { chunk_attn_mfma(F, args); __syncthreads(); } SEAM(10);
    if (IN(11)) { stagger_delay(); pg8::Gemm g{Y, (const bf16*)(ws + WS_W_OUT1), MTOK, DM, DM}; pg8::StaticOrder S; S.init(MTOK, DM, F.G, (int)blockIdx.x);
        pg8::gemm_phase(F.wave, F.lds, g, S, E1); } SEAM(11);
    if (IN(12)) { pg8::Gemm g{XB, (const bf16*)(ws + WS_W_QG) + (size_t)2048 * DM, MTOK, 2048, DM};
        pg8::Epi E = E0; E.O = Z; E.ldc = 2048; E.rs = RS; E.act_silu = 0xF0u;
        if (fuse_xa) { pg8::PairOrder S{F.vcu}; pg8::gemm_phase(F.wave, F.lds, g, S, E); }
        else { pg8::StaticOrder S; S.init(MTOK, 2048, F.G, (int)blockIdx.x); pg8::gemm_phase(F.wave, F.lds, g, S, E); } }
    if (fuse_xa) { if (IN(12) && IN(13)) LOCAL_HANDOFF(); } else SEAM(12);
    if (IN(13)) { xattn_mfma(F, 1, fuse_xa); } SEAM(13);
    if (IN(14)) { stagger_delay(); pg8::Gemm g{Y, (const bf16*)(ws + WS_W_O) + (size_t)DM * DM, MTOK, DM, DM}; pg8::StaticOrder S; S.init(MTOK, DM, F.G, (int)blockIdx.x);
        pg8::Epi E = E1; E.mode = 6; E.fin_g = args.in[28]; E.fin_cnt = F.ctl + CW_FIN; E.fin_out = args.out; pg8::gemm_phase(F.wave, F.lds, g, S, E); }
#if defined(PROBE_TAIL)
    xcd_barrier(bar);
#if PROBE_TAIL == 1
    conv_phase(F, args);
#endif
#endif
#undef IN
#undef SEAM
}

extern "C" void kernel_launch(void* const* d_in, const int* in_sizes, int n_in, void* d_out, int out_size, void* d_ws, size_t ws_size, hipStream_t stream) {
    static int grid = 0;
    if (grid == 0) {
        if (n_in != 29 || out_size != MTOK * DM || ws_size < WS_END) { fprintf(stderr, "kernel_launch: unexpected shapes: n_in %d out %d ws %zu\n", n_in, out_size, ws_size); grid = -1; return; }
        int dev = 0, cus = 0, per_cu = 0;
        if (hipGetDevice(&dev) != hipSuccess || hipDeviceGetAttribute(&cus, hipDeviceAttributeMultiprocessorCount, dev) != hipSuccess) { grid = -1; return; }
        if (hipFuncSetAttribute((const void*)trunk_fwd, hipFuncAttributeMaxDynamicSharedMemorySize, LDS_BYTES) != hipSuccess) { fprintf(stderr, "kernel_launch: hipFuncSetAttribute failed\n"); grid = -1; return; }
        if (hipOccupancyMaxActiveBlocksPerMultiprocessor(&per_cu, (const void*)trunk_fwd, NWAVES * 64, LDS_BYTES) != hipSuccess || per_cu < 1) { fprintf(stderr, "kernel_launch: occupancy query reports %d\n", per_cu); per_cu = 1; }
        (void)hipGetLastError();
        grid = cus;
        if (grid > cus * per_cu) grid = cus * per_cu;
    }
    if (grid < 0) return;
    (void)hipMemsetAsync((char*)d_ws + WS_CTL, 0, CTL_ZERO_BYTES, stream);
    Args a{};
    for (int i = 0; i < 29; ++i) a.in[i] = (const float*)d_in[i];
    a.out = (float*)d_out; a.ws = (unsigned char*)d_ws;
    if (MK_N_LAUNCHES == 1) { a.ph_lo = 0; a.ph_hi = NPH; hipLaunchKernelGGL(trunk_fwd, dim3(grid), dim3(NWAVES * 64), LDS_BYTES, stream, a); }
    else { for (int p = 0; p < NPH; ++p) { a.ph_lo = p; a.ph_hi = p + 1; hipLaunchKernelGGL(trunk_fwd, dim3(grid), dim3(NWAVES * 64), LDS_BYTES, stream, a); } }
}
```

```cpp
#include <hip/hip_runtime.h>
#include <cstdio>
#include <cstdint>
#include <utility>

#ifndef MK_N_LAUNCHES
#define MK_N_LAUNCHES 1
#endif
#ifndef STAGGER_US
#define STAGGER_US 0
#endif
#ifndef CA_PROBE
#define CA_PROBE 0
#endif
#ifndef DUP_MASK
#define DUP_MASK 0u
#endif

#define GAS __attribute__((address_space(1)))
#define LAS __attribute__((address_space(3)))
typedef unsigned short bf16;
typedef short bf16x8 __attribute__((ext_vector_type(8)));
typedef float f32x4 __attribute__((ext_vector_type(4)));
typedef float f32x2 __attribute__((ext_vector_type(2)));
typedef unsigned u32x4 __attribute__((ext_vector_type(4)));
typedef unsigned u32x2 __attribute__((ext_vector_type(2)));
typedef float f32x16 __attribute__((ext_vector_type(16)));
typedef short s16x4 __attribute__((ext_vector_type(4)));
__host__ __device__ __forceinline__ int crow16(int reg, int hi) { return (reg & 3) + 8 * (reg >> 2) + 4 * hi; }

constexpr int BATCH = 4, SEQ = 8192, DM = 1024, MTOK = BATCH * SEQ;
constexpr int EVEN_IN = 2560, ODD_IN = 4096, S5W = 512, NGRP = 32, NST = 64, CONVK = 31;
constexpr int MEMLEN = 256, NCHUNK = SEQ / 64;
constexpr float EPS = 1e-6f, LOG2E = 1.4426950408889634f;
constexpr float QSCALE_ATT = 0.125f * LOG2E;
constexpr float QSCALE_XA = 0.0625f * LOG2E;
constexpr int NWAVES = 8;

constexpr size_t MiB = 1u << 20;
constexpr size_t WS_CTL = 0, CTL_ZERO_BYTES = 1 * MiB;
constexpr size_t WS_W_IN0 = 2 * MiB, WS_W_OUT0 = 7 * MiB, WS_W_GLU = 9 * MiB, WS_W_IN1 = 10 * MiB, WS_W_OUT1 = 18 * MiB;
constexpr size_t WS_W_QG = 20 * MiB, WS_W_KV = 28 * MiB, WS_W_O = 36 * MiB, WS_MEMN = 40 * MiB, WS_KP = 42 * MiB, WS_VP = 46 * MiB;
constexpr size_t WS_PAR = 50 * MiB, WS_RS = 51 * MiB, WS_SC = 53 * MiB;
constexpr size_t WS_XB = 64 * MiB, WS_Y = 128 * MiB, WS_ZS = 192 * MiB, WS_Z = 224 * MiB, WS_END = 480 * MiB;
constexpr int CW_BAR = 4096, CW_FIN = 8192;

constexpr int RING_BYTES = 143360, LDSCTL_OFF = RING_BYTES, MISC_OFF = LDSCTL_OFF + 320, RSTD_OFF = 147456, LDS_BYTES = 163840;

#define RLX_AGENT __ATOMIC_RELAXED, __HIP_MEMORY_SCOPE_AGENT
__device__ __forceinline__ unsigned f2bf(float f) { unsigned u = __builtin_bit_cast(unsigned, f); return (u + 0x7fffu + ((u >> 16) & 1u)) >> 16; }
typedef __bf16 bf16x2_t __attribute__((ext_vector_type(2)));
__device__ __forceinline__ unsigned pk2(float lo, float hi) { const f32x2 v = {lo, hi}; const bf16x2_t b = __builtin_convertvector(v, bf16x2_t); return __builtin_bit_cast(unsigned, b); }
__device__ __forceinline__ float bflo(unsigned w) { return __uint_as_float(w << 16); }
__device__ __forceinline__ float bfhi(unsigned w) { return __uint_as_float(w & 0xffff0000u); }
__device__ __forceinline__ float bf2f(unsigned short b) { return __uint_as_float((unsigned)b << 16); }
__device__ __forceinline__ int lane_id_v() { int l; asm volatile("v_mbcnt_lo_u32_b32 %0, -1, 0\n\tv_mbcnt_hi_u32_b32 %0, -1, %0" : "=v"(l)); return l; }
__device__ __forceinline__ bf16x8 gload16_asm(const void* p) { bf16x8 v; asm volatile("global_load_dwordx4 %0, %1, off" : "=v"(v) : "v"(p) : "memory"); return v; }
__device__ __forceinline__ void glds16_asm(const void* gsrc, unsigned lds_dst) { unsigned keep;
    asm volatile("s_mov_b32 %0, m0\n\ts_mov_b32 m0, %2\n\ts_nop 0\n\tglobal_load_lds_dwordx4 %1, off\n\ts_mov_b32 m0, %0" : "=&s"(keep) : "v"(gsrc), "s"(lds_dst) : "memory"); }
__device__ __forceinline__ float max3_asm(float a, float b, float c) { float r; asm("v_max3_f32 %0, %1, %2, %3" : "=v"(r) : "v"(a), "v"(b), "v"(c)); return r; }
__device__ __forceinline__ float max2_asm(float a, float b) { float r; asm("v_max_f32_e32 %0, %1, %2" : "=v"(r) : "v"(a), "v"(b)); return r; }
__device__ __forceinline__ int opaque0() { int z; asm volatile("v_mov_b32 %0, 0" : "=v"(z)); return z; }
__device__ __forceinline__ float fast_sigmoid(float x) { return __builtin_amdgcn_rcpf(1.0f + __builtin_amdgcn_exp2f(-x * LOG2E)); }
__device__ __forceinline__ float fast_silu(float x) { return x * fast_sigmoid(x); }
__device__ __forceinline__ float gelu_tanh(float y) { const float x = 0.7978845608028654f * (y + 0.044715f * y * y * y); return y * fast_sigmoid(2.0f * x); }
__device__ __forceinline__ float wave_sum(float v) {
    v += __builtin_bit_cast(float, __builtin_amdgcn_update_dpp(0, __builtin_bit_cast(int, v), 0xB1, 0xF, 0xF, true));
    v += __builtin_bit_cast(float, __builtin_amdgcn_update_dpp(0, __builtin_bit_cast(int, v), 0x4E, 0xF, 0xF, true));
    v += __builtin_bit_cast(float, __builtin_amdgcn_update_dpp(0, __builtin_bit_cast(int, v), 0x141, 0xF, 0xF, true));
    v += __builtin_bit_cast(float, __builtin_amdgcn_update_dpp(0, __builtin_bit_cast(int, v), 0x140, 0xF, 0xF, true));
    const int b = __builtin_bit_cast(int, v);
    const float r0 = __builtin_bit_cast(float, __builtin_amdgcn_readlane(b, 0)), r1 = __builtin_bit_cast(float, __builtin_amdgcn_readlane(b, 16));
    const float r2 = __builtin_bit_cast(float, __builtin_amdgcn_readlane(b, 32)), r3 = __builtin_bit_cast(float, __builtin_amdgcn_readlane(b, 48));
    return (r0 + r1) + (r2 + r3);
}
__device__ __forceinline__ void unpack8(const u32x4 w, float* f) {
    f[0] = bflo(w.x); f[1] = bfhi(w.x); f[2] = bflo(w.y); f[3] = bfhi(w.y); f[4] = bflo(w.z); f[5] = bfhi(w.z); f[6] = bflo(w.w); f[7] = bfhi(w.w);
}

namespace pg8 {
constexpr int BM = 256, BK = 64, HALF = 128, HTB = HALF * BK * 2, STAGE_BYTES = 8 * HTB, NXCD = 8, WGM = 8;
__host__ __device__ __forceinline__ int lds_byte(int r, int c) { const int st = (r >> 4) * 2 + (c >> 5), rr = r & 15, cc = c & 31, ob = rr * 64 + cc * 2; return st * 1024 + (ob ^ (((ob >> 9) & 1) << 5)); }
__host__ __device__ __forceinline__ void stage_rc(int b, int& R, int& C) { const int st = b / 1024, sb = b % 1024, swz = sb ^ (((sb >> 9) & 1) << 5); R = (st >> 1) * 16 + swz / 64; C = (st & 1) * 32 + (swz % 64) / 2; }
__host__ __device__ __forceinline__ int perm32(int rho) { const int n = rho >> 4, i = rho & 15; return 8 * (i >> 2) + 4 * n + (i & 3); }

struct Unit { int pm, pn; };
struct Gemm { const bf16* A; const bf16* Bt; int M, N, K; };

struct StaticOrder {
    int nM, nN, nwg, G, c;
    __host__ __device__ void init(int M, int N, int G_, int c_) { nM = M / BM; nN = N / BM; nwg = nM * nN; G = G_; c = c_; }
    __host__ __device__ bool next(int i, Unit& u) const {
        const long L = (long)i * G + c; if (L >= nwg) return false;
        int wgid = (int)L; { const int q = nwg / NXCD, r = nwg % NXCD, xcd = wgid % NXCD, off = wgid / NXCD; wgid = (xcd < r ? xcd * (q + 1) : r * (q + 1) + (xcd - r) * q) + off; }
        const int nig = WGM * nN, gid = wgid / nig, fm = gid * WGM, gsz = (nM - fm) < WGM ? (nM - fm) : WGM;
        u.pm = fm + ((wgid % nig) % gsz); u.pn = (wgid % nig) / gsz; return true;
    }
};

#define G_SILU_IN_ATTN 1
#define EPI_ST_MODE 0
#if EPI_ST_MODE == 1
__device__ __forceinline__ void st16_wt(void* p, u32x4 w) { asm volatile("global_store_dwordx4 %0, %1, off\n\ts_nop 1" :: "v"(p), "v"(w) : "memory"); }
#define EPI_ST16(ptr, w) st16_wt((void*)(ptr), (w))
#else
#define EPI_ST16(ptr, w) (*(u32x4*)(ptr) = (w))
#endif
__device__ __forceinline__ float fq_sum(float x) {
    unsigned a = __float_as_uint(x);
    { const auto r = __builtin_amdgcn_permlane16_swap(a, a, false, false); a = __float_as_uint(__uint_as_float(r[0]) + __uint_as_float(r[1])); }
    { const auto r = __builtin_amdgcn_permlane32_swap(a, a, false, false); a = __float_as_uint(__uint_as_float(r[0]) + __uint_as_float(r[1])); }
    return __uint_as_float(a);
}
__device__ __forceinline__ unsigned cvt_pk_bf16(float lo, float hi) { unsigned r; asm volatile("v_cvt_pk_bf16_f32 %0, %1, %2" : "=v"(r) : "v"(lo), "v"(hi)); return r; }

struct Epi {
    int mode; bool perm;
    unsigned act_silu, act_sig;
    const float* fin_g; unsigned* fin_cnt; float* fin_out;
    bf16* O; int ldc; const float* rs;
    const float* xold; float* xout; bf16* xb; bf16* xl; float* rsout;
    const bf16* zs; const bf16* gatep; int gate_ld; const float* gb;
    __device__ __forceinline__ void operator()(f32x4 (&acc)[2][2][4][2], const Unit& u, int wr, int wc, int fr, int fq, LAS float* rcache, int& cached_pm) const {
#if defined(PROBE_NULLEPI)
        if (mode == 7) {
#pragma unroll
            for (int a_ = 0; a_ < 2; ++a_)
#pragma unroll
                for (int b_ = 0; b_ < 2; ++b_)
#pragma unroll
                    for (int m_ = 0; m_ < 4; ++m_)
#pragma unroll
                        for (int n_ = 0; n_ < 2; ++n_) asm volatile("" :: "v"(acc[a_][b_][m_][n_]));
            return; }
#endif
        if (mode == 0) {
            const int row0 = u.pm * BM + wr * 64 + fr, col0 = u.pn * BM + wc * 32 + 8 * fq;
            const int act = ((act_silu >> u.pn) & 1u) ? 1 : (((act_sig >> u.pn) & 1u) ? 2 : 0);
            float scv[2][4];
            if (rs) {
                if (cached_pm == u.pm) { const f32x4 c0 = *(const LAS f32x4*)rcache, c1 = *(const LAS f32x4*)(rcache + 4);
#pragma unroll
                    for (int e = 0; e < 4; ++e) { scv[0][e] = c0[e]; scv[1][e] = c1[e]; } }
                else {
                    f32x4 rsv[2][4];
#pragma unroll
                    for (int ai = 0; ai < 2; ++ai)
#pragma unroll
                        for (int m = 0; m < 4; ++m) rsv[ai][m] = *(const f32x4*)(rs + (size_t)(row0 + ai * HALF + m * 16) * 16 + 4 * fq);
#pragma unroll
                    for (int ai = 0; ai < 2; ++ai)
#pragma unroll
                        for (int m = 0; m < 4; ++m) { const f32x4 a = rsv[ai][m]; float sq = (a[0] + a[1]) + (a[2] + a[3]); sq = fq_sum(sq);
                            scv[ai][m] = __builtin_amdgcn_rsqf(sq * (1.0f / 1024.0f) + EPS); }
                    *(LAS f32x4*)rcache = (f32x4){scv[0][0], scv[0][1], scv[0][2], scv[0][3]}; *(LAS f32x4*)(rcache + 4) = (f32x4){scv[1][0], scv[1][1], scv[1][2], scv[1][3]};
                    cached_pm = u.pm;
                }
            }
#pragma unroll
            for (int ai = 0; ai < 2; ++ai)
#pragma unroll
                for (int m = 0; m < 4; ++m) {
                    const int row = row0 + ai * HALF + m * 16;
                    const float sc = rs ? scv[ai][m] : 1.f;
                    bf16* rowp = O + (size_t)row * ldc + col0;
#pragma unroll
                    for (int bj = 0; bj < 2; ++bj) { f32x4 v0 = acc[ai][bj][m][0] * sc, v1 = acc[ai][bj][m][1] * sc;
                        if (act) {
#pragma unroll
                            for (int e = 0; e < 4; ++e) { const float s0 = fast_sigmoid(v0[e]), s1 = fast_sigmoid(v1[e]); v0[e] = (act == 1) ? v0[e] * s0 : s0; v1[e] = (act == 1) ? v1[e] * s1 : s1; } }
                        u32x4 w; w.x = cvt_pk_bf16(v0[0], v0[1]); w.y = cvt_pk_bf16(v0[2], v0[3]); w.z = cvt_pk_bf16(v1[0], v1[1]); w.w = cvt_pk_bf16(v1[2], v1[3]);
                        EPI_ST16(rowp + bj * HALF, w); }
                }
        } else if (mode == 1) {
            const int row0 = u.pm * BM + wr * 64 + fr, col0 = u.pn * BM + wc * 32 + 8 * fq;
            if (xold) {
#pragma unroll
                for (int aim = 0; aim < 4; ++aim) { const int ai = aim >> 1;
                    f32x4 xf[2][2][2];
#pragma unroll
                    for (int mm = 0; mm < 2; ++mm)
#pragma unroll
                        for (int bj = 0; bj < 2; ++bj) { const size_t off = (size_t)(row0 + ai * HALF + (2 * (aim & 1) + mm) * 16) * DM + col0 + bj * HALF; xf[mm][bj][0] = *(const f32x4*)(xold + off); xf[mm][bj][1] = *(const f32x4*)(xold + off + 4); }
#pragma unroll
                    for (int mm = 0; mm < 2; ++mm) { const int m = 2 * (aim & 1) + mm;
                        const int row = row0 + ai * HALF + m * 16; const size_t off = (size_t)row * DM + col0; float ss = 0.f;
#pragma unroll
                        for (int bj = 0; bj < 2; ++bj) {
                            const f32x4 x0 = xf[mm][bj][0] + acc[ai][bj][m][0], x1 = xf[mm][bj][1] + acc[ai][bj][m][1];
                            ss += ((x0[0] * x0[0] + x0[1] * x0[1]) + (x0[2] * x0[2] + x0[3] * x0[3])) + ((x1[0] * x1[0] + x1[1] * x1[1]) + (x1[2] * x1[2] + x1[3] * x1[3]));
                            u32x4 wh; wh.x = cvt_pk_bf16(x0[0], x0[1]); wh.y = cvt_pk_bf16(x0[2], x0[3]); wh.z = cvt_pk_bf16(x1[0], x1[1]); wh.w = cvt_pk_bf16(x1[2], x1[3]);
                            EPI_ST16(xb + off + bj * HALF, wh); }
                        ss = fq_sum(ss);
                        if (fq == 0) rsout[(size_t)row * 16 + u.pn * 4 + wc] = ss;
                    }
                }
            } else {
                u32x4 xin[2][4][2];
#pragma unroll
                for (int ai = 0; ai < 2; ++ai)
#pragma unroll
                    for (int m = 0; m < 4; ++m)
#pragma unroll
                        for (int bj = 0; bj < 2; ++bj) xin[ai][m][bj] = *(const u32x4*)(xb + (size_t)(row0 + ai * HALF + m * 16) * DM + col0 + bj * HALF);
#pragma unroll
                for (int ai = 0; ai < 2; ++ai)
#pragma unroll
                    for (int m = 0; m < 4; ++m) {
                        const int row = row0 + ai * HALF + m * 16; const size_t off = (size_t)row * DM + col0; float ss = 0.f;
#pragma unroll
                        for (int bj = 0; bj < 2; ++bj) {
                            float x[8]; unpack8(xin[ai][m][bj], x);
#pragma unroll
                            for (int e = 0; e < 4; ++e) { x[e] += acc[ai][bj][m][0][e]; x[4 + e] += acc[ai][bj][m][1][e]; }
#pragma unroll
                            for (int e = 0; e < 8; ++e) ss += x[e] * x[e];
                            u32x4 wh; wh.x = cvt_pk_bf16(x[0], x[1]); wh.y = cvt_pk_bf16(x[2], x[3]); wh.z = cvt_pk_bf16(x[4], x[5]); wh.w = cvt_pk_bf16(x[6], x[7]);
                            EPI_ST16(xb + off + bj * HALF, wh); }
                        ss = fq_sum(ss);
                        if (fq == 0) rsout[(size_t)row * 16 + u.pn * 4 + wc] = ss;
                    }
            }
        } else if (mode == 6) {
            const int row0 = u.pm * BM + wr * 64 + fr, col0 = u.pn * BM + wc * 32 + 8 * fq;
            u32x4 xin[2][4][2];
#pragma unroll
            for (int ai = 0; ai < 2; ++ai)
#pragma unroll
                for (int m = 0; m < 4; ++m)
#pragma unroll
                    for (int bj = 0; bj < 2; ++bj) xin[ai][m][bj] = *(const u32x4*)(xb + (size_t)(row0 + ai * HALF + m * 16) * DM + col0 + bj * HALF);
#pragma unroll
            for (int ai = 0; ai < 2; ++ai)
#pragma unroll
                for (int m = 0; m < 4; ++m) {
                    const int row = row0 + ai * HALF + m * 16; float ss = 0.f;
#pragma unroll
                    for (int bj = 0; bj < 2; ++bj)
                    { float h[8]; unpack8(xin[ai][m][bj], h);
#pragma unroll
                        for (int n = 0; n < 2; ++n) { f32x4 x = acc[ai][bj][m][n];
#pragma unroll
                            for (int e = 0; e < 4; ++e) x[e] += h[4 * n + e];
                            acc[ai][bj][m][n] = x; ss += (x[0] * x[0] + x[1] * x[1]) + (x[2] * x[2] + x[3] * x[3]); } }
                    ss = fq_sum(ss);
                    if (fq == 0) __hip_atomic_store(rsout + (size_t)row * 16 + u.pn * 4 + wc, ss, __ATOMIC_RELAXED, __HIP_MEMORY_SCOPE_AGENT);
                }
            asm volatile("s_waitcnt vmcnt(0)" ::: "memory");
            unsigned* cnt = fin_cnt + 64 * u.pm;
            if (fr == 0 && fq == 0) __hip_atomic_fetch_add(cnt, 1u, __ATOMIC_RELAXED, __HIP_MEMORY_SCOPE_AGENT);
            for (unsigned sp = 0; sp < (1u << 20); ++sp) {
                if ((unsigned)__builtin_amdgcn_readfirstlane((int)__hip_atomic_load(cnt, __ATOMIC_RELAXED, __HIP_MEMORY_SCOPE_AGENT)) >= 32u) break;
                __builtin_amdgcn_s_sleep(2);
            }
            float tsl[2][4]; f32x4 gv[2][2];
#pragma unroll
            for (int ai = 0; ai < 2; ++ai)
#pragma unroll
                for (int m = 0; m < 4; ++m) { const float* sl = rsout + (size_t)(row0 + ai * HALF + m * 16) * 16 + 4 * fq;
                    tsl[ai][m] = (__hip_atomic_load(sl, __ATOMIC_RELAXED, __HIP_MEMORY_SCOPE_AGENT) + __hip_atomic_load(sl + 1, __ATOMIC_RELAXED, __HIP_MEMORY_SCOPE_AGENT))
                               + (__hip_atomic_load(sl + 2, __ATOMIC_RELAXED, __HIP_MEMORY_SCOPE_AGENT) + __hip_atomic_load(sl + 3, __ATOMIC_RELAXED, __HIP_MEMORY_SCOPE_AGENT)); }
#pragma unroll
            for (int bj = 0; bj < 2; ++bj)
#pragma unroll
                for (int n = 0; n < 2; ++n) gv[bj][n] = *(const f32x4*)(fin_g + col0 + bj * HALF + n * 4);
#pragma unroll
            for (int ai = 0; ai < 2; ++ai)
#pragma unroll
                for (int m = 0; m < 4; ++m) {
                    const int row = row0 + ai * HALF + m * 16; const size_t off = (size_t)row * DM + col0;
                    float t = tsl[ai][m]; t = fq_sum(t);
                    const float rstd = __builtin_amdgcn_rsqf(t * (1.0f / 1024.0f) + EPS);
#pragma unroll
                    for (int bj = 0; bj < 2; ++bj)
#pragma unroll
                        for (int n = 0; n < 2; ++n) *(f32x4*)(fin_out + off + bj * HALF + n * 4) = acc[ai][bj][m][n] * rstd * gv[bj][n];
                }
        } else if (mode == 5 || mode == 8) {
            const int row0 = u.pm * BM + wr * 64 + fr, col0 = u.pn * BM + wc * 32 + 8 * fq;
            const int quarter = u.pn >> 2; bf16* const Oq = O + (size_t)quarter * ((size_t)MTOK * 1024);
            float scv[2][4];
            if (cached_pm == u.pm) { const f32x4 c0 = *(const LAS f32x4*)rcache, c1 = *(const LAS f32x4*)(rcache + 4);
#pragma unroll
                for (int e = 0; e < 4; ++e) { scv[0][e] = c0[e]; scv[1][e] = c1[e]; } }
            else {
                f32x4 rsv[2][4];
#pragma unroll
                for (int ai = 0; ai < 2; ++ai)
#pragma unroll
                    for (int m = 0; m < 4; ++m) rsv[ai][m] = *(const f32x4*)(rs + (size_t)(row0 + ai * HALF + m * 16) * 16 + 4 * fq);
#pragma unroll
                for (int ai = 0; ai < 2; ++ai)
#pragma unroll
                    for (int m = 0; m < 4; ++m) { const f32x4 a = rsv[ai][m]; float sq = (a[0] + a[1]) + (a[2] + a[3]); sq = fq_sum(sq);
                        scv[ai][m] = __builtin_amdgcn_rsqf(sq * (1.0f / 1024.0f) + EPS); }
                *(LAS f32x4*)rcache = (f32x4){scv[0][0], scv[0][1], scv[0][2], scv[0][3]}; *(LAS f32x4*)(rcache + 4) = (f32x4){scv[1][0], scv[1][1], scv[1][2], scv[1][3]};
                cached_pm = u.pm;
            }
#pragma unroll
            for (int ai = 0; ai < 2; ++ai)
#pragma unroll
                for (int m = 0; m < 4; ++m) {
                    const int row = row0 + ai * HALF + m * 16;
                    const float sc = scv[ai][m];
                    const int bb = row >> 13, tt = row & 8191, chunk = tt >> 6, key = tt & 63;
#pragma unroll
                    for (int bj = 0; bj < 2; ++bj) { const int cc = (col0 + bj * HALF) & 1023, h = cc >> 6, dc = (cc & 63) >> 3;
                        f32x4 v0 = acc[ai][bj][m][0] * sc, v1 = acc[ai][bj][m][1] * sc;
#if !G_SILU_IN_ATTN
                        if (quarter == 3) {
#pragma unroll
                            for (int e = 0; e < 4; ++e) { v0[e] *= fast_sigmoid(v0[e]); v1[e] *= fast_sigmoid(v1[e]); } }
#endif
                        u32x4 w; w.x = cvt_pk_bf16(v0[0], v0[1]); w.y = cvt_pk_bf16(v0[2], v0[3]); w.z = cvt_pk_bf16(v1[0], v1[1]); w.w = cvt_pk_bf16(v1[2], v1[3]);
                        size_t off;
                        if (quarter == 1) off = ((size_t)(((bb * 16 + h) * 128 + chunk) * 8 + dc) * 64 + key) * 8;
                        else if (quarter == 2) off = (size_t)((bb * 16 + h) * 128 + chunk) * 4096 + key * 64 + ((dc ^ (((key >> 1) & 1) << 2)) * 8);
                        else off = (size_t)row * 1024 + cc;
#if defined(PROBE_NULLEPI)
                        if (mode == 8) asm volatile("" :: "v"(w), "v"(Oq + off)); else
#endif
                        EPI_ST16(Oq + off, w); }
                }
        } else if (mode == 3) {
            const int row0 = u.pm * BM + wr * 64 + fr, col0 = u.pn * BM + wc * 32 + 8 * fq;
#pragma unroll
            for (int ai = 0; ai < 2; ++ai)
#pragma unroll
                for (int m = 0; m < 4; ++m) {
                    const int row = row0 + ai * HALF + m * 16, b = row >> 8, key = row & 255;
#pragma unroll
                    for (int bj = 0; bj < 2; ++bj) { const int col = col0 + bj * HALF, l = col >> 10, hx = (col >> 8) & 3, dc = (col & 255) >> 3;
                        const f32x4 v0 = acc[ai][bj][m][0], v1 = acc[ai][bj][m][1];
                        u32x4 w; w.x = cvt_pk_bf16(v0[0], v0[1]); w.y = cvt_pk_bf16(v0[2], v0[3]); w.z = cvt_pk_bf16(v1[0], v1[1]); w.w = cvt_pk_bf16(v1[2], v1[3]);
                        *(u32x4*)(O + ((size_t)((((l * 4 + b) * 4 + hx) * 32 + dc) * 256 + key)) * 8) = w; }
                }
        } else if (mode == 4) {
            const int row0 = u.pm * BM + wr * 64 + fr, col0 = u.pn * BM + wc * 32 + 8 * fq;
#pragma unroll
            for (int ai = 0; ai < 2; ++ai)
#pragma unroll
                for (int m = 0; m < 4; ++m) {
                    const int row = row0 + ai * HALF + m * 16, l = row >> 10, hx = (row >> 8) & 3, d = row & 255;
#pragma unroll
                    for (int bj = 0; bj < 2; ++bj) { const int col = col0 + bj * HALF, b = col >> 8, kg = (col & 255) >> 2;
                        const f32x4 v0 = acc[ai][bj][m][0], v1 = acc[ai][bj][m][1];
                        u32x2 w0, w1; w0.x = cvt_pk_bf16(v0[0], v0[1]); w0.y = cvt_pk_bf16(v0[2], v0[3]); w1.x = cvt_pk_bf16(v1[0], v1[1]); w1.y = cvt_pk_bf16(v1[2], v1[3]);
                        bf16* p = O + ((size_t)((((l * 4 + b) * 4 + hx) * 64 + kg) * 256 + d)) * 4;
                        *(u32x2*)p = w0; *(u32x2*)(p + 256 * 4) = w1; }
                }
        } else {
            const int row0 = u.pm * BM + wr * 64 + fr, col0 = u.pn * BM + wc * 32 + 8 * fq;
            const f32x4 bb[2][2] = {{*(const f32x4*)(gb + col0), *(const f32x4*)(gb + col0 + 4)}, {*(const f32x4*)(gb + col0 + HALF), *(const f32x4*)(gb + col0 + HALF + 4)}};
            u32x4 zin[2][2], gin[2][2];
#define GLU_LOAD(buf, q_) do { const int bj_ = (q_) >> 2, ai_ = ((q_) >> 1) & 1, mh_ = (q_) & 1; _Pragma("unroll") for (int mm = 0; mm < 2; ++mm) { const int row_ = row0 + ai_ * HALF + (2 * mh_ + mm) * 16, col_ = col0 + bj_ * HALF; \
                zin[buf][mm] = *(const u32x4*)(zs + (size_t)row_ * S5W + col_); gin[buf][mm] = *(const u32x4*)(gatep + (size_t)row_ * gate_ld + col_); } } while (0)
            GLU_LOAD(0, 0);
#pragma unroll
            for (int q = 0; q < 8; ++q) { const int bj = q >> 2, ai = (q >> 1) & 1, mh = q & 1, cbuf = q & 1;
                if (q + 1 < 8) { if (cbuf == 0) GLU_LOAD(1, q + 1); else GLU_LOAD(0, q + 1); }
                const int col = col0 + bj * HALF; const f32x4 b0 = bb[bj][0], b1 = bb[bj][1];
#pragma unroll
                for (int mm = 0; mm < 2; ++mm) { const int m = 2 * mh + mm;
                    const int row = row0 + ai * HALF + m * 16;
                    const u32x4 zw = zin[cbuf][mm]; const u32x4 gw = gin[cbuf][mm];
                    float z[8], g[8], o[8]; unpack8(zw, z); unpack8(gw, g);
                    const f32x4 a0 = acc[ai][bj][m][0] + b0, a1 = acc[ai][bj][m][1] + b1;
#pragma unroll
                    for (int e = 0; e < 4; ++e) { o[e] = z[e] * fast_sigmoid(a0[e]) * g[e]; o[4 + e] = z[4 + e] * fast_sigmoid(a1[e]) * g[4 + e]; }
                    u32x4 w; w.x = cvt_pk_bf16(o[0], o[1]); w.y = cvt_pk_bf16(o[2], o[3]); w.z = cvt_pk_bf16(o[4], o[5]); w.w = cvt_pk_bf16(o[6], o[7]);
                    *(u32x4*)(O + (size_t)row * ldc + col) = w;
                }
            }
#undef GLU_LOAD
        }
    }
};

struct PairOrder {
    int vcu;
    __device__ __forceinline__ bool next(int i, Unit& u) const { if (i >= 4) return false;
        u.pm = (i >> 1) * 64 + (vcu >> 5) * 8 + ((vcu & 31) >> 2); u.pn = (vcu & 3) + 4 * (i & 1); return true; }
};
template <class Sched> __device__ __forceinline__ void gemm_phase(const int wid, LAS unsigned char* lds, const Gemm g, const Sched& S, const Epi& E) {
    const int lane = lane_id_v(), tid = wid * 64 + lane, wr = wid >> 2, wc = wid & 3, fr = lane & 15, fq = lane >> 4;
    const int K = g.K, nt = K / BK;
    unsigned voffA[2], voffB[2];
#pragma unroll
    for (int i = 0; i < 2; ++i) { int R, C; stage_rc(tid * 16 + i * 8192, R, C); const int Rb = E.perm ? ((R & ~31) + perm32(R & 31)) : R;
        voffA[i] = (unsigned)(R * K + C) * 2u; voffB[i] = (unsigned)(Rb * K + C) * 2u; }
    const size_t kstep = (size_t)(BK * 2);
    const size_t hstep = (size_t)HALF * K * 2;
    const size_t tstep = 2 * hstep;
    const unsigned ldsw = (unsigned)wid * 1024u;
    const int aoff = lds_byte(wr * 64 + fr, fq * 8), boff = lds_byte(wc * 32 + fr, fq * 8);
#define PG8_SA(b, h) (((b) * 2 + (h)) * HTB)
#define PG8_SB(b, h) ((4 + (b) * 2 + (h)) * HTB)
#define PG8_STAGE(bufoff, gbase, voff) do { _Pragma("unroll") for (int _i = 0; _i < 2; ++_i) \
        __builtin_amdgcn_global_load_lds((const unsigned*)((const char*)(gbase) + (voff)[_i]), (LAS unsigned*)(lds + (bufoff) + ldsw + _i * 8192), 16, 0, 0); } while (0)
#define PG8_LDA(dst, b, h) do { _Pragma("unroll") for (int m = 0; m < 4; ++m) _Pragma("unroll") for (int k = 0; k < 2; ++k) dst[m][k] = *(const LAS bf16x8*)(lds + PG8_SA(b, h) + aoff + m * 2048 + k * 1024); } while (0)
#define PG8_LDB(dst, b, h) do { _Pragma("unroll") for (int n = 0; n < 2; ++n) _Pragma("unroll") for (int k = 0; k < 2; ++k) dst[n][k] = *(const LAS bf16x8*)(lds + PG8_SB(b, h) + boff + n * 2048 + k * 1024); } while (0)
#define PG8_MMA(ai, bj, At, Bt) do { __builtin_amdgcn_s_setprio(1); _Pragma("unroll") for (int m = 0; m < 4; ++m) _Pragma("unroll") for (int n = 0; n < 2; ++n) _Pragma("unroll") for (int k = 0; k < 2; ++k) \
        acc[ai][bj][m][n] = __builtin_amdgcn_mfma_f32_16x16x32_bf16(Bt[n][k], At[m][k], acc[ai][bj][m][n], 0, 0, 0); __builtin_amdgcn_s_setprio(0); } while (0)
#define PG8_WAIT_V(n) asm volatile("s_waitcnt vmcnt(" #n ")" ::: "memory")
#define PG8_WAIT_L(n) asm volatile("s_waitcnt lgkmcnt(" #n ")" ::: "memory")
#define PG8_BAR __builtin_amdgcn_s_barrier()
#define PG8_SCHED __builtin_amdgcn_sched_barrier(0)
    Unit cur, nxt; int ui = 0;
    if (!S.next(0, cur)) return;
    int cached_pm = -1; LAS float* const rcache = (LAS float*)(lds + RSTD_OFF) + tid * 8;
    f32x4 acc[2][2][4][2];
#pragma unroll
    for (int a = 0; a < 2; ++a)
#pragma unroll
        for (int b = 0; b < 2; ++b)
#pragma unroll
            for (int m = 0; m < 4; ++m)
#pragma unroll
                for (int n = 0; n < 2; ++n) acc[a][b][m][n] = (f32x4){0.f, 0.f, 0.f, 0.f};
    bf16x8 At[4][2], B0[2][2], B1[2][2];
    const char* cA = (const char*)g.A + (size_t)cur.pm * tstep; const char* cB = (const char*)g.Bt + (size_t)cur.pn * tstep;
    PG8_STAGE(PG8_SB(0, 0), cB, voffB); PG8_STAGE(PG8_SB(0, 1), cB + hstep, voffB); PG8_STAGE(PG8_SA(0, 0), cA, voffA); PG8_STAGE(PG8_SA(0, 1), cA + hstep, voffA);
    if (wr == 1) PG8_BAR;
    PG8_WAIT_V(2); PG8_BAR;
    PG8_STAGE(PG8_SB(1, 0), cB + kstep, voffB); PG8_STAGE(PG8_SA(1, 0), cA + kstep, voffA); PG8_STAGE(PG8_SB(1, 1), cB + hstep + kstep, voffB);
    PG8_WAIT_V(6); PG8_BAR;
    for (;;) {
        const bool has_next = S.next(ui + 1, nxt);
        const char* nA = has_next ? (const char*)g.A + (size_t)nxt.pm * tstep : cA; const char* nB = has_next ? (const char*)g.Bt + (size_t)nxt.pn * tstep : cB;
        for (int t = 0; t < nt; t += 2) {
            const bool last = (t == nt - 2);
            const char* a1 = cA + (size_t)(t + 1) * kstep;
            const char* a2 = last ? nA : cA + (size_t)(t + 2) * kstep; const char* b2 = last ? nB : cB + (size_t)(t + 2) * kstep;
            const char* a3 = a2 + kstep; const char* b3 = b2 + kstep;
            PG8_LDB(B0, 0, 0); PG8_LDB(B1, 0, 1); PG8_SCHED; PG8_LDA(At, 0, 0); PG8_STAGE(PG8_SA(1, 1), a1 + hstep, voffA);
            PG8_WAIT_V(8); PG8_WAIT_L(0); PG8_BAR; PG8_MMA(0, 0, At, B0); PG8_MMA(0, 1, At, B1); PG8_BAR; PG8_SCHED;
            PG8_LDA(At, 0, 1); PG8_STAGE(PG8_SB(0, 0), b2, voffB); PG8_STAGE(PG8_SB(0, 1), b2 + hstep, voffB); PG8_STAGE(PG8_SA(0, 0), a2, voffA);
            PG8_WAIT_V(8); PG8_WAIT_L(0); PG8_BAR; PG8_MMA(1, 0, At, B0); PG8_MMA(1, 1, At, B1); PG8_BAR; PG8_SCHED;
            PG8_LDB(B0, 1, 0); PG8_LDB(B1, 1, 1); PG8_SCHED; PG8_LDA(At, 1, 0); PG8_STAGE(PG8_SA(0, 1), a2 + hstep, voffA);
            PG8_WAIT_V(8); PG8_WAIT_L(0); PG8_BAR; PG8_MMA(0, 0, At, B0); PG8_MMA(0, 1, At, B1); PG8_BAR; PG8_SCHED;
            PG8_LDA(At, 1, 1); PG8_STAGE(PG8_SB(1, 0), b3, voffB); PG8_STAGE(PG8_SB(1, 1), b3 + hstep, voffB); PG8_STAGE(PG8_SA(1, 0), a3, voffA);
            PG8_WAIT_V(8); PG8_WAIT_L(0); PG8_BAR; PG8_MMA(1, 0, At, B0); PG8_MMA(1, 1, At, B1); PG8_BAR; PG8_SCHED;
        }
        if (wr == 0) PG8_BAR;
        E(acc, cur, wr, wc, fr, fq, rcache, cached_pm);
        if (!has_next) break;
#pragma unroll
        for (int a = 0; a < 2; ++a)
#pragma unroll
            for (int b = 0; b < 2; ++b)
#pragma unroll
                for (int m = 0; m < 4; ++m)
#pragma unroll
                    for (int n = 0; n < 2; ++n) acc[a][b][m][n] = (f32x4){0.f, 0.f, 0.f, 0.f};
        cur = nxt; cA = nA; cB = nB; ++ui;
        if (wr == 1) PG8_BAR;
    }
    PG8_WAIT_V(0);
    PG8_BAR;
#undef PG8_SA
#undef PG8_SB
#undef PG8_STAGE
#undef PG8_LDA
#undef PG8_LDB
#undef PG8_MMA
#undef PG8_WAIT_V
#undef PG8_WAIT_L
#undef PG8_BAR
#undef PG8_SCHED
}
}

#define XB_TMO      128
#define XB_XCNT(j)  (256  + 64 * (j))
#define XB_XSUB(j)  (1280 + 64 * (j))
#define XB_XGEN(j)  (2304 + 64 * (j))
#define XB_TOP      3328
#define XB_TOPGEN   3392
#define XCD_BAR_WORDS 3456
#define XB_SPIN_CAP (1u << 18)
__device__ __forceinline__ unsigned xb_ld(unsigned* p)              { return __hip_atomic_load(p, __ATOMIC_RELAXED, __HIP_MEMORY_SCOPE_AGENT); }
__device__ __forceinline__ unsigned xb_add(unsigned* p, unsigned v) { return __hip_atomic_fetch_add(p, v, __ATOMIC_RELAXED, __HIP_MEMORY_SCOPE_AGENT); }
__device__ __forceinline__ unsigned xb_xcc_id() { return (unsigned)__builtin_amdgcn_s_getreg((3 << 11) | 20) & 0xFu; }
#define XB_SPIN(cond, bar) do { unsigned _sp = 0; while (cond) { __builtin_amdgcn_s_sleep(1); \
    if ((++_sp & 255u) == 0u) { if (xb_ld(&(bar)[XB_TMO])) break; if (_sp > XB_SPIN_CAP) { atomicAdd(&(bar)[XB_TMO], 1u); break; } } } } while (0)
struct XcdBarrier { unsigned* bar; unsigned x; volatile LAS unsigned* st; int wave; };
__device__ __forceinline__ XcdBarrier xcd_barrier_post(unsigned* bar, volatile LAS unsigned* st, int wave) {
    XcdBarrier b; b.bar = bar; b.x = xb_xcc_id(); b.st = st; b.wave = wave;
    if (wave == 0 && lane_id_v() == 0) (void)xb_add(&bar[XB_XCNT(b.x)], 1u);
    return b;
}
__device__ __forceinline__ void xcd_barrier_complete(unsigned* bar, unsigned x, unsigned& nloc, unsigned& nx) {
    const unsigned G = gridDim.x * gridDim.y * gridDim.z;
    unsigned sum, cnt, mine, sp = 0u;
    for (;;) {
        sum = 0u; cnt = 0u; mine = 0u;
#pragma unroll
        for (unsigned j = 0; j < 16; ++j) { const unsigned c = xb_ld(&bar[XB_XCNT(j)]); sum += c; cnt += (c > 0u) ? 1u : 0u; mine = (j == x) ? c : mine; }
        if (sum == G) break;
        __builtin_amdgcn_s_sleep(1);
        if ((++sp & 255u) == 0u) { if (xb_ld(&bar[XB_TMO])) break; if (sp > XB_SPIN_CAP) { atomicAdd(&bar[XB_TMO], 1u); break; } }
    }
    nloc = mine > 0u ? mine : 1u; nx = cnt > 0u ? cnt : 1u;
}
__device__ __forceinline__ void xcd_barrier(const XcdBarrier& b) {
    asm volatile("s_waitcnt vmcnt(0)" ::: "memory");
    __syncthreads();
    if (b.wave == 0 && lane_id_v() == 0) {
        unsigned* bar = b.bar;
        __builtin_amdgcn_s_waitcnt(0);
        unsigned nloc = b.st[0], nx = b.st[1];
        if (nloc == 0u) { xcd_barrier_complete(bar, b.x, nloc, nx); b.st[0] = nloc; b.st[1] = nx; }
        const unsigned old = xb_add(&bar[XB_XSUB(b.x)], 1u);
        const unsigned gen = old / nloc;
        if (old + 1u == (gen + 1u) * nloc) {
            __builtin_amdgcn_fence(__ATOMIC_RELEASE, "agent");
            asm volatile("s_waitcnt vmcnt(0)" ::: "memory");
            const unsigned og = xb_add(&bar[XB_TOP], 1u);
            const unsigned tg = og / nx;
            if (og + 1u == (tg + 1u) * nx) xb_add(&bar[XB_TOPGEN], 1u);
            else XB_SPIN(xb_ld(&bar[XB_TOPGEN]) == tg, bar);
            __builtin_amdgcn_fence(__ATOMIC_ACQUIRE, "agent");
            xb_add(&bar[XB_XGEN(b.x)], 1u);
            asm volatile("s_waitcnt vmcnt(0)" ::: "memory");
        } else {
            XB_SPIN(xb_ld(&bar[XB_XGEN(b.x)]) == gen, bar);
            __builtin_amdgcn_fence(__ATOMIC_ACQUIRE, "agent");
            asm volatile("s_waitcnt vmcnt(0)" ::: "memory");
        }
    }
    __syncthreads();
}

struct Args { const float* in[29]; float* out; unsigned char* ws; int ph_lo, ph_hi; };
struct Frame {
    LAS unsigned char* lds; volatile LAS unsigned* MISC; unsigned* ctl;
    int wave, vcu, G;
    unsigned char* ws; float* out;
};

__device__ __forceinline__ void p0_transpose_item(const float* W, const float* gain, int K, int N, bf16* WT, int qcols, float qscale, LAS float* scr, int item, int lane, int kvsplit = 0) {
    const int nblk = N / 32, kb = item / nblk, nb = item % nblk, k0 = 64 * kb, n0 = 32 * nb;
    const float cs = (n0 < qcols) ? qscale : 1.0f;
    float wv[32];
#pragma unroll
    for (int i = 0; i < 32; ++i) wv[i] = W[(size_t)(k0 + 2 * i + (lane >> 5)) * N + n0 + (lane & 31)];
    if (gain) {
#pragma unroll
        for (int i = 0; i < 32; ++i) wv[i] *= gain[k0 + 2 * i + (lane >> 5)];
    }
#pragma unroll
    for (int i = 0; i < 32; ++i) scr[(2 * i + (lane >> 5)) * 33 + (lane & 31)] = wv[i] * cs;
    asm volatile("s_waitcnt lgkmcnt(0)" ::: "memory");
    const int c = lane & 7;
#pragma unroll
    for (int j = 0; j < 4; ++j) { const int n = (lane >> 3) + 8 * j; const LAS float* s = scr + (8 * c) * 33 + n;
        u32x4 o; o.x = pk2(s[0 * 33], s[1 * 33]); o.y = pk2(s[2 * 33], s[3 * 33]); o.z = pk2(s[4 * 33], s[5 * 33]); o.w = pk2(s[6 * 33], s[7 * 33]);
        const int drow = kvsplit ? ((n0 < 1024) ? (n0 + n) : (n0 + n + 1024)) : (n0 + n);
        *(u32x4*)(WT + (size_t)drow * K + k0 + 8 * c) = o; }
    asm volatile("s_waitcnt lgkmcnt(0)" ::: "memory");
}

__device__ __forceinline__ void p1_late_weights(Frame& F, const Args& a, int gwl, int nwl) {
    LAS float* scr = (LAS float*)(F.lds + F.wave * 16384);
    const int lane = lane_id_v(); unsigned char* ws = F.ws;
    constexpr int I_OUT = 16 * 32, I_GLU = 8 * 16, I_IN1 = 16 * 128, I_QG = 16 * 64, I_O = 16 * 32;
    constexpr int NITEMS = I_OUT + I_GLU + I_IN1 + I_OUT + 2 * I_QG + 2 * I_O;
    for (int it = gwl; it < NITEMS; it += nwl) {
        int r = it;
        if (r < I_OUT) { p0_transpose_item(a.in[19], nullptr, DM, DM, (bf16*)(ws + WS_W_OUT0), 0, 1.f, scr, r, lane); continue; } r -= I_OUT;
        if (r < I_GLU) { p0_transpose_item(a.in[13], nullptr, S5W, S5W, (bf16*)(ws + WS_W_GLU), 0, 1.f, scr, r, lane); continue; } r -= I_GLU;
        if (r < I_IN1) { p0_transpose_item(a.in[21], a.in[20], DM, ODD_IN, (bf16*)(ws + WS_W_IN1), DM, QSCALE_ATT, scr, r, lane); continue; } r -= I_IN1;
        if (r < I_OUT) { p0_transpose_item(a.in[23], nullptr, DM, DM, (bf16*)(ws + WS_W_OUT1), 0, 1.f, scr, r, lane); continue; } r -= I_OUT;
        if (r < 2 * I_QG) { const int l = r / I_QG; p0_transpose_item(a.in[25] + (size_t)l * DM * 2048, a.in[24] + l * DM, DM, 2048, (bf16*)(ws + WS_W_QG) + (size_t)l * 2048 * DM, DM, QSCALE_XA, scr, r % I_QG, lane); continue; } r -= 2 * I_QG;
        { const int l = r / I_O; p0_transpose_item(a.in[27] + (size_t)l * DM * DM, nullptr, DM, DM, (bf16*)(ws + WS_W_O) + (size_t)l * DM * DM, 0, 1.f, scr, r % I_O, lane); }
    }
}
__device__ __forceinline__ void p0_prologue(Frame& F, const Args& a) {
    LAS float* scr = (LAS float*)(F.lds + F.wave * 16384);
    const int gw = F.vcu * NWAVES + F.wave, NGW = F.G * NWAVES, lane = lane_id_v();
    unsigned char* ws = F.ws;
    constexpr int I_IN0 = 16 * 80, I_KV = 16 * 64;
    constexpr int NITEMS = I_IN0 + 2 * I_KV;
    for (int it = gw; it < NITEMS; it += NGW) {
        int r = it;
        if (r < I_IN0) { p0_transpose_item(a.in[4], a.in[3], DM, EVEN_IN, (bf16*)(ws + WS_W_IN0), 0, 1.f, scr, r, lane); continue; } r -= I_IN0;
        { const int l = r / I_KV; p0_transpose_item(a.in[26] + (size_t)l * DM * 2048, nullptr, DM, 2048, (bf16*)(ws + WS_W_KV) + (size_t)l * 1024 * DM, 0, 1.f, scr, r % I_KV, lane, 1); }
    }
    for (int m = gw; m < BATCH * MEMLEN; m += NGW) {
        const f32x4* xr = (const f32x4*)(a.in[1] + (size_t)m * DM) + lane; const f32x4* gr = (const f32x4*)a.in[2] + lane;
        f32x4 v[4]; float s = 0.f;
#pragma unroll
        for (int j = 0; j < 4; ++j) { v[j] = xr[64 * j]; s += (v[j].x * v[j].x + v[j].y * v[j].y) + (v[j].z * v[j].z + v[j].w * v[j].w); }
        const float rstd = 1.0f / sqrtf(wave_sum(s) * (1.f / DM) + EPS);
        u32x2* o8 = (u32x2*)((bf16*)(ws + WS_MEMN) + (size_t)m * DM) + lane;
#pragma unroll
        for (int j = 0; j < 4; ++j) { const f32x4 g = gr[64 * j]; u32x2 w; w.x = pk2(v[j].x * rstd * g.x, v[j].y * rstd * g.y); w.y = pk2(v[j].z * rstd * g.z, v[j].w * rstd * g.w); o8[64 * j] = w; }
    }
    for (int m0 = gw * 4; m0 < MTOK; m0 += NGW * 4) {
        f32x4 v[4][4];
#pragma unroll
        for (int q = 0; q < 4; ++q)
#pragma unroll
            for (int j = 0; j < 4; ++j) v[q][j] = ((const f32x4*)(a.in[0] + (size_t)(m0 + q) * DM) + lane)[64 * j];
#pragma unroll
        for (int q = 0; q < 4; ++q) {
            u32x2* o8 = (u32x2*)((bf16*)(ws + WS_XB) + (size_t)(m0 + q) * DM) + lane;
            float* rs = (float*)(ws + WS_RS) + (size_t)(m0 + q) * 16;
            float sj[4];
#pragma unroll
            for (int j = 0; j < 4; ++j) { const f32x4 x = v[q][j]; sj[j] = wave_sum((x.x * x.x + x.y * x.y) + (x.z * x.z + x.w * x.w));
                u32x2 w; w.x = pk2(x.x, x.y); w.y = pk2(x.z, x.w); o8[64 * j] = w; }
            if (lane < 16) rs[lane] = (lane & 3) ? 0.f : ((lane >> 2) == 0 ? sj[0] : ((lane >> 2) == 1 ? sj[1] : ((lane >> 2) == 2 ? sj[2] : sj[3])));
        }
    }
    {
        const int gt = (F.vcu * NWAVES + F.wave) * 64 + lane;
        if (gt < NGRP * NST) {
            const int g = gt >> 6;
            const float lr = a.in[5][gt], li = a.in[6][gt], dt = expf(a.in[7][g]);
            const float mag = expf(lr * dt); float sn, cs; sincosf(li * dt, &sn, &cs);
            const float are = mag * cs, aim = mag * sn;
            const float den = lr * lr + li * li, nr = are - 1.0f;
            const float cre = (nr * lr + aim * li) / den, cim = (aim * lr - nr * li) / den;
            float pr = are, pi = aim;
#pragma unroll
            for (int i = 0; i < 6; ++i) { const float t = pr * pr - pi * pi; pi = 2.f * pr * pi; pr = t; }
            ((f32x4*)(ws + WS_PAR))[gt] = (f32x4){are, aim, pr, pi};
            const float* br = a.in[8] + (size_t)gt * 16; const float* bi = a.in[9] + (size_t)gt * 16;
            const int p = gt & 63;
            f32x4 brv[4], biv[4]; float crv[16], civ[16];
#pragma unroll
            for (int q = 0; q < 4; ++q) { brv[q] = ((const f32x4*)br)[q]; biv[q] = ((const f32x4*)bi)[q]; }
#pragma unroll
            for (int co = 0; co < 16; ++co) { crv[co] = a.in[10][(size_t)(g * 16 + co) * 64 + p]; civ[co] = a.in[11][(size_t)(g * 16 + co) * 64 + p]; }
            ((f32x4*)(ws + WS_PAR))[gt] = (f32x4){are, aim, pr, pi};
            bf16* bbt_re = (bf16*)(ws + WS_PAR + 524288) + (size_t)((g * 4 + 2 * (p >> 5)) * 32 + (p & 31)) * 16; bf16* bbt_im = bbt_re + 32 * 16;
#pragma unroll
            for (int q = 0; q < 4; ++q) { u32x2 wr_, wi_; float xr[4], xi[4];
#pragma unroll
                for (int e = 0; e < 4; ++e) { xr[e] = cre * brv[q][e] - cim * biv[q][e]; xi[e] = cre * biv[q][e] + cim * brv[q][e]; }
                wr_.x = pk2(xr[0], xr[1]); wr_.y = pk2(xr[2], xr[3]); wi_.x = pk2(xi[0], xi[1]); wi_.y = pk2(xi[2], xi[3]);
                ((u32x2*)bbt_re)[q] = wr_; ((u32x2*)bbt_im)[q] = wi_; }
            bf16* cmt = (bf16*)(ws + WS_PAR + 655360) + (size_t)g * 16 * 128 + 2 * p;
#pragma unroll
            for (int co = 0; co < 16; ++co) *(unsigned*)(cmt + co * 128) = pk2(crv[co], -civ[co]);
        }
    }
}

__device__ __forceinline__ float fma_asm(float a, float b, float c) { float d; asm("v_fma_f32 %0, %1, %2, %3" : "=v"(d) : "v"(a), "v"(b), "v"(c)); return d; }
__device__ __forceinline__ float fnma_asm(float a, float b, float c) { float d; asm("v_fma_f32 %0, -%1, %2, %3" : "=v"(d) : "v"(a), "v"(b), "v"(c)); return d; }
#define S5_CMAC(dr, di, ar, ai, xr, xi) asm("v_fma_f32 %0, %2, %4, %0\n\tv_fma_f32 %1, %2, %5, %1\n\tv_fma_f32 %0, -%3, %5, %0\n\tv_fma_f32 %1, %3, %4, %1" : "+v"(dr), "+v"(di) : "v"(ar), "v"(ai), "v"(xr), "v"(xi))
template <bool FULL> __device__ __forceinline__ void s5_scan_tile(f32x16& zr, f32x16& zi, const float (&pw)[8], float& cr, float& ci, int hi) {
#pragma unroll
    for (int i = 0; i < 4; ++i)
#pragma unroll
        for (int e = 1; e < 4; ++e) S5_CMAC(zr[4 * i + e], zi[4 * i + e], pw[0], pw[1], zr[4 * i + e - 1], zi[4 * i + e - 1]);
#pragma unroll
    for (int i = 0; i < 4; ++i) {
        float er = zr[4 * i + 3], orr = er, ei = zi[4 * i + 3], oi = ei;
        asm volatile("s_nop 1\n\tv_permlane32_swap_b32 %0, %1\n\tv_permlane32_swap_b32 %2, %3" : "+v"(er), "+v"(orr), "+v"(ei), "+v"(oi));
        float ner = er, nei = ei; S5_CMAC(ner, nei, pw[6], pw[7], cr, ci);
        const float cinr = hi ? ner : cr, cini = hi ? nei : ci;
        float nor = orr, noi = oi; S5_CMAC(nor, noi, pw[6], pw[7], ner, nei);
        cr = nor; ci = noi;
        if (FULL) {
#pragma unroll
            for (int e = 0; e < 4; ++e) S5_CMAC(zr[4 * i + e], zi[4 * i + e], pw[2 * e], pw[2 * e + 1], cinr, cini);
        }
    }
}
template <bool FULL> __device__ __forceinline__ void s5_phase(Frame& F, const Args& a) {
    const int gw = F.vcu * NWAVES + F.wave, NGW = F.G * NWAVES;
    const bf16* Z = (const bf16*)(F.ws + WS_Z); bf16* ZS = (bf16*)(F.ws + WS_ZS);
    f32x2* SR = (f32x2*)(F.ws + WS_SC);
    LAS unsigned char* const hb = F.lds + F.wave * (64 * 272);
    for (int wu = gw; wu < BATCH * NGRP * 16; wu += NGW) {
        const int lane = lane_id_v(), r = lane & 31, hi = lane >> 5;
        LAS unsigned char* const hbw = hb + (4 * hi) * 272 + r * 4; LAS unsigned char* const hbr = hb + (lane & 15) * 272 + (lane >> 4) * 16;
        const int rho = wu & 15, g = (wu >> 4) & 31, b = wu >> 9;
        const f32x4 pA = ((const f32x4*)(F.ws + WS_PAR))[g * 64 + r], pB = ((const f32x4*)(F.ws + WS_PAR))[g * 64 + 32 + r];
        float pwA[8], pwB[8];
        pwA[0] = pA.x; pwA[1] = pA.y; pwA[2] = pA.x * pA.x - pA.y * pA.y; pwA[3] = 2.f * pA.x * pA.y; pwA[4] = pwA[2] * pA.x - pwA[3] * pA.y; pwA[5] = pwA[2] * pA.y + pwA[3] * pA.x;
        pwA[6] = pwA[2] * pwA[2] - pwA[3] * pwA[3]; pwA[7] = 2.f * pwA[2] * pwA[3];
        pwB[0] = pB.x; pwB[1] = pB.y; pwB[2] = pB.x * pB.x - pB.y * pB.y; pwB[3] = 2.f * pB.x * pB.y; pwB[4] = pwB[2] * pB.x - pwB[3] * pB.y; pwB[5] = pwB[2] * pB.y + pwB[3] * pB.x;
        pwB[6] = pwB[2] * pwB[2] - pwB[3] * pwB[3]; pwB[7] = 2.f * pwB[2] * pwB[3];
        bf16x8 bbf[4];
#pragma unroll
        for (int ct = 0; ct < 4; ++ct) bbf[ct] = *(const bf16x8*)((const bf16*)(F.ws + WS_PAR + 524288) + (size_t)((g * 4 + ct) * 32 + r) * 16 + 8 * hi);
        bf16x8 cm[4]; f32x4 dsk = (f32x4){0.f, 0.f, 0.f, 0.f};
        float cAr = 0.f, cAi = 0.f, cBr = 0.f, cBi = 0.f;
        if (FULL) {
#pragma unroll
            for (int ks = 0; ks < 4; ++ks) cm[ks] = *(const bf16x8*)((const bf16*)(F.ws + WS_PAR + 655360) + (size_t)(g * 16 + (lane & 15)) * 128 + 32 * ks + 8 * (lane >> 4));
            dsk = *(const f32x4*)(a.in[12] + g * 16 + 4 * (lane >> 4));
            float qAr = pA.z, qAi = pA.w, qBr = pB.z, qBi = pB.w;
#pragma unroll
            for (int i = 0; i < 3; ++i) { float t = qAr * qAr - qAi * qAi; qAi = 2.f * qAr * qAi; qAr = t; t = qBr * qBr - qBi * qBi; qBi = 2.f * qBr * qBi; qBr = t; }
            const f32x2* sr = SR + (size_t)(wu - rho) * 64 + r;
            for (int j = 0; j < rho; ++j) { const f32x2 sA = sr[(size_t)j * 64], sB = sr[(size_t)j * 64 + 32];
                float nr = sA.x, ni = sA.y; S5_CMAC(nr, ni, qAr, qAi, cAr, cAi); cAr = nr; cAi = ni;
                nr = sB.x; ni = sB.y; S5_CMAC(nr, ni, qBr, qBi, cBr, cBi); cBr = nr; cBi = ni; }
        }
        const size_t rrow0 = (size_t)b * SEQ + (size_t)rho * 512;
        const bf16* up = Z + (rrow0 + r) * EVEN_IN + g * 16 + 8 * hi;
        bf16x8 uf_next = *(const bf16x8*)up;
        for (int c8 = 0; c8 < 8; ++c8) {
            const size_t row0 = rrow0 + (size_t)c8 * 64;
            u32x2 uw[4];
            if (FULL) {
#pragma unroll
                for (int tk = 0; tk < 4; ++tk) uw[tk] = *(const u32x2*)(Z + (row0 + 16 * tk + (lane & 15)) * EVEN_IN + g * 16 + 4 * (lane >> 4));
            }
#pragma unroll
            for (int tt = 0; tt < 2; ++tt) {
                const bf16x8 uf = uf_next;
                { const int tn = c8 * 2 + tt + 1; uf_next = *(const bf16x8*)(up + (size_t)(tn < 16 ? tn : 15) * 32 * EVEN_IN); }
                f32x16 acc[4];
#pragma unroll
                for (int ct = 0; ct < 4; ++ct) {
#pragma unroll
                    for (int e = 0; e < 16; ++e) acc[ct][e] = 0.f;
                    acc[ct] = __builtin_amdgcn_mfma_f32_32x32x16_bf16(uf, bbf[ct], acc[ct], 0, 0, 0);
                }
                asm volatile("s_nop 15\n\ts_nop 7" : "+v"(acc[0]), "+v"(acc[1]), "+v"(acc[2]), "+v"(acc[3]));
                s5_scan_tile<FULL>(acc[0], acc[1], pwA, cAr, cAi, hi);
                s5_scan_tile<FULL>(acc[2], acc[3], pwB, cBr, cBi, hi);
                if (FULL) {
#pragma unroll
                    for (int e = 0; e < 16; ++e) { LAS unsigned char* rowp = hbw + (32 * tt + (e & 3) + 8 * (e >> 2)) * 272;
                        *(LAS unsigned*)(rowp) = pk2(acc[0][e], acc[1][e]);
                        *(LAS unsigned*)(rowp + 128) = pk2(acc[2][e], acc[3][e]); }
                }
                __builtin_amdgcn_sched_barrier(0);
            }
            if (FULL) {
                const int tl = lane & 15, kq = lane >> 4;
#pragma unroll
                for (int tk = 0; tk < 4; ++tk) {
                    f32x4 y = (f32x4){0.f, 0.f, 0.f, 0.f};
                    const int tok = 16 * tk + tl;
#pragma unroll
                    for (int ks = 0; ks < 4; ++ks) { const bf16x8 hf = *(const LAS bf16x8*)(hbr + tk * (16 * 272) + ks * 64);
                        y = __builtin_amdgcn_mfma_f32_16x16x32_bf16(cm[ks], hf, y, 0, 0, 0); }
                    const float y0 = y[0] + dsk[0] * bflo(uw[tk].x), y1 = y[1] + dsk[1] * bfhi(uw[tk].x), y2 = y[2] + dsk[2] * bflo(uw[tk].y), y3 = y[3] + dsk[3] * bfhi(uw[tk].y);
                    u32x2 o; o.x = pk2(gelu_tanh(y0), gelu_tanh(y1)); o.y = pk2(gelu_tanh(y2), gelu_tanh(y3));
                    *(u32x2*)(ZS + (row0 + tok) * S5W + g * 16 + 4 * kq) = o;
                }
            }
        }
        if (!FULL) SR[(size_t)wu * 64 + r + 32 * hi] = hi ? (f32x2){cBr, cBi} : (f32x2){cAr, cAi};
    }
}

template <int S> __device__ __forceinline__ void conv_tap_v(f32x2 (&out2)[32], const f32x2 (&wA)[16], const f32x2 (&wB)[16], float v) {
    if (S < 64) {
        const f32x2 vv = {v, v};
        constexpr int i0 = (S >= 0 ? S : S - 1) / 2;
#pragma unroll
        for (int m = 0; m < 16; ++m) { const int i = i0 + m; if (i >= 0 && i < 32) out2[i] = __builtin_elementwise_fma((S & 1) ? wB[m] : wA[m], vv, out2[i]); }
    }
}
struct ConvBuf { unsigned short xa[8], xg[8]; };
template <int S0, int... I> __device__ __forceinline__ void conv_load(std::integer_sequence<int, I...>, ConvBuf& B, const bf16* zrow0, int t0) {
    ((B.xa[I] = (S0 + I < 64) ? zrow0[(long)((S0 + I >= 0 || t0 + S0 + I >= 0) ? (S0 + I) : 0) * EVEN_IN + 1024] : (unsigned short)0), ...);
    ((B.xg[I] = (S0 + I < 64) ? zrow0[(long)((S0 + I >= 0 || t0 + S0 + I >= 0) ? (S0 + I) : 0) * EVEN_IN + 1536] : (unsigned short)0), ...);
}
template <int S0, int... I> __device__ __forceinline__ void conv_taps8(std::integer_sequence<int, I...>, f32x2 (&out)[32], const f32x2 (&wA)[16], const f32x2 (&wB)[16], const ConvBuf& B, int t0) {
    (conv_tap_v<S0 + I>(out, wA, wB, (S0 + I >= 0 || t0 + S0 + I >= 0) ? bf2f(B.xa[I]) * bf2f(B.xg[I]) : 0.f), ...);
}
__device__ __forceinline__ void conv_phase(Frame& F, const Args& a) {
    const int lane = lane_id_v(), wave = F.wave, c = wave * 64 + lane;
    const bf16* Z = (const bf16*)(F.ws + WS_Z); bf16* Y = (bf16*)(F.ws + WS_Y);
    LAS f32x2* red = (LAS f32x2*)F.lds;
    LAS f32x2* stats = (LAS f32x2*)(F.lds + 4096);
    LAS unsigned char* const gbuf = F.lds + 8192; const unsigned gbuf0 = (unsigned)(uintptr_t)F.lds + 8192;
    const float cb = a.in[16][c], lng = a.in[17][c], lnb = a.in[18][c];
    for (int tile = F.vcu; tile < BATCH * NCHUNK; tile += F.G) {
        const int b = tile >> 7, t0 = (tile & 127) * 64; const size_t row0 = (size_t)b * SEQ + t0;
        __syncthreads();
        { const int lane_d = lane_id_v();
#pragma unroll 1
        for (int k = 0; k < 8; ++k) { const int t = wave * 8 + k;
            glds16_asm(Z + (row0 + t) * EVEN_IN + 2048 + lane_d * 8, (unsigned)__builtin_amdgcn_readfirstlane((int)(gbuf0 + t * 1024))); } }
        f32x2 out2[32];
#pragma unroll
        for (int t = 0; t < 32; ++t) out2[t] = (f32x2){cb, cb};
        const __attribute__((address_space(1))) float* wp0 = (const __attribute__((address_space(1))) float*)a.in[15]; asm volatile("" : "+s"(wp0)); const __attribute__((address_space(1))) float* wp = wp0 + (wave * 64 + lane_id_v());
    f32x2 wA[16], wB[16];
#pragma unroll
    for (int m = 0; m < 16; ++m) {
        const float e0 = wp[(30 - 2 * m) * 512], e1 = (2 * m + 1 <= 30) ? wp[(29 - 2 * m) * 512] : 0.f, em = (m >= 1) ? wp[(31 - 2 * m) * 512] : 0.f;
        wA[m] = (f32x2){e0, e1}; wB[m] = (f32x2){em, e0}; }

        { const bf16* zr0 = Z + row0 * EVEN_IN + (wave * 64 + lane_id_v()); const auto sq = std::make_integer_sequence<int, 8>{};
          ConvBuf A, B;
          conv_load<-30>(sq, A, zr0, t0); __builtin_amdgcn_sched_barrier(0); conv_load<-22>(sq, B, zr0, t0); __builtin_amdgcn_sched_barrier(0);
          conv_taps8<-30>(sq, out2, wA, wB, A, t0); conv_load<-14>(sq, A, zr0, t0); __builtin_amdgcn_sched_barrier(0);
          conv_taps8<-22>(sq, out2, wA, wB, B, t0); conv_load<-6>(sq, B, zr0, t0); __builtin_amdgcn_sched_barrier(0);
          conv_taps8<-14>(sq, out2, wA, wB, A, t0); conv_load<2>(sq, A, zr0, t0); __builtin_amdgcn_sched_barrier(0);
          conv_taps8<-6>(sq, out2, wA, wB, B, t0);  conv_load<10>(sq, B, zr0, t0); __builtin_amdgcn_sched_barrier(0);
          conv_taps8<2>(sq, out2, wA, wB, A, t0);   conv_load<18>(sq, A, zr0, t0); __builtin_amdgcn_sched_barrier(0);
          conv_taps8<10>(sq, out2, wA, wB, B, t0);  conv_load<26>(sq, B, zr0, t0); __builtin_amdgcn_sched_barrier(0);
          conv_taps8<18>(sq, out2, wA, wB, A, t0);  conv_load<34>(sq, A, zr0, t0); __builtin_amdgcn_sched_barrier(0);
          conv_taps8<26>(sq, out2, wA, wB, B, t0);  conv_load<42>(sq, B, zr0, t0); __builtin_amdgcn_sched_barrier(0);
          conv_taps8<34>(sq, out2, wA, wB, A, t0);  conv_load<50>(sq, A, zr0, t0); __builtin_amdgcn_sched_barrier(0);
          conv_taps8<42>(sq, out2, wA, wB, B, t0);  conv_load<58>(sq, B, zr0, t0); __builtin_amdgcn_sched_barrier(0);
          conv_taps8<50>(sq, out2, wA, wB, A, t0);
          conv_taps8<58>(sq, out2, wA, wB, B, t0); }
        float out[64];
#pragma unroll
        for (int t = 0; t < 32; ++t) { out[2 * t] = out2[t].x; out[2 * t + 1] = out2[t].y; }
        float r1[32];
#pragma unroll
        for (int i = 0; i < 32; ++i) { float x = out[i], y = out[i + 32];
            asm volatile("s_nop 1\n\tv_permlane32_swap_b32 %0, %1" : "+v"(x), "+v"(y)); r1[i] = x + y; }
#pragma unroll
        for (int half = 16; half >= 1; half >>= 1) { const bool up_ = (lane & half) != 0;
#pragma unroll
            for (int i = 0; i < half; ++i) { const float keep = up_ ? r1[i + half] : r1[i], send = up_ ? r1[i] : r1[i + half]; r1[i] = keep + __shfl_xor(send, half); } }
        const float s1 = r1[0];
#pragma unroll
        for (int i = 0; i < 32; ++i) { float x = out[i] * out[i], y = out[i + 32] * out[i + 32];
            asm volatile("s_nop 1\n\tv_permlane32_swap_b32 %0, %1" : "+v"(x), "+v"(y)); r1[i] = x + y; }
#pragma unroll
        for (int half = 16; half >= 1; half >>= 1) { const bool up_ = (lane & half) != 0;
#pragma unroll
            for (int i = 0; i < half; ++i) { const float keep = up_ ? r1[i + half] : r1[i], send = up_ ? r1[i] : r1[i + half]; r1[i] = keep + __shfl_xor(send, half); } }
        const float s2 = r1[0];
        __syncthreads();
        red[wave * 64 + lane] = (f32x2){s1, s2};
        __syncthreads();
        if (wave == 0) { float q1 = 0.f, q2 = 0.f;
#pragma unroll
            for (int i = 0; i < 8; ++i) { const f32x2 p = red[i * 64 + lane]; q1 += p.x; q2 += p.y; }
            const float mu = q1 * (1.f / 512.f); const float var = fmaxf(q2 * (1.f / 512.f) - mu * mu, 0.f);
            stats[lane] = (f32x2){mu, 1.0f / sqrtf(var + EPS)}; }
        asm volatile("s_waitcnt vmcnt(0)" ::: "memory");
        __syncthreads();
        {
            const int c_o = wave * 64 + lane_id_v();
            LAS unsigned short* gcol = (LAS unsigned short*)gbuf + c_o;
#pragma unroll
            for (int t = 0; t < 64; ++t) { const f32x2 st = stats[t]; const float cn = (out[t] - st.x) * st.y * lng + lnb;
                gcol[t * 512] = (unsigned short)f2bf(fast_silu(cn) * bf2f(gcol[t * 512])); }
        }
        __syncthreads();
        {
            const int tid = wave * 64 + lane_id_v();
#pragma unroll 2
            for (int k = 0; k < 8; ++k) { const int item = tid + 512 * k, t = item >> 6, ch = item & 63;
                *(u32x4*)(Y + (row0 + t) * DM + 512 + 8 * ch) = *(const LAS u32x4*)(gbuf + ((size_t)t * 512 + 8 * ch) * 2); }
        }
    }
}

__device__ __forceinline__ s16x4 tr_read(const LAS unsigned char* p) { return __builtin_bit_cast(s16x4, __builtin_amdgcn_ds_read_tr16_b64_v4i16((LAS s16x4*)p)); }
__device__ __forceinline__ void chunk_attn_mfma(Frame& F, const Args& a) {
    const int w = F.wave;
    const int hh = w >> 2, cc = (w >> 1) & 1, half = w & 1;
    LAS unsigned char* const lds = F.lds; const unsigned lds0 = (unsigned)(uintptr_t)F.lds; LAS float* const btab = (LAS float*)(lds + 131072);
    const bf16* ZQ = (const bf16*)(F.ws + WS_Z); const bf16* ZK = ZQ + (size_t)MTOK * 1024; const bf16* ZV = ZK + (size_t)MTOK * 1024; const bf16* ZG = ZV + (size_t)MTOK * 1024;
    bf16* Y = (bf16*)(F.ws + WS_Y);
#define CA_DMA_TILE_X(tb_, sb_, trel) do { const int T_ = (tb_) + (trel); if (T_ >= 0) { _Pragma("unroll") for (int i_ = 0; i_ < 4; ++i_) { const int piece_ = 4 * w + i_, sub_ = piece_ >> 3; \
        const bf16* src_ = ((sub_ < 2) ? ZK : ZV) + (size_t)((b * 16 + 2 * hp + (sub_ & 1)) * 128 + T_) * 4096 + (piece_ & 7) * 512 + lane * 8; \
        glds16_asm(src_, (unsigned)__builtin_amdgcn_readfirstlane((int)(lds0 + (((trel) + (sb_)) & 3) * 32768 + piece_ * 1024))); } } } while (0)
#define CA_DMA_TILE(trel) CA_DMA_TILE_X(tbase, sbase, trel)
#define CA_WAITBAR(n) asm volatile("s_waitcnt vmcnt(" #n ") lgkmcnt(0)\n\ts_barrier" ::: "memory")
    for (int uw_ = F.vcu; uw_ < BATCH * 8 * 8; uw_ += F.G) {
      const int hp = (uw_ >> 3) & 7, b = uw_ >> 6, cp0 = (uw_ & 7) * 8;
      const int h = 2 * hp + hh;
      int lane = lane_id_v(), r = lane & 31, hi = lane >> 5;
      __syncthreads();
      for (int i = w * 64 + lane; i < 2 * 320; i += NWAVES * 64) { const int hs = i / 320, ix = i - hs * 320; btab[i] = a.in[22][(2 * hp + hs) * 257 + (ix > 256 ? 256 : ix)] * LOG2E; }
      bf16x8 qn0, qn1, qn2, qn3;
      { const size_t qrow_ = (size_t)b * SEQ + (2 * cp0 + cc) * 64 + half * 32 + r; const bf16* qp_ = ZQ + qrow_ * 1024 + h * 64 + 8 * hi;
        qn0 = *(const bf16x8*)qp_; qn1 = *(const bf16x8*)(qp_ + 16); qn2 = *(const bf16x8*)(qp_ + 32); qn3 = *(const bf16x8*)(qp_ + 48); }
      { const int tb0 = 2 * cp0 - 8; CA_DMA_TILE_X(tb0, 0, 0); CA_DMA_TILE_X(tb0, 0, 1); }
      for (int ui = 0; ui < 8; ++ui) {
        const int cp = cp0 + ui, sbase = 2 * ui;
        const int c = 2 * cp + cc, tbase = 2 * cp - 8;
        lane = lane_id_v(); r = lane & 31; hi = lane >> 5;
        const int q4 = (lane & 15) >> 2, p4 = lane & 3, dsel = (lane >> 4) & 1, sw = (q4 >> 1) & 1;
        const int vlane = (4 * hi + q4) * 128 + (2 * dsel + (p4 >> 1)) * 16 + (p4 & 1) * 8;
        const size_t qrow = (size_t)b * SEQ + c * 64 + half * 32 + r;
        CA_WAITBAR(0);
        bf16x8 qf0 = qn0, qf1 = qn1, qf2 = qn2, qf3 = qn3;
        asm volatile("" : "+v"(qf0), "+v"(qf1), "+v"(qf2), "+v"(qf3));
        const float cfar = btab[hh * 320 + 256];
        float m = 0.f, l = 0.f; float firstv = 1.f; asm volatile("" : "+v"(firstv));
        f32x16 o0, o1, negm;
#pragma unroll
        for (int e = 0; e < 16; ++e) { o0[e] = 0.f; o1[e] = 0.f; negm[e] = cfar; }
#pragma unroll
        for (int s = 0; s < 9; ++s) {
            bool issue;
            if (s == 0) { CA_DMA_TILE(2); CA_DMA_TILE(3); issue = (tbase + 3 >= 0); }
            else if (s <= 6) { CA_DMA_TILE(s + 3); issue = (tbase + s + 3 >= 0); }
            else { issue = false;
                if (ui < 7) { const int tbn = tbase + 2;
                    if (s == 7) { const size_t qrow_ = qrow + 128; const bf16* qp_ = ZQ + qrow_ * 1024 + h * 64 + 8 * hi;
                        qn0 = *(const bf16x8*)qp_; qn1 = *(const bf16x8*)(qp_ + 16); qn2 = *(const bf16x8*)(qp_ + 32); qn3 = *(const bf16x8*)(qp_ + 48); }
                    CA_DMA_TILE_X(tbn, sbase + 2, s - 7); issue = (tbn + s - 7 >= 0); } }
            const int T = tbase + s + cc;
            if (T >= 0) {
                const int bsel = (s + cc + sbase) & 3;
                const LAS unsigned char* kb = lds + bsel * 32768 + hh * 8192 + (hi * 64 + r) * 16;
                const LAS unsigned char* vb = lds + bsel * 32768 + 16384 + hh * 8192 + vlane;
                f32x16 p0, p1;
                bf16x8 kf[8];
#pragma unroll
                for (int s4 = 0; s4 < 4; ++s4) { kf[2 * s4] = *(const LAS bf16x8*)(kb + (2 * s4) * 1024); kf[2 * s4 + 1] = *(const LAS bf16x8*)(kb + (2 * s4) * 1024 + 512); }
                s16x4 va[2][2][2], vc[2][2][2];
#pragma unroll
                for (int kh = 0; kh < 2; ++kh)
#pragma unroll
                    for (int s2 = 0; s2 < 2; ++s2) { const LAS unsigned char* vk = vb + (32 * kh + 16 * s2) * 128;
                        va[kh][s2][0] = tr_read(vk + sw * 64); va[kh][s2][1] = tr_read(vk + 8 * 128 + sw * 64);
                        vc[kh][s2][0] = tr_read(vk + (1 - sw) * 64); vc[kh][s2][1] = tr_read(vk + 8 * 128 + (1 - sw) * 64); }
                if (s >= 6) {
                    const LAS float* bp = btab + hh * 320 + (64 * (8 - s) + half * 32 + r - 4 * hi + 128 - 27 - 32);
#pragma unroll
                    for (int e = 0; e < 16; ++e) { const int ko = (e & 3) + 8 * (e >> 2); p0[e] = bp[27 + 32 - ko] - m; p1[e] = bp[27 - ko] - m; }
                } else { p0 = negm; p1 = negm; }
                __builtin_amdgcn_sched_barrier(0);
#pragma unroll
                for (int s4 = 0; s4 < 4; ++s4) {
                    const bf16x8 qf = s4 == 0 ? qf0 : (s4 == 1 ? qf1 : (s4 == 2 ? qf2 : qf3));
                    p0 = __builtin_amdgcn_mfma_f32_32x32x16_bf16(kf[2 * s4], qf, p0, 0, 0, 0);
                    p1 = __builtin_amdgcn_mfma_f32_32x32x16_bf16(kf[2 * s4 + 1], qf, p1, 0, 0, 0);
                }
                if (CA_PROBE == 2) {
                    u32x4 zz = (u32x4){0u, 0u, 0u, 0u}; asm volatile("" : "+v"(zz));
#pragma unroll
                    for (int s4 = 0; s4 < 4; ++s4) { const bf16x8 k0 = *(const LAS bf16x8*)(kb + (2 * s4) * 1024), k1 = *(const LAS bf16x8*)(kb + (2 * s4) * 1024 + 512);
                        p0 = __builtin_amdgcn_mfma_f32_32x32x16_bf16(k0, __builtin_bit_cast(bf16x8, zz), p0, 0, 0, 0); p1 = __builtin_amdgcn_mfma_f32_32x32x16_bf16(k1, __builtin_bit_cast(bf16x8, zz), p1, 0, 0, 0); }
                }
                asm volatile("s_nop 15\n\ts_nop 7" : "+v"(p0), "+v"(p1));
                float rm = max3_asm(p0[0], p0[1], p0[2]), rm2 = max3_asm(p0[3], p0[4], p0[5]), rm3 = max3_asm(p1[0], p1[1], p1[2]), rm4 = max3_asm(p1[3], p1[4], p1[5]);
#pragma unroll
                for (int e = 6; e < 16; e += 2) { rm = max3_asm(rm, p0[e], p0[e + 1]); rm3 = max3_asm(rm3, p1[e], p1[e + 1]); { const float t_ = rm; rm = rm2; rm2 = t_; } { const float t_ = rm3; rm3 = rm4; rm4 = t_; } }
                rm = max3_asm(rm, rm2, rm3); rm = max2_asm(rm, rm4);
                { const auto rr = __builtin_amdgcn_permlane32_swap(__float_as_uint(rm), __float_as_uint(rm), false, false); rm = max2_asm(__uint_as_float(rr[0]), __uint_as_float(rr[1])); }
                if (firstv != 0.f || rm > 6.f) {
                    const float dl = rm, al = (firstv != 0.f) ? 1.f : __builtin_amdgcn_exp2f(-dl);
                    m += dl; l *= al; firstv = 0.f;
#pragma unroll
                    for (int e = 0; e < 16; ++e) { p0[e] -= dl; p1[e] -= dl; o0[e] *= al; o1[e] *= al; negm[e] = cfar - m; }
                }
                float ps0 = 0.f, ps1 = 0.f, ps2 = 0.f, ps3 = 0.f;
#pragma unroll
                for (int e = 0; e < 16; e += 2) { p0[e] = __builtin_amdgcn_exp2f(p0[e]); p1[e] = __builtin_amdgcn_exp2f(p1[e]); p0[e + 1] = __builtin_amdgcn_exp2f(p0[e + 1]); p1[e + 1] = __builtin_amdgcn_exp2f(p1[e + 1]);
                    ps0 += p0[e]; ps1 += p1[e]; ps2 += p0[e + 1]; ps3 += p1[e + 1]; }
                l += (ps0 + ps1) + (ps2 + ps3);
                if (CA_PROBE == 3) { float dz = 0.f; asm volatile("" : "+v"(dz)); float acc_ = 0.f;
#pragma unroll
                    for (int e = 0; e < 16; ++e) { acc_ += __builtin_amdgcn_exp2f(p0[e] * dz) + __builtin_amdgcn_exp2f(p1[e] * dz); }
                    l += (acc_ - 32.f) * dz; }
                u32x4 pf[2][2];
#pragma unroll
                for (int s2 = 0; s2 < 2; ++s2) {
                    u32x4 t; t.x = pk2(p0[8 * s2 + 0], p0[8 * s2 + 1]); t.y = pk2(p0[8 * s2 + 2], p0[8 * s2 + 3]); t.z = pk2(p0[8 * s2 + 4], p0[8 * s2 + 5]); t.w = pk2(p0[8 * s2 + 6], p0[8 * s2 + 7]); pf[0][s2] = t;
                    u32x4 v; v.x = pk2(p1[8 * s2 + 0], p1[8 * s2 + 1]); v.y = pk2(p1[8 * s2 + 2], p1[8 * s2 + 3]); v.z = pk2(p1[8 * s2 + 4], p1[8 * s2 + 5]); v.w = pk2(p1[8 * s2 + 6], p1[8 * s2 + 7]); pf[1][s2] = v;
                }
#pragma unroll
                for (int kh = 0; kh < 2; ++kh)
#pragma unroll
                    for (int s2 = 0; s2 < 2; ++s2) {
                        const s16x4 a0 = va[kh][s2][0], a1 = va[kh][s2][1], c0 = vc[kh][s2][0], c1 = vc[kh][s2][1];
                        const bf16x8 vf0 = (bf16x8){a0[0], a0[1], a0[2], a0[3], a1[0], a1[1], a1[2], a1[3]};
                        const bf16x8 vf1 = (bf16x8){c0[0], c0[1], c0[2], c0[3], c1[0], c1[1], c1[2], c1[3]};
                        o0 = __builtin_amdgcn_mfma_f32_32x32x16_bf16(vf0, __builtin_bit_cast(bf16x8, pf[kh][s2]), o0, 0, 0, 0);
                        o1 = __builtin_amdgcn_mfma_f32_32x32x16_bf16(vf1, __builtin_bit_cast(bf16x8, pf[kh][s2]), o1, 0, 0, 0);
                    }
                if (CA_PROBE == 1) {
                    u32x4 zz = (u32x4){0u, 0u, 0u, 0u}; asm volatile("" : "+v"(zz));
#pragma unroll
                    for (int kh = 0; kh < 2; ++kh)
#pragma unroll
                        for (int s2 = 0; s2 < 2; ++s2) { const LAS unsigned char* vk = vb + (32 * kh + 16 * s2) * 128;
                            const s16x4 a0 = tr_read(vk + sw * 64), a1 = tr_read(vk + 8 * 128 + sw * 64), c0 = tr_read(vk + (1 - sw) * 64), c1 = tr_read(vk + 8 * 128 + (1 - sw) * 64);
                            const bf16x8 vf0 = (bf16x8){a0[0], a0[1], a0[2], a0[3], a1[0], a1[1], a1[2], a1[3]}; const bf16x8 vf1 = (bf16x8){c0[0], c0[1], c0[2], c0[3], c1[0], c1[1], c1[2], c1[3]};
                            o0 = __builtin_amdgcn_mfma_f32_32x32x16_bf16(vf0, __builtin_bit_cast(bf16x8, zz), o0, 0, 0, 0);
                            o1 = __builtin_amdgcn_mfma_f32_32x32x16_bf16(vf1, __builtin_bit_cast(bf16x8, zz), o1, 0, 0, 0); }
                }
            }
            __builtin_amdgcn_sched_barrier(0);
            if (s < 8) { if (issue) CA_WAITBAR(4); else CA_WAITBAR(0); }
        }
        { const auto rr = __builtin_amdgcn_permlane32_swap(__float_as_uint(l), __float_as_uint(l), false, false); l = __uint_as_float(rr[0]) + __uint_as_float(rr[1]); }
        const float rl = 1.0f / l;
        const bf16* gp = ZG + qrow * 1024 + h * 64 + 8 * hi; bf16* yp = Y + qrow * DM + h * 64 + 8 * hi;
        u32x4 gq4[4];
#pragma unroll
        for (int q = 0; q < 4; ++q) gq4[q] = *(const u32x4*)(gp + 16 * q);
#pragma unroll
        for (int q = 0; q < 4; ++q) {
            const int dt = q >> 1, i0 = 2 * (q & 1);
            u32x4 G = gq4[q];
            { const auto r1 = __builtin_amdgcn_permlane32_swap(G.x, G.z, false, false); const auto r2 = __builtin_amdgcn_permlane32_swap(G.y, G.w, false, false); G.x = r1[0]; G.z = r1[1]; G.y = r2[0]; G.w = r2[1]; }
            float gf[8] = {bflo(G.x), bfhi(G.x), bflo(G.y), bfhi(G.y), bflo(G.z), bfhi(G.z), bflo(G.w), bfhi(G.w)};
#if G_SILU_IN_ATTN
#pragma unroll
            for (int e = 0; e < 8; ++e) gf[e] = fast_silu(gf[e]);
#endif
#pragma unroll
            for (int e = 0; e < 8; ++e) gf[e] *= rl;
            u32x2 ya, yb;
            if (dt == 0) {
                ya.x = pk2(o0[4 * i0] * gf[0], o0[4 * i0 + 1] * gf[1]); ya.y = pk2(o0[4 * i0 + 2] * gf[2], o0[4 * i0 + 3] * gf[3]);
                yb.x = pk2(o0[4 * i0 + 4] * gf[4], o0[4 * i0 + 5] * gf[5]); yb.y = pk2(o0[4 * i0 + 6] * gf[6], o0[4 * i0 + 7] * gf[7]);
            } else {
                ya.x = pk2(o1[4 * i0] * gf[0], o1[4 * i0 + 1] * gf[1]); ya.y = pk2(o1[4 * i0 + 2] * gf[2], o1[4 * i0 + 3] * gf[3]);
                yb.x = pk2(o1[4 * i0 + 4] * gf[4], o1[4 * i0 + 5] * gf[5]); yb.y = pk2(o1[4 * i0 + 6] * gf[6], o1[4 * i0 + 7] * gf[7]);
            }
            { const auto r1 = __builtin_amdgcn_permlane32_swap(ya.x, yb.x, false, false); const auto r2 = __builtin_amdgcn_permlane32_swap(ya.y, yb.y, false, false);
              *(u32x4*)(yp + 16 * q) = (u32x4){r1[0], r2[0], r1[1], r2[1]}; }
        }
      }
    }
#undef CA_DMA_TILE_X
#undef CA_DMA_TILE
#undef CA_WAITBAR
}

__device__ __forceinline__ void xattn_mfma(Frame& F, int layer, const bool pairmap) {
    const int w = F.wave;
    const bf16* QG = (const bf16*)(F.ws + WS_Z); bf16* Y = (bf16*)(F.ws + WS_Y);
    LAS unsigned char* const lds = F.lds; const unsigned lds0 = (unsigned)(uintptr_t)F.lds;
    LAS unsigned char* const qbuf = lds + 98304 + w * 4096; const unsigned qbuf0 = lds0 + 98304 + w * 4096;
    const int nu = pairmap ? 2 : (BATCH * 4 * (SEQ / 256) - F.vcu + F.G - 1) / F.G;
    const int nsteps = nu * 8;
#define XA_UNIT(g_) (pairmap ? (((((g_) >> 3) * 64 + (F.vcu >> 5) * 8 + ((F.vcu & 31) >> 2)) >> 5) << 7 | (F.vcu & 3) << 5 | ((((g_) >> 3) * 64 + (F.vcu >> 5) * 8 + ((F.vcu & 31) >> 2)) & 31)) : (F.vcu + ((g_) >> 3) * F.G))
#define XA_DMA_KV(g_) do { const int u_ = XA_UNIT(g_), j_ = (g_) & 7, hx_ = (u_ >> 5) & 3, b_ = u_ >> 7; const unsigned slot_ = lds0 + ((g_) % 3) * 32768; \
        if (j_ < 4) { const bf16* kb_ = (const bf16*)(F.ws + WS_KP) + (size_t)((layer * 4 + b_) * 4 + hx_) * (32 * 256 * 8) + (size_t)j_ * 16384 + lane * 8; \
            _Pragma("unroll") for (int i_ = 0; i_ < 4; ++i_) { const int piece_ = w * 4 + i_; glds16_asm(kb_ + piece_ * 512, (unsigned)__builtin_amdgcn_readfirstlane((int)(slot_ + piece_ * 1024))); } } \
        else { const bf16* vb_ = (const bf16*)(F.ws + WS_VP) + (size_t)((layer * 4 + b_) * 4 + hx_) * (64 * 256 * 4) + (size_t)(64 * (j_ - 4)) * 4; \
            _Pragma("unroll") for (int i_ = 0; i_ < 4; ++i_) { const int piece_ = w * 4 + i_, p_ = piece_ * 64 + lane, kg_ = p_ >> 5, dp_ = p_ & 31; \
                glds16_asm(vb_ + ((size_t)kg_ * 256 + 2 * dp_) * 4, (unsigned)__builtin_amdgcn_readfirstlane((int)(slot_ + piece_ * 1024))); } } } while (0)
#define XA_DMA_QG(g_) do { const int u_ = XA_UNIT(g_), j_ = (g_) & 7, qb_ = u_ & 31, hx_ = (u_ >> 5) & 3, b_ = u_ >> 7; \
        const bf16* src_ = QG + ((size_t)b_ * SEQ + qb_ * 256 + w * 32 + (lane & 31)) * 2048 + hx_ * 256 + (j_ < 4 ? 64 * j_ : 1024 + 64 * (j_ - 4)) + (lane >> 5) * 8; \
        _Pragma("unroll") for (int i_ = 0; i_ < 4; ++i_) glds16_asm(src_ + 16 * i_, (unsigned)__builtin_amdgcn_readfirstlane((int)(qbuf0 + i_ * 1024))); } while (0)
#define XA_WAITBAR(n) asm volatile("s_waitcnt vmcnt(" #n ") lgkmcnt(0)\n\ts_barrier" ::: "memory")
    if (nsteps > 0) {
        int lane = lane_id_v();
        __syncthreads();
        XA_DMA_QG(0); XA_DMA_KV(0); XA_DMA_KV(1);
        XA_WAITBAR(0);
        u32x4 ydef[4]; bool have_y = false; size_t ydef_row = 0; int ydef_col = 0;
#define XA_FLUSH_Y() do { if (have_y) { bf16* yp_ = Y + ydef_row * DM + ydef_col; \
            _Pragma("unroll") for (int q_ = 0; q_ < 4; ++q_) *(u32x4*)(yp_ + 16 * q_) = ydef[q_]; have_y = false; } } while (0)
        for (int ui = 0; ui < nu; ++ui) {
            lane = lane_id_v();
            const int r = lane & 31, hi = lane >> 5;
            const int u = XA_UNIT(ui * 8), qb = u & 31, hx = (u >> 5) & 3, b = u >> 7;
            const size_t qrow = (size_t)b * SEQ + qb * 256 + w * 32 + r;
            u32x4 pf[8][2]; float rl;
            {
                f32x16 sacc[8];
#pragma unroll
                for (int kt = 0; kt < 8; ++kt)
#pragma unroll
                    for (int e = 0; e < 16; ++e) sacc[kt][e] = 0.f;
#pragma unroll 1
                for (int j = 0; j < 4; ++j) {
                    const int g = ui * 8 + j;
                    XA_FLUSH_Y();
                    bf16x8 qf[4];
#pragma unroll
                    for (int s4 = 0; s4 < 4; ++s4) qf[s4] = *(const LAS bf16x8*)(qbuf + ((2 * s4 + hi) * 32 + r) * 16);
                    asm volatile("s_waitcnt lgkmcnt(0)" ::: "memory");
                    if (g + 1 < nsteps) XA_DMA_QG(g + 1);
                    if (g + 2 < nsteps) XA_DMA_KV(g + 2);
                    const LAS unsigned char* kb = lds + (g % 3) * 32768 + (hi * 256 + r) * 16;
                    bf16x8 kfa[4], kfb[4];
#pragma unroll
                    for (int s4 = 0; s4 < 4; ++s4) kfa[s4] = *(const LAS bf16x8*)(kb + (2 * s4 * 256) * 16);
#pragma unroll
                    for (int kt = 0; kt < 8; kt += 2) {
#pragma unroll
                        for (int s4 = 0; s4 < 4; ++s4) kfb[s4] = *(const LAS bf16x8*)(kb + (2 * s4 * 256 + 32 * (kt + 1)) * 16);
                        __builtin_amdgcn_sched_barrier(0);
#pragma unroll
                        for (int s4 = 0; s4 < 4; ++s4) sacc[kt] = __builtin_amdgcn_mfma_f32_32x32x16_bf16(kfa[s4], qf[s4], sacc[kt], 0, 0, 0);
                        __builtin_amdgcn_sched_barrier(0);
                        if (kt + 2 < 8) {
#pragma unroll
                            for (int s4 = 0; s4 < 4; ++s4) kfa[s4] = *(const LAS bf16x8*)(kb + (2 * s4 * 256 + 32 * (kt + 2)) * 16);
                        }
                        __builtin_amdgcn_sched_barrier(0);
#pragma unroll
                        for (int s4 = 0; s4 < 4; ++s4) sacc[kt + 1] = __builtin_amdgcn_mfma_f32_32x32x16_bf16(kfb[s4], qf[s4], sacc[kt + 1], 0, 0, 0);
                        __builtin_amdgcn_sched_barrier(0);
                    }
                    if (j < 3) { if (g + 2 < nsteps) XA_WAITBAR(4); else XA_WAITBAR(0); }
                }
                float m = sacc[0][0];
#pragma unroll
                for (int kt = 0; kt < 8; ++kt)
#pragma unroll
                    for (int e = 0; e < 16; ++e) m = fmaxf(m, sacc[kt][e]);
                m = fmaxf(m, __shfl_xor(m, 32));
                float l = 0.f;
#pragma unroll
                for (int kt = 0; kt < 8; ++kt) {
#pragma unroll
                    for (int e = 0; e < 16; ++e) { const float pp = __builtin_amdgcn_exp2f(sacc[kt][e] - m); sacc[kt][e] = pp; l += pp; }
#pragma unroll
                    for (int s2 = 0; s2 < 2; ++s2) { u32x4 t; t.x = pk2(sacc[kt][8 * s2 + 0], sacc[kt][8 * s2 + 1]); t.y = pk2(sacc[kt][8 * s2 + 2], sacc[kt][8 * s2 + 3]);
                        t.z = pk2(sacc[kt][8 * s2 + 4], sacc[kt][8 * s2 + 5]); t.w = pk2(sacc[kt][8 * s2 + 6], sacc[kt][8 * s2 + 7]); pf[kt][s2] = t; }
                }
                l += __shfl_xor(l, 32);
                rl = 1.0f / l;
                __builtin_amdgcn_sched_barrier(0);
                { const int g = ui * 8 + 3; if (g + 2 < nsteps) XA_WAITBAR(4); else XA_WAITBAR(0); }
            }
#pragma unroll 1
            for (int j = 4; j < 8; ++j) {
                const int g = ui * 8 + j;
                XA_FLUSH_Y();
                u32x2 gq[8];
#pragma unroll
                for (int t = 0; t < 2; ++t)
#pragma unroll
                    for (int i = 0; i < 4; ++i) gq[4 * t + i] = *(const LAS u32x2*)(qbuf + ((4 * t + i) * 32 + r) * 16 + 8 * hi);
                asm volatile("s_waitcnt lgkmcnt(0)" ::: "memory");
                if (g + 1 < nsteps) XA_DMA_QG(g + 1);
                if (g + 2 < nsteps) XA_DMA_KV(g + 2);
                const LAS unsigned char* vb = lds + (g % 3) * 32768 + (hi * 64 + r) * 8;
#pragma unroll
                for (int dt = 0; dt < 2; ++dt) {
                    f32x16 oacc;
#pragma unroll
                    for (int e = 0; e < 16; ++e) oacc[e] = 0.f;
                    s16x4 va[2][2][2], vn[2][2][2];
#define XA_VLD(dst, kt2) do { _Pragma("unroll") for (int q_ = 0; q_ < 2; ++q_) _Pragma("unroll") for (int s2 = 0; s2 < 2; ++s2) { const int kg = 8 * ((kt2) + q_) + 4 * s2; \
                        dst[q_][s2][0] = *(const LAS s16x4*)(vb + (kg * 64 + 32 * dt) * 8); dst[q_][s2][1] = *(const LAS s16x4*)(vb + ((kg + 2) * 64 + 32 * dt) * 8); } } while (0)
#define XA_VMM(src, kt2) do { _Pragma("unroll") for (int q_ = 0; q_ < 2; ++q_) _Pragma("unroll") for (int s2 = 0; s2 < 2; ++s2) { const s16x4 v0 = src[q_][s2][0], v1 = src[q_][s2][1]; \
                        const bf16x8 vf = (bf16x8){v0[0], v0[1], v0[2], v0[3], v1[0], v1[1], v1[2], v1[3]}; \
                        oacc = __builtin_amdgcn_mfma_f32_32x32x16_bf16(vf, __builtin_bit_cast(bf16x8, pf[(kt2) + q_][s2]), oacc, 0, 0, 0); } } while (0)
                    XA_VLD(va, 0);
                    XA_VLD(vn, 2); __builtin_amdgcn_sched_barrier(0); XA_VMM(va, 0); __builtin_amdgcn_sched_barrier(0);
                    XA_VLD(va, 4); __builtin_amdgcn_sched_barrier(0); XA_VMM(vn, 2); __builtin_amdgcn_sched_barrier(0);
                    XA_VLD(vn, 6); __builtin_amdgcn_sched_barrier(0); XA_VMM(va, 4); __builtin_amdgcn_sched_barrier(0);
                    XA_VMM(vn, 6);
#undef XA_VLD
#undef XA_VMM
                    u32x2 yo[4];
#pragma unroll
                    for (int i = 0; i < 4; ++i) { const u32x2 gw = gq[4 * dt + i];
                        yo[i].x = pk2(oacc[4 * i] * rl * bflo(gw.x), oacc[4 * i + 1] * rl * bfhi(gw.x)); yo[i].y = pk2(oacc[4 * i + 2] * rl * bflo(gw.y), oacc[4 * i + 3] * rl * bfhi(gw.y)); }
#pragma unroll
                    for (int pr = 0; pr < 2; ++pr) { const auto r1 = __builtin_amdgcn_permlane32_swap(yo[2 * pr].x, yo[2 * pr + 1].x, false, false); const auto r2 = __builtin_amdgcn_permlane32_swap(yo[2 * pr].y, yo[2 * pr + 1].y, false, false);
                        ydef[2 * dt + pr] = (u32x4){r1[0], r2[0], r1[1], r2[1]}; }
                }
                have_y = true; ydef_row = qrow; ydef_col = hx * 256 + 64 * (j - 4) + 8 * hi;
                __builtin_amdgcn_sched_barrier(0);
                if (g + 2 < nsteps) XA_WAITBAR(4); else XA_WAITBAR(0);
            }
        }
        XA_FLUSH_Y();
    }
#undef XA_FLUSH_Y
#undef XA_UNIT
#undef XA_DMA_KV
#undef XA_DMA_QG
#undef XA_WAITBAR
}

__device__ __forceinline__ void final_norm(Frame& F, const Args& a) {
    const int gw = F.vcu * NWAVES + F.wave, NGW = F.G * NWAVES, lane = lane_id_v();
    const f32x4* gr = (const f32x4*)a.in[28] + lane;
    for (int m = gw; m < MTOK; m += NGW) {
        f32x4* xr = (f32x4*)(F.out + (size_t)m * DM) + lane;
        f32x4 v[4]; float s = 0.f;
#pragma unroll
        for (int j = 0; j < 4; ++j) { v[j] = xr[64 * j]; s += (v[j].x * v[j].x + v[j].y * v[j].y) + (v[j].z * v[j].z + v[j].w * v[j].w); }
        const float rstd = 1.0f / sqrtf(wave_sum(s) * (1.f / DM) + EPS);
#pragma unroll
        for (int j = 0; j < 4; ++j) { const f32x4 g = gr[64 * j]; xr[64 * j] = (f32x4){v[j].x * rstd * g.x, v[j].y * rstd * g.y, v[j].z * rstd * g.z, v[j].w * rstd * g.w}; }
    }
}

__device__ __forceinline__ void stagger_delay() {
    if (STAGGER_US > 0 && (blockIdx.x & 1)) { const unsigned long long t0 = __builtin_amdgcn_s_memrealtime();
        while (__builtin_amdgcn_s_memrealtime() - t0 < (unsigned long long)(STAGGER_US * 100)) __builtin_amdgcn_s_sleep(32); }
}
constexpr int NPH = 15;
__global__ void __launch_bounds__(NWAVES * 64, 2) trunk_fwd(Args args) {
    extern __shared__ __attribute__((aligned(16))) unsigned char lds[];
    Frame F;
    F.lds = (LAS unsigned char*)lds;
    F.MISC = (volatile LAS unsigned*)(F.lds + MISC_OFF);
    F.wave = __builtin_amdgcn_readfirstlane(threadIdx.x >> 6);
    F.G = gridDim.x; { const int bx = blockIdx.x; F.vcu = (F.G % 8 == 0) ? (bx % 8) * (F.G / 8) + bx / 8 : bx; }
    F.ws = args.ws; F.out = args.out; F.ctl = (unsigned*)(args.ws + WS_CTL);
    for (int u = threadIdx.x; u < (RSTD_OFF - LDSCTL_OFF) / 4; u += NWAVES * 64) ((LAS unsigned*)(F.lds + LDSCTL_OFF))[u] = 0u;
    __syncthreads();
    const int lo = args.ph_lo, hi = args.ph_hi;
    const bool multi = (hi - lo) > 1;
    XcdBarrier bar; bar.bar = F.ctl + CW_BAR; bar.x = 0; bar.st = nullptr;
    if (multi) bar = xcd_barrier_post(F.ctl + CW_BAR, F.MISC + 8, F.wave);
#define IN(k) (lo <= (k) && (k) < hi)
#define DUP(k) for (int rep_ = 0; rep_ < (((DUP_MASK >> (k)) & 1u) ? 2 : 1); ++rep_)
#define SEAM(k) do { if (IN(k) && IN((k) + 1)) xcd_barrier(bar); } while (0)
    unsigned char* ws = args.ws;
    bf16* const XB = (bf16*)(ws + WS_XB); bf16* const Y = (bf16*)(ws + WS_Y); bf16* const Z = (bf16*)(ws + WS_Z); bf16* const ZS = (bf16*)(ws + WS_ZS);
    float* const RS = (float*)(ws + WS_RS);
    pg8::Epi E0{}; E0.mode = 0; E0.perm = true;
    pg8::Epi E1{}; E1.mode = 1; E1.perm = true; E1.xout = args.out; E1.xb = XB; E1.xl = nullptr; E1.rsout = RS; E1.xold = nullptr;

    if (IN(0)) DUP(0) { p0_prologue(F, args); __syncthreads(); } SEAM(0);
    if (IN(1)) DUP(1) {
        { pg8::Gemm g{XB, (const bf16*)(ws + WS_W_IN0), MTOK, EVEN_IN, DM}; pg8::StaticOrder S; S.init(MTOK, EVEN_IN, F.G, (int)blockIdx.x);
          pg8::Epi E = E0; E.O = Z; E.ldc = EVEN_IN; E.rs = RS; E.act_silu = 0x30Cu; E.act_sig = 0xC0u; pg8::gemm_phase(F.wave, F.lds, g, S, E); }
        { pg8::Gemm g{(const bf16*)(ws + WS_MEMN), (const bf16*)(ws + WS_W_KV), BATCH * MEMLEN, 2048, DM}; pg8::StaticOrder S; S.init(BATCH * MEMLEN, 2048, F.G, (int)blockIdx.x);
          pg8::Epi E = E0; E.mode = 3; E.O = (bf16*)(ws + WS_KP); pg8::gemm_phase(F.wave, F.lds, g, S, E); }
        { pg8::Gemm g{(const bf16*)(ws + WS_W_KV) + (size_t)2048 * DM, (const bf16*)(ws + WS_MEMN), 2048, BATCH * MEMLEN, DM}; pg8::StaticOrder S; S.init(2048, BATCH * MEMLEN, F.G, (int)((blockIdx.x + F.G - 32) % F.G));
          pg8::Epi E = E0; E.mode = 4; E.O = (bf16*)(ws + WS_VP); pg8::gemm_phase(F.wave, F.lds, g, S, E); }
        { const int bx = (int)blockIdx.x; const int nidle = F.G > 64 ? F.G - 64 : F.G; const int me = F.G > 64 ? bx - 64 : bx;
          if (me >= 0) p1_late_weights(F, args, me * NWAVES + F.wave, nidle * NWAVES); __syncthreads(); }
    } SEAM(1);
    if (IN(2)) { DUP(16) { s5_phase<false>(F, args); } DUP(17) { conv_phase(F, args); } } SEAM(2);
    if (IN(3)) DUP(3) { s5_phase<true>(F, args); __syncthreads(); } SEAM(3);
    if (IN(4)) DUP(4) { pg8::Gemm g{ZS, (const bf16*)(ws + WS_W_GLU), MTOK, S5W, S5W}; pg8::StaticOrder S; S.init(MTOK, S5W, F.G, (int)blockIdx.x);
        pg8::Epi E{}; E.mode = 2; E.perm = true; E.O = Y; E.ldc = DM; E.zs = ZS; E.gatep = Z + 512; E.gate_ld = EVEN_IN; E.gb = args.in[14];
        pg8::gemm_phase(F.wave, F.lds, g, S, E); } SEAM(4);
    if (IN(5)) DUP(5) { stagger_delay(); pg8::Gemm g{Y, (const bf16*)(ws + WS_W_OUT0), MTOK, DM, DM}; pg8::StaticOrder S; S.init(MTOK, DM, F.G, (int)blockIdx.x);
        pg8::Epi E = E1; E.xold = args.in[0]; pg8::gemm_phase(F.wave, F.lds, g, S, E); } SEAM(5);
    const bool fuse_xa = multi && (F.G == 256);
#define LOCAL_HANDOFF() do { asm volatile("s_waitcnt vmcnt(0)" ::: "memory"); __syncthreads(); \
        if (F.wave == 0 && lane_id_v() == 0) { __builtin_amdgcn_fence(__ATOMIC_ACQUIRE, "agent"); asm volatile("s_waitcnt vmcnt(0)" ::: "memory"); } __syncthreads(); } while (0)
    if (IN(6)) DUP(6) { pg8::Gemm g{XB, (const bf16*)(ws + WS_W_QG), MTOK, 2048, DM};
        pg8::Epi E = E0; E.O = Z; E.ldc = 2048; E.rs = RS; E.act_silu = 0xF0u;
        if (fuse_xa) { pg8::PairOrder S{F.vcu}; pg8::gemm_phase(F.wave, F.lds, g, S, E); }
        else { pg8::StaticOrder S; S.init(MTOK, 2048, F.G, (int)blockIdx.x); pg8::gemm_phase(F.wave, F.lds, g, S, E); } }
    if (fuse_xa) { if (IN(6) && IN(7)) LOCAL_HANDOFF(); } else SEAM(6);
    if (IN(7)) DUP(7) { xattn_mfma(F, 0, fuse_xa); __syncthreads(); } SEAM(7);
    if (IN(8)) { stagger_delay(); pg8::Gemm g{Y, (const bf16*)(ws + WS_W_O), MTOK, DM, DM}; pg8::StaticOrder S; S.init(MTOK, DM, F.G, (int)blockIdx.x);
        pg8::gemm_phase(F.wave, F.lds, g, S, E1); } SEAM(8);
    if (IN(9)) DUP(9) { pg8::Gemm g{XB, (const bf16*)(ws + WS_W_IN1), MTOK, ODD_IN, DM}; pg8::StaticOrder S; S.init(MTOK, ODD_IN, F.G, (int)blockIdx.x);
#if defined(PROBE_NULLEPI)
        { pg8::Epi En = E0; En.mode = PROBE_NULLEPI; En.O = Z; En.rs = RS; pg8::gemm_phase(F.wave, F.lds, g, S, En); }
#endif
        pg8::Epi E = E0; E.mode = 5; E.O = Z; E.rs = RS; pg8::gemm_phase(F.wave, F.lds, g, S, E); } SEAM(9);
    if (IN(10)) DUP(10) { chunk_attn_mfma(F, args); __syncthreads(); } SEAM(10);
    if (IN(11)) { stagger_delay(); pg8::Gemm g{Y, (const bf16*)(ws + WS_W_OUT1), MTOK, DM, DM}; pg8::StaticOrder S; S.init(MTOK, DM, F.G, (int)blockIdx.x);
        pg8::gemm_phase(F.wave, F.lds, g, S, E1); } SEAM(11);
    if (IN(12)) { pg8::Gemm g{XB, (const bf16*)(ws + WS_W_QG) + (size_t)2048 * DM, MTOK, 2048, DM};
        pg8::Epi E = E0; E.O = Z; E.ldc = 2048; E.rs = RS; E.act_silu = 0xF0u;
        if (fuse_xa) { pg8::PairOrder S{F.vcu}; pg8::gemm_phase(F.wave, F.lds, g, S, E); }
        else { pg8::StaticOrder S; S.init(MTOK, 2048, F.G, (int)blockIdx.x); pg8::gemm_phase(F.wave, F.lds, g, S, E); } }
    if (fuse_xa) { if (IN(12) && IN(13)) LOCAL_HANDOFF(); } else SEAM(12);
    if (IN(13)) { xattn_mfma(F, 1, fuse_xa); } SEAM(13);
    if (IN(14)) { stagger_delay(); pg8::Gemm g{Y, (const bf16*)(ws + WS_W_O) + (size_t)DM * DM, MTOK, DM, DM}; pg8::StaticOrder S; S.init(MTOK, DM, F.G, (int)blockIdx.x);
        pg8::Epi E = E1; E.mode = 6; E.fin_g = args.in[28]; E.fin_cnt = F.ctl + CW_FIN; E.fin_out = args.out; pg8::gemm_phase(F.wave, F.lds, g, S, E); }
#if defined(PROBE_TAIL)
    xcd_barrier(bar);
#if PROBE_TAIL == 1
    conv_phase(F, args);
#endif
#endif
#undef IN
#undef SEAM
}

extern "C" void kernel_launch(void* const* d_in, const int* in_sizes, int n_in, void* d_out, int out_size, void* d_ws, size_t ws_size, hipStream_t stream) {
    static int grid = 0;
    if (grid == 0) {
        if (n_in != 29 || out_size != MTOK * DM || ws_size < WS_END) { fprintf(stderr, "kernel_launch: unexpected shapes: n_in %d out %d ws %zu\n", n_in, out_size, ws_size); grid = -1; return; }
        int dev = 0, cus = 0, per_cu = 0;
        if (hipGetDevice(&dev) != hipSuccess || hipDeviceGetAttribute(&cus, hipDeviceAttributeMultiprocessorCount, dev) != hipSuccess) { grid = -1; return; }
        if (hipFuncSetAttribute((const void*)trunk_fwd, hipFuncAttributeMaxDynamicSharedMemorySize, LDS_BYTES) != hipSuccess) { fprintf(stderr, "kernel_launch: hipFuncSetAttribute failed\n"); grid = -1; return; }
        if (hipOccupancyMaxActiveBlocksPerMultiprocessor(&per_cu, (const void*)trunk_fwd, NWAVES * 64, LDS_BYTES) != hipSuccess || per_cu < 1) { fprintf(stderr, "kernel_launch: occupancy query reports %d\n", per_cu); per_cu = 1; }
        (void)hipGetLastError();
        grid = cus;
        if (grid > cus * per_cu) grid = cus * per_cu;
    }
    if (grid < 0) return;
    (void)hipMemsetAsync((char*)d_ws + WS_CTL, 0, CTL_ZERO_BYTES, stream);
    Args a{};
    for (int i = 0; i < 29; ++i) a.in[i] = (const float*)d_in[i];
    a.out = (float*)d_out; a.ws = (unsigned char*)d_ws;
    if (MK_N_LAUNCHES == 1) { a.ph_lo = 0; a.ph_hi = NPH; hipLaunchKernelGGL(trunk_fwd, dim3(grid), dim3(NWAVES * 64), LDS_BYTES, stream, a); }
    else { for (int p = 0; p < NPH; ++p) { a.ph_lo = p; a.ph_hi = p + 1; hipLaunchKernelGGL(trunk_fwd, dim3(grid), dim3(NWAVES * 64), LDS_BYTES, stream, a); } }
}
```
